# Optimizing an MI355X kernel written in HIP

```python
import jax
import jax.numpy as jnp
from jax import lax
import numpy as np

D_MODEL = 2048
BATCH = 8
SEQ = 2048
DEPTH = 2

GRID_W = 64
CTX_LEN = 256
N_BRANCH = 4
BRANCH_W = D_MODEL // 4
FN_GROUPS = 4
FN_W = BRANCH_W
NA_HEADS = 8
NA_DH = BRANCH_W // NA_HEADS
NA_KH = 8
NA_KW = 16
NA_SCALE = NA_DH ** -0.5
MLA_HEADS = 4
MLA_NOPE = 128
MLA_ROPE = 64
MLA_V = BRANCH_W // MLA_HEADS
MLA_QLORA = D_MODEL // 4
MLA_KVLORA = D_MODEL // 8
MLA_SCALE = (MLA_NOPE + MLA_ROPE) ** -0.5
RW_DH = 64
RW_HEADS = BRANCH_W // RW_DH
RW_W = RW_HEADS * RW_DH
RW_DECAY_LORA = 32
RW_AAA_LORA = 32
RW_GATE_LORA = 96
RW_GN_EPS = 64e-5
N_EXPERTS = 16
EXPERT_FF = D_MODEL // 2
CAPACITY_FACTOR = 2
ROPE_THETA = 10000.0
NORM_EPS = 1e-6
Q_BLOCK = 128
NEG_INF = -1e30
F32 = jnp.float32

RW_KS_SPEC = (('k', RW_W), ('v', RW_W), ('wf', RW_DECAY_LORA), ('wb', RW_DECAY_LORA),
              ('af', RW_AAA_LORA), ('ab', RW_AAA_LORA))
RW_QS_SPEC = (('r', RW_W), ('g', RW_GATE_LORA))
RW_KS = 2 * RW_W + 2 * RW_DECAY_LORA + 2 * RW_AAA_LORA
RW_QS = RW_W + RW_GATE_LORA
KEY_SPEC = (('na_k', NA_HEADS * NA_DH), ('na_v', NA_HEADS * NA_DH), ('mla_ckv', MLA_KVLORA),
            ('mla_kpe', MLA_ROPE), ('rw_ks', RW_KS))
QUERY_SPEC = (('na_q', NA_HEADS * NA_DH), ('mla_cq', MLA_QLORA), ('rw_qs', RW_QS), ('fn', FN_W),
              ('gate', N_BRANCH * D_MODEL))
KEY_COLS = 2 * NA_HEADS * NA_DH + MLA_KVLORA + MLA_ROPE + RW_KS
Z_COLS = KEY_COLS + NA_HEADS * NA_DH + MLA_QLORA + RW_QS + FN_W + N_BRANCH * D_MODEL

kernel_name = 'hybrid_gated_diffusion_block'


def _split(z, spec):
    out, off = {}, 0
    for name, width in spec:
        out[name] = z[..., off:off + width]
        off += width
    return out


def _rmsnorm(x, g):
    xf = x.astype(F32)
    y = xf * lax.rsqrt(jnp.mean(xf * xf, axis=-1, keepdims=True) + NORM_EPS)
    return (y * g.astype(F32)).astype(x.dtype)


def _modulate(x, g, shift, scale):
    return _rmsnorm(x, g) * (1 + scale) + shift


def _heads(t, n_heads, gain=None):
    t = t.reshape(t.shape[0], t.shape[1], n_heads, -1)
    return t if gain is None else _rmsnorm(t, gain)


def _rope_1d(x, pos):
    half = x.shape[-1] // 2
    freqs = ROPE_THETA ** (-jnp.arange(half, dtype=F32) / half)
    ang = pos.astype(F32)[:, None] * freqs[None, :]
    cos, sin = jnp.cos(ang)[None, :, None, :], jnp.sin(ang)[None, :, None, :]
    xf = x.astype(F32)
    x1, x2 = xf[..., :half], xf[..., half:]
    return jnp.concatenate([x1 * cos - x2 * sin, x1 * sin + x2 * cos], -1).astype(x.dtype)


def _rope_2d(x, prow, pcol):
    half = x.shape[-1] // 2
    return jnp.concatenate([_rope_1d(x[..., :half], prow), _rope_1d(x[..., half:], pcol)], -1)


def _rope_pe(t, prow, pcol):
    return jnp.concatenate([t[..., :MLA_NOPE], _rope_2d(t[..., MLA_NOPE:], prow, pcol)], -1)


def _softmax_attn(q, k, v, scale):
    s = jnp.einsum('bqhd,bkhd->bhqk', q, k).astype(F32) * scale
    p = jax.nn.softmax(s, axis=-1).astype(v.dtype)
    return jnp.einsum('bhqk,bkhd->bqhd', p, v)


def _blocked_attn(q, k, v, scale):
    B, L, H, d = q.shape
    qb = jnp.moveaxis(q.reshape(B, L // Q_BLOCK, Q_BLOCK, H, d), 1, 0)
    o = lax.map(lambda qi: _softmax_attn(qi, k, v, scale), qb)
    return jnp.moveaxis(o, 0, 1).reshape(B, L, H, v.shape[-1])


def _neigh_attn_latent(q, k, v, kc, vc, rpb):
    B, L, H, dh = q.shape
    rows = L // GRID_W
    kh = min(NA_KH, rows)
    r = jnp.arange(rows)
    col = jnp.arange(GRID_W)
    rs = jnp.clip(r - kh // 2, 0, rows - kh)
    band = rs[:, None] + jnp.arange(kh)[None, :]
    cs = jnp.clip(col - NA_KW // 2, 0, GRID_W - NA_KW)
    valid = (col[None, :] >= cs[:, None]) & (col[None, :] < cs[:, None] + NA_KW)
    dr_idx = band - r[:, None] + NA_KH - 1
    dc_idx = jnp.clip(col[None, :] - col[:, None] + NA_KW - 1, 0, 2 * NA_KW - 2)
    bias = rpb.astype(F32)[:, dr_idx[:, None, :, None], dc_idx[None, :, None, :]]
    bias = jnp.where(valid[None, None, :, None, :], bias, NEG_INF)
    qg = q.reshape(B, rows, GRID_W, H, dh)
    kb = k.reshape(B, rows, GRID_W, H, dh)[:, band]
    vb = v.reshape(B, rows, GRID_W, H, dh)[:, band]
    s_loc = jnp.einsum('brqhd,brikhd->bhrqik', qg, kb).astype(F32) * NA_SCALE + bias[None]
    s_ctx = jnp.einsum('brqhd,bmhd->bhrqm', qg, kc).astype(F32) * NA_SCALE
    n_loc = kh * GRID_W
    s = jnp.concatenate([s_loc.reshape(B, H, rows, GRID_W, n_loc), s_ctx], axis=-1)
    p = jax.nn.softmax(s, axis=-1).astype(v.dtype)
    p_loc = p[..., :n_loc].reshape(B, H, rows, GRID_W, kh, GRID_W)
    o = (jnp.einsum('bhrqik,brikhd->brqhd', p_loc, vb)
         + jnp.einsum('bhrqm,bmhd->brqhd', p[..., n_loc:], vc))
    return o.reshape(B, L, H, dh)


def _mla_q(cq, p, prow=None, pcol=None):
    B, N, _ = cq.shape
    q = (_rmsnorm(cq, p['mla_cq_norm']) @ p['mla_w_uq']).reshape(B, N, MLA_HEADS, MLA_NOPE + MLA_ROPE)
    q = _rmsnorm(q, p['mla_q_norm'])
    return q if prow is None else _rope_pe(q, prow, pcol)


def _mla_kv(ckv, kpe, p, prow=None, pcol=None):
    B, N, _ = ckv.shape
    kv = (_rmsnorm(ckv, p['mla_ckv_norm']) @ p['mla_w_ukv']).reshape(B, N, MLA_HEADS, MLA_NOPE + MLA_V)
    k_pe = jnp.broadcast_to(kpe[:, :, None, :], (B, N, MLA_HEADS, MLA_ROPE))
    k = _rmsnorm(jnp.concatenate([kv[..., :MLA_NOPE], k_pe], axis=-1), p['mla_k_norm'])
    if prow is not None:
        k = _rope_pe(k, prow, pcol)
    return k, kv[..., MLA_NOPE:]


def _fourier(zf):
    B, N, _ = zf.shape
    g = zf.astype(F32).reshape(B, N, FN_GROUPS, FN_W // FN_GROUPS).transpose(0, 2, 1, 3)
    y = jnp.real(jnp.fft.fft2(g, norm='ortho'))
    return y.transpose(0, 2, 1, 3).reshape(B, N, FN_W).astype(zf.dtype)


def _shift_mix(z, mu):
    zp = jnp.pad(z, ((0, 0), (1, 1), (0, 0)))
    sh = 0.5 * (zp[:, :-2] + zp[:, 2:])
    return z + (sh - z) * mu


def _rwkv_prepare(zks, p):
    B, N, _ = zks.shape
    s = _split(zks.astype(F32), RW_KS_SPEC)
    hd = lambda t: t.reshape(B, N, RW_HEADS, RW_DH)
    k = s['k']
    v = hd(s['v'])
    kk = hd(k * p['rw_k_k'])
    kk = kk / jnp.maximum(jnp.sqrt(jnp.sum(kk * kk, axis=-1, keepdims=True)), 1e-12)
    dirs = []
    for d, (wn, an) in enumerate((('wf', 'af'), ('wb', 'ab'))):
        w = p['rw_w0'][d] + jnp.tanh(s[wn]) @ p['rw_w2'][d]
        decay = jnp.exp(-jnp.exp(-jax.nn.softplus(-w) - 0.5))
        a = jax.nn.sigmoid(p['rw_a0'][d] + s[an] @ p['rw_a2'][d])
        kd = k * (1.0 + (a - 1.0) * p['rw_k_a'])
        dirs.append((hd(decay), kk * hd(a), hd(kd)))
    return v, kk, dirs


def _wkv7(S0, decay, kk, b, k, v, r=None, reverse=False):
    seq = [jnp.moveaxis(t, 1, 0) for t in (decay, kk, b, k, v)]
    if r is not None:
        seq.append(jnp.moveaxis(r, 1, 0))

    def step(S, xs):
        w_t, kk_t, b_t, k_t, v_t = xs[:5]
        sa = jnp.einsum('bhvk,bhk->bhv', S, kk_t)
        S = S * w_t[:, :, None, :] - sa[..., None] * b_t[:, :, None, :] + v_t[..., None] * k_t[:, :, None, :]
        y = jnp.einsum('bhvk,bhk->bhv', S, xs[5]) if r is not None else None
        return S, y

    S, ys = lax.scan(step, S0, tuple(seq), reverse=reverse)
    return S, (None if r is None else jnp.moveaxis(ys, 0, 1))


def _rwkv_out(y, r, k_sum, v, g_lora, p):
    B, N = y.shape[:2]
    mu = jnp.mean(y, axis=-1, keepdims=True)
    var = jnp.mean(jnp.square(y - mu), axis=-1, keepdims=True)
    yn = ((y - mu) * lax.rsqrt(var + RW_GN_EPS)).reshape(B, N, RW_W) * p['rw_ln_w'] + p['rw_ln_b']
    bonus = jnp.sum(r * k_sum * p['rw_r_k'], axis=-1, keepdims=True) * v
    gate = jax.nn.sigmoid(g_lora) @ p['rw_g2']
    return (yn + bonus.reshape(B, N, RW_W)) * gate


def _rwkv_branch(zks, zqs, zks_c, zqs_c, p):
    B = zks.shape[0]
    v, kk, dirs = _rwkv_prepare(_shift_mix(zks, p['rw_mu_ks']), p)
    vc, kkc, dirs_c = _rwkv_prepare(_shift_mix(zks_c, p['rw_mu_ks']), p)
    qs = _split(_shift_mix(zqs, p['rw_mu_qs']).astype(F32), RW_QS_SPEC)
    r = qs['r'].reshape(B, -1, RW_HEADS, RW_DH)
    if zqs_c is not None:
        qsc = _split(_shift_mix(zqs_c, p['rw_mu_qs']).astype(F32), RW_QS_SPEC)
        rc = qsc['r'].reshape(B, -1, RW_HEADS, RW_DH)
    else:
        qsc, rc = None, None
    S0 = jnp.zeros((B, RW_HEADS, RW_DH, RW_DH), F32)
    ys, ycs = [], []
    for d, reverse in enumerate((False, True)):
        decay_c, b_c, k_c = dirs_c[d]
        S_c, y_c = _wkv7(S0, decay_c, kkc, b_c, k_c, vc, rc, reverse)
        decay_l, b_l, k_l = dirs[d]
        _, y_l = _wkv7(S_c, decay_l, kk, b_l, k_l, v, r, reverse)
        ys.append(y_l)
        ycs.append(y_c)
    out = _rwkv_out(ys[0] + ys[1], r, dirs[0][2] + dirs[1][2], v, qs['g'], p).astype(zks.dtype)
    if rc is None:
        return out, None
    out_c = _rwkv_out(ycs[0] + ycs[1], rc, dirs_c[0][2] + dirs_c[1][2], vc, qsc['g'], p).astype(zks.dtype)
    return out, out_c


def _merge(branches, gate_cols, w_br, w_out):
    B, N, _ = gate_cols.shape
    gates = jax.nn.sigmoid(gate_cols.astype(F32)).astype(gate_cols.dtype).reshape(B, N, N_BRANCH, D_MODEL)
    acc = gates[:, :, 0] * (branches[0] @ w_br[0])
    for i in range(1, N_BRANCH):
        acc = acc + gates[:, :, i] * (branches[i] @ w_br[i])
    return acc @ w_out


def _mixer(h, hc, p, ctx_out):
    B, L, _ = h.shape
    n_ctx = hc.shape[1]
    pos = jnp.arange(L)
    prow, pcol = pos // GRID_W, pos % GRID_W
    z = h @ p['w_in']
    zk = _split(z[..., :KEY_COLS], KEY_SPEC)
    zq = _split(z[..., KEY_COLS:], QUERY_SPEC)
    zc = hc @ (p['w_in'] if ctx_out else p['w_in'][:, :KEY_COLS])
    zck = _split(zc[..., :KEY_COLS], KEY_SPEC)
    zcq = _split(zc[..., KEY_COLS:], QUERY_SPEC) if ctx_out else None

    na_k = _heads(zk['na_k'], NA_HEADS, p['na_k_norm'])
    na_v = _heads(zk['na_v'], NA_HEADS)
    na_kc = _heads(zck['na_k'], NA_HEADS, p['na_k_norm'])
    na_vc = _heads(zck['na_v'], NA_HEADS)
    na_q = _heads(zq['na_q'], NA_HEADS, p['na_q_norm'])
    y_na = _neigh_attn_latent(na_q, na_k, na_v, na_kc, na_vc, p['na_rpb']).reshape(B, L, BRANCH_W)

    m_k, m_v = _mla_kv(zk['mla_ckv'], zk['mla_kpe'], p, prow, pcol)
    m_kc, m_vc = _mla_kv(zck['mla_ckv'], zck['mla_kpe'], p)
    m_q = _mla_q(zq['mla_cq'], p, prow, pcol)
    y_mla = _blocked_attn(m_q, jnp.concatenate([m_k, m_kc], axis=1), jnp.concatenate([m_v, m_vc], axis=1),
                          MLA_SCALE).reshape(B, L, BRANCH_W)

    y_rw, yc_rw = _rwkv_branch(zk['rw_ks'], zq['rw_qs'], zck['rw_ks'],
                               zcq['rw_qs'] if ctx_out else None, p)

    y_fn = _fourier(zq['fn'])

    y = _merge((y_fn, y_na, y_mla, y_rw), zq['gate'], p['w_br'], p['w_out'])
    if not ctx_out:
        return y, None
    yc_na = _softmax_attn(_heads(zcq['na_q'], NA_HEADS, p['na_q_norm']), na_kc, na_vc,
                          NA_SCALE).reshape(B, n_ctx, BRANCH_W)
    yc_mla = _softmax_attn(_mla_q(zcq['mla_cq'], p), m_kc, m_vc, MLA_SCALE).reshape(B, n_ctx, BRANCH_W)
    yc_fn = _fourier(zcq['fn'])
    yc = _merge((yc_fn, yc_na, yc_mla, yc_rw), zcq['gate'], p['w_br'], p['w_out'])
    return y, yc


def _expert_choice_moe(h, w_router, w1, w3, w2):
    B, N, D = h.shape
    cap = CAPACITY_FACTOR * N // N_EXPERTS
    aff = jax.nn.softmax((h @ w_router).astype(F32), axis=-1)
    gate, idx = lax.top_k(jnp.swapaxes(aff, 1, 2), cap)
    xe = jax.vmap(lambda hb, ib: hb[ib])(h, idx)
    a = jnp.einsum('becd,edf->becf', xe, w1)
    u = jnp.einsum('becd,edf->becf', xe, w3)
    ye = jnp.einsum('becf,efd->becd', jax.nn.silu(a) * u, w2) * gate[..., None].astype(h.dtype)
    return jax.vmap(lambda yb, ib: jnp.zeros((N, D), yb.dtype).at[ib.reshape(-1)].add(yb.reshape(-1, D)))(ye, idx)


def setup_inputs(seed: int = 0) -> dict:
    key = jax.random.key(seed)
    keys = iter(jax.random.split(key, 48))

    def nrm(shape, scale):
        return jax.random.normal(next(keys), shape, F32) * scale

    def gain(shape):
        return 1.0 + nrm(shape, 0.02)

    def unif(shape, lo, hi):
        return jax.random.uniform(next(keys), shape, F32, lo, hi)

    return {
        'x': nrm((BATCH, SEQ, D_MODEL), 1.0),
        'c': nrm((BATCH, D_MODEL), 1.0),
        'ctx': nrm((BATCH, CTX_LEN, D_MODEL), 1.0),
        'c_ctx': nrm((D_MODEL,), 1.0),
        'ada_w': nrm((DEPTH, D_MODEL, 6 * D_MODEL), 0.5 * D_MODEL ** -0.5),
        'ada_b': nrm((DEPTH, 6 * D_MODEL), 0.01),
        'norm1_g': gain((DEPTH, D_MODEL)),
        'norm2_g': gain((DEPTH, D_MODEL)),
        'w_in': nrm((DEPTH, D_MODEL, Z_COLS), D_MODEL ** -0.5),
        'na_q_norm': gain((DEPTH, NA_DH)),
        'na_k_norm': gain((DEPTH, NA_DH)),
        'na_rpb': nrm((DEPTH, NA_HEADS, 2 * NA_KH - 1, 2 * NA_KW - 1), 0.1),
        'mla_cq_norm': gain((DEPTH, MLA_QLORA)),
        'mla_ckv_norm': gain((DEPTH, MLA_KVLORA)),
        'mla_w_uq': nrm((DEPTH, MLA_QLORA, MLA_HEADS * (MLA_NOPE + MLA_ROPE)), MLA_QLORA ** -0.5),
        'mla_w_ukv': nrm((DEPTH, MLA_KVLORA, MLA_HEADS * (MLA_NOPE + MLA_V)), MLA_KVLORA ** -0.5),
        'mla_q_norm': gain((DEPTH, MLA_NOPE + MLA_ROPE)),
        'mla_k_norm': gain((DEPTH, MLA_NOPE + MLA_ROPE)),
        'rw_mu_ks': unif((DEPTH, RW_KS), 0.0, 1.0),
        'rw_mu_qs': unif((DEPTH, RW_QS), 0.0, 1.0),
        'rw_w0': unif((DEPTH, 2, RW_W), -4.0, 1.0),
        'rw_w2': nrm((DEPTH, 2, RW_DECAY_LORA, RW_W), 0.1),
        'rw_a0': nrm((DEPTH, 2, RW_W), 0.1),
        'rw_a2': nrm((DEPTH, 2, RW_AAA_LORA, RW_W), 0.5 * RW_AAA_LORA ** -0.5),
        'rw_g2': nrm((DEPTH, RW_GATE_LORA, RW_W), RW_GATE_LORA ** -0.5),
        'rw_k_k': 0.85 + nrm((DEPTH, RW_W), 0.05),
        'rw_k_a': 1.0 + nrm((DEPTH, RW_W), 0.05),
        'rw_r_k': nrm((DEPTH, RW_HEADS, RW_DH), 0.1),
        'rw_ln_w': gain((DEPTH, RW_W)),
        'rw_ln_b': nrm((DEPTH, RW_W), 0.01),
        'w_br': nrm((DEPTH, N_BRANCH, BRANCH_W, D_MODEL), BRANCH_W ** -0.5),
        'w_out': nrm((DEPTH, D_MODEL, D_MODEL), D_MODEL ** -0.5),
        'moe_router': nrm((DEPTH, D_MODEL, N_EXPERTS), D_MODEL ** -0.5),
        'moe_w1': nrm((DEPTH, N_EXPERTS, D_MODEL, EXPERT_FF), D_MODEL ** -0.5),
        'moe_w3': nrm((DEPTH, N_EXPERTS, D_MODEL, EXPERT_FF), D_MODEL ** -0.5),
        'moe_w2': nrm((DEPTH, N_EXPERTS, EXPERT_FF, D_MODEL), EXPERT_FF ** -0.5),
    }


def reference(x, c, ctx, c_ctx, ada_w, ada_b, norm1_g, norm2_g, w_in, na_q_norm, na_k_norm, na_rpb,
              mla_cq_norm, mla_ckv_norm, mla_w_uq, mla_w_ukv, mla_q_norm, mla_k_norm,
              rw_mu_ks, rw_mu_qs, rw_w0, rw_w2, rw_a0, rw_a2, rw_g2, rw_k_k, rw_k_a, rw_r_k,
              rw_ln_w, rw_ln_b, w_br, w_out, moe_router, moe_w1, moe_w3, moe_w2):
    silu_c = jax.nn.silu(c)
    silu_cc = jax.nn.silu(c_ctx)[None, :]
    xc = ctx
    for layer in range(DEPTH):
        last = layer == DEPTH - 1
        p = {
            'w_in': w_in[layer], 'na_q_norm': na_q_norm[layer], 'na_k_norm': na_k_norm[layer],
            'na_rpb': na_rpb[layer], 'mla_cq_norm': mla_cq_norm[layer], 'mla_ckv_norm': mla_ckv_norm[layer],
            'mla_w_uq': mla_w_uq[layer], 'mla_w_ukv': mla_w_ukv[layer], 'mla_q_norm': mla_q_norm[layer],
            'mla_k_norm': mla_k_norm[layer], 'rw_mu_ks': rw_mu_ks[layer], 'rw_mu_qs': rw_mu_qs[layer],
            'rw_w0': rw_w0[layer], 'rw_w2': rw_w2[layer], 'rw_a0': rw_a0[layer], 'rw_a2': rw_a2[layer],
            'rw_g2': rw_g2[layer], 'rw_k_k': rw_k_k[layer], 'rw_k_a': rw_k_a[layer], 'rw_r_k': rw_r_k[layer],
            'rw_ln_w': rw_ln_w[layer], 'rw_ln_b': rw_ln_b[layer], 'w_br': w_br[layer], 'w_out': w_out[layer],
        }
        mod = (silu_c @ ada_w[layer] + ada_b[layer])[:, None, :]
        mod_c = (silu_cc @ ada_w[layer] + ada_b[layer])[:, None, :]
        sh1, sc1, g1, sh2, sc2, g2 = jnp.split(mod, 6, axis=-1)
        csh1, csc1, cg1, csh2, csc2, cg2 = jnp.split(mod_c, 6, axis=-1)
        h = _modulate(x, norm1_g[layer], sh1, sc1)
        hc = _modulate(xc, norm1_g[layer], csh1, csc1)
        y, yc = _mixer(h, hc, p, not last)
        x = x + g1 * y
        x = x + g2 * _expert_choice_moe(_modulate(x, norm2_g[layer], sh2, sc2), moe_router[layer],
                                        moe_w1[layer], moe_w3[layer], moe_w2[layer])
        if not last:
            xc = xc + cg1 * yc
            xc = xc + cg2 * _expert_choice_moe(_modulate(xc, norm2_g[layer], csh2, csc2), moe_router[layer],
                                               moe_w1[layer], moe_w3[layer], moe_w2[layer])
    return x
```

```cpp
#include <hip/hip_runtime.h>
#include <stdint.h>
#include <stdio.h>
#include <string.h>

#define LAS __attribute__((address_space(3)))
typedef unsigned short bf16_t;
typedef short bf16x8 __attribute__((ext_vector_type(8)));
typedef float f32x4 __attribute__((ext_vector_type(4)));
typedef float f32x2 __attribute__((ext_vector_type(2)));
typedef unsigned u32x4 __attribute__((ext_vector_type(4)));
typedef unsigned u32x2 __attribute__((ext_vector_type(2)));

constexpr int NB = 8, SEQ = 2048, DM = 2048, CTXL = 256, DEPTH = 2;
constexpr int T = NB * SEQ, TC = NB * CTXL, TT = T + TC;
constexpr int ZW = 4864;
constexpr int GW = 8192;
constexpr int ZN = ZW + GW;
constexpr int NEXP = 16, EFF = 1024;
constexpr int XE_ROWS = 128 * 256 + 16 * 256;
constexpr float NORM_EPS = 1e-6f;

struct Params {
    const float* in[36];
    float* out;
    unsigned* bar;
    float* MOD;
    float* MODP;
    float* XCUR;
    bf16_t* WIN_T;
    bf16_t* WBR_T;
    bf16_t* WOUT_T;
    bf16_t* WUQ_T;
    bf16_t* WUKV_T;
    bf16_t* WLORA_T;
    bf16_t* WFC;
    bf16_t* ADFT;
    bf16_t* ADFTC;
    bf16_t* H;
    bf16_t* Y;
    bf16_t* ZS;
    bf16_t* G;
    bf16_t* NQ;
    bf16_t* NK;
    bf16_t* CQN;
    bf16_t* CKVN;
    bf16_t* LA;
    bf16_t* RK;
    bf16_t* RV;
    bf16_t* RR;
    float*  RKK;
    float*  DEC;
    float*  BB;
    bf16_t* KD;
    bf16_t* GRW;
    float*  YS;
    bf16_t* Q0;
    bf16_t* KV0;
    bf16_t* MQ;
    bf16_t* MK;
    bf16_t* XCS;
    bf16_t* XCSC;
    float*  ACC;
    bf16_t* ACCB;
    bf16_t* W13T;
    bf16_t* W2T;
    bf16_t* H2;
    float*  AFFT;
    float*  AFFC;
    int*    IDXROW;
    float*  GATEV;
    int*    SEL;
    bf16_t* XE;
    bf16_t* HH;
    bf16_t* YE;
};

__device__ __forceinline__ float bf2f(bf16_t h) { return __uint_as_float(((unsigned)h) << 16); }
__device__ __forceinline__ bf16_t f2bf(float f) { unsigned u = __float_as_uint(f); u += 0x7fffu + ((u >> 16) & 1u); return (bf16_t)(u >> 16); }
__device__ __forceinline__ unsigned pk2(float lo, float hi) { return (unsigned)f2bf(lo) | ((unsigned)f2bf(hi) << 16); }
__device__ __forceinline__ void unpack8(u32x4 w, float* v) {
    v[0] = __uint_as_float(w.x << 16); v[1] = __uint_as_float(w.x & 0xffff0000u);
    v[2] = __uint_as_float(w.y << 16); v[3] = __uint_as_float(w.y & 0xffff0000u);
    v[4] = __uint_as_float(w.z << 16); v[5] = __uint_as_float(w.z & 0xffff0000u);
    v[6] = __uint_as_float(w.w << 16); v[7] = __uint_as_float(w.w & 0xffff0000u);
}
__device__ __forceinline__ u32x4 pack8(const float* v) { u32x4 w; w.x = pk2(v[0], v[1]); w.y = pk2(v[2], v[3]); w.z = pk2(v[4], v[5]); w.w = pk2(v[6], v[7]); return w; }
__device__ __forceinline__ void load8(const bf16_t* p, float* v) { unpack8(*(const u32x4*)p, v); }
__device__ __forceinline__ void store8(bf16_t* p, const float* v) { *(u32x4*)p = pack8(v); }
__device__ __forceinline__ float wave_sum(float v) {
#pragma unroll
    for (int o = 32; o; o >>= 1) v += __shfl_xor(v, o);
    return v;
}
__device__ __forceinline__ float wave_max(float v) {
#pragma unroll
    for (int o = 32; o; o >>= 1) v = fmaxf(v, __shfl_xor(v, o));
    return v;
}
__device__ __forceinline__ float sum8(float v) { v += __shfl_xor(v, 1); v += __shfl_xor(v, 2); v += __shfl_xor(v, 4); return v; }
__device__ __forceinline__ float sigmoidf_(float x) { return 1.0f / (1.0f + __expf(-x)); }
__device__ __forceinline__ int row_s(int r) { return r < T ? (r >> 11) : 8; }

namespace pg8 {
constexpr int BM = 256, BK = 64, HALF = 128, HTB = HALF * BK * 2, STAGE_BYTES = 8 * HTB, NXCD = 8, WGM = 8;
__host__ __device__ __forceinline__ int lds_byte(int r, int c) { const int st = (r >> 4) * 2 + (c >> 5), rr = r & 15, cc = c & 31, ob = rr * 64 + cc * 2; return st * 1024 + (ob ^ (((ob >> 9) & 1) << 5)); }
__host__ __device__ __forceinline__ void stage_rc(int b, int& R, int& C) { const int st = b / 1024, sb = b % 1024, swz = sb ^ (((sb >> 9) & 1) << 5); R = (st >> 1) * 16 + swz / 64; C = (st & 1) * 32 + (swz % 64) / 2; }
__host__ __device__ __forceinline__ int perm32(int rho) { const int n = rho >> 4, i = rho & 15; return 8 * (i >> 2) + 4 * n + (i & 3); }

struct Unit { int pm, pn, aux, pad; const char* a; const char* b; };

__device__ __forceinline__ bool tile_of(long L, int nM, int nN, int& pm, int& pn) {
    const int nwg = nM * nN; if (L >= nwg) return false;
    int wgid = (int)L; { const int q = nwg / NXCD, r = nwg % NXCD, xcd = wgid % NXCD, off = wgid / NXCD; wgid = (xcd < r ? xcd * (q + 1) : r * (q + 1) + (xcd - r) * q) + off; }
    const int nig = WGM * nN, gid = wgid / nig, fm = gid * WGM, gsz = (nM - fm) < WGM ? (nM - fm) : WGM;
    pm = fm + ((wgid % nig) % gsz); pn = (wgid % nig) / gsz; return true;
}

struct Sched2D {
    const char* A; const char* B; long a_tile, b_tile, b_grp; int nM, nN, G, c, moe;
    __device__ __forceinline__ bool next(int i, Unit& u) const {
        int pm, pn; if (!tile_of((long)i * G + c, nM, nN, pm, pn)) return false;
        u.pm = pm; u.pn = pn; u.aux = 0; u.pad = 0;
        u.a = A + (long)pm * a_tile;
        const int e = moe ? (pm < 128 ? (pm >> 3) : (pm - 128)) : 0;
        u.b = B + (long)pn * b_tile + (long)e * b_grp;
        return true;
    }
};
struct SchedMerge {
    const char* A; const char* B; int nM, nN, G, c;
    __device__ __forceinline__ bool next(int i, Unit& u) const {
        int pm, pn; if (!tile_of((long)(i >> 2) * G + c, nM, nN, pm, pn)) return false;
        const int br = i & 3;
        u.pm = pm; u.pn = pn; u.aux = br; u.pad = 0;
        u.a = A + ((long)pm * 256 * 2048 + br * 512) * 2;
        u.b = B + ((long)br * 2048 * 512 + (long)pn * 256 * 512) * 2;
        return true;
    }
};

template <class Epi, class Sched>
__device__ __forceinline__ void gemm_phase(LAS unsigned char* lds, const int K, const int lda, const int ldb, const Sched& S, const Epi& E) {
    const int tid = threadIdx.x, wid = __builtin_amdgcn_readfirstlane(tid >> 6), lane = tid & 63, wr = wid >> 2, wc = wid & 3, fr = lane & 15, fq = lane >> 4;
    const int nt = K / BK;
    unsigned voffA[2], voffB[2];
#pragma unroll
    for (int i = 0; i < 2; ++i) { int R, C; stage_rc(tid * 16 + i * 8192, R, C); const int Rb = Epi::PERM ? ((R & ~31) + perm32(R & 31)) : R;
        voffA[i] = (unsigned)(R * lda + C) * 2u; voffB[i] = (unsigned)(Rb * ldb + C) * 2u; }
    const size_t kstep = (size_t)(BK * 2);
    const size_t hstepA = (size_t)HALF * lda * 2, hstepB = (size_t)HALF * ldb * 2;
    const unsigned ldsw = (unsigned)wid * 1024u;
    const int aoff = lds_byte(wr * 64 + fr, fq * 8), boff = lds_byte(wc * 32 + fr, fq * 8);
#define PG8_SA(b, h) (((b) * 2 + (h)) * HTB)
#define PG8_SB(b, h) ((4 + (b) * 2 + (h)) * HTB)
#define PG8_STAGE(bufoff, gbase, voff) do { _Pragma("unroll") for (int _i = 0; _i < 2; ++_i) \
        __builtin_amdgcn_global_load_lds((const unsigned*)((const char*)(gbase) + (voff)[_i]), (LAS unsigned*)(lds + (bufoff) + ldsw + _i * 8192), 16, 0, 0); } while (0)
#define PG8_LDA(dst, b, h) do { _Pragma("unroll") for (int m = 0; m < 4; ++m) _Pragma("unroll") for (int k = 0; k < 2; ++k) dst[m][k] = *(const LAS bf16x8*)(lds + PG8_SA(b, h) + aoff + m * 2048 + k * 1024); } while (0)
#define PG8_LDB(dst, b, h) do { _Pragma("unroll") for (int n = 0; n < 2; ++n) _Pragma("unroll") for (int k = 0; k < 2; ++k) dst[n][k] = *(const LAS bf16x8*)(lds + PG8_SB(b, h) + boff + n * 2048 + k * 1024); } while (0)
#define PG8_MMA(ai, bj, At, Bt) do { __builtin_amdgcn_s_setprio(1); _Pragma("unroll") for (int m = 0; m < 4; ++m) _Pragma("unroll") for (int n = 0; n < 2; ++n) _Pragma("unroll") for (int k = 0; k < 2; ++k) \
        acc[ai][bj][m][n] = __builtin_amdgcn_mfma_f32_16x16x32_bf16(Bt[n][k], At[m][k], acc[ai][bj][m][n], 0, 0, 0); __builtin_amdgcn_s_setprio(0); } while (0)
#define PG8_WAIT_V(n) asm volatile("s_waitcnt vmcnt(" #n ")" ::: "memory")
#define PG8_WAIT_L(n) asm volatile("s_waitcnt lgkmcnt(" #n ")" ::: "memory")
#define PG8_BAR __builtin_amdgcn_s_barrier()
#define PG8_SCHED __builtin_amdgcn_sched_barrier(0)
    Unit cur, nxt; int ui = 0;
    if (!S.next(0, cur)) return;
    f32x4 acc[2][2][4][2];
#pragma unroll
    for (int a = 0; a < 2; ++a)
#pragma unroll
        for (int b = 0; b < 2; ++b)
#pragma unroll
            for (int m = 0; m < 4; ++m)
#pragma unroll
                for (int n = 0; n < 2; ++n) acc[a][b][m][n] = (f32x4){0.f, 0.f, 0.f, 0.f};
    bf16x8 At[4][2], B0[2][2], B1[2][2];
    const char* cA = cur.a; const char* cB = cur.b;
    PG8_STAGE(PG8_SB(0, 0), cB, voffB); PG8_STAGE(PG8_SA(0, 0), cA, voffA); PG8_STAGE(PG8_SB(0, 1), cB + hstepB, voffB); PG8_STAGE(PG8_SA(0, 1), cA + hstepA, voffA);
    if (wr == 1) PG8_BAR;
    PG8_WAIT_V(4); PG8_BAR;
    PG8_STAGE(PG8_SB(1, 0), cB + kstep, voffB); PG8_STAGE(PG8_SA(1, 0), cA + kstep, voffA); PG8_STAGE(PG8_SB(1, 1), cB + hstepB + kstep, voffB);
    PG8_WAIT_V(6); PG8_BAR;
    for (;;) {
        const bool has_next = S.next(ui + 1, nxt);
        const char* nA = has_next ? nxt.a : cA; const char* nB = has_next ? nxt.b : cB;
        for (int t = 0; t < nt; t += 2) {
            const bool last = (t == nt - 2);
            const char* a1 = cA + (size_t)(t + 1) * kstep;
            const char* a2 = last ? nA : cA + (size_t)(t + 2) * kstep; const char* b2 = last ? nB : cB + (size_t)(t + 2) * kstep;
            const char* a3 = a2 + kstep; const char* b3 = b2 + kstep;
            PG8_LDB(B0, 0, 0); PG8_SCHED; PG8_LDA(At, 0, 0); PG8_STAGE(PG8_SA(1, 1), a1 + hstepA, voffA);
            PG8_WAIT_L(8); PG8_BAR; PG8_WAIT_L(0); PG8_MMA(0, 0, At, B0); PG8_BAR; PG8_SCHED;
            PG8_LDB(B1, 0, 1); PG8_STAGE(PG8_SB(0, 0), b2, voffB);
            PG8_BAR; PG8_WAIT_L(0); PG8_MMA(0, 1, At, B1); PG8_BAR;
            PG8_LDA(At, 0, 1); PG8_STAGE(PG8_SA(0, 0), a2, voffA);
            PG8_BAR; PG8_WAIT_L(0); PG8_MMA(1, 0, At, B0); PG8_BAR; PG8_SCHED;
            PG8_STAGE(PG8_SB(0, 1), b2 + hstepB, voffB);
            PG8_WAIT_V(6); PG8_BAR; PG8_MMA(1, 1, At, B1); PG8_BAR;
            PG8_LDB(B0, 1, 0); PG8_SCHED; PG8_LDA(At, 1, 0); PG8_STAGE(PG8_SA(0, 1), a2 + hstepA, voffA);
            PG8_WAIT_L(8); PG8_BAR; PG8_WAIT_L(0); PG8_MMA(0, 0, At, B0); PG8_BAR; PG8_SCHED;
            PG8_LDB(B1, 1, 1); PG8_STAGE(PG8_SB(1, 0), b3, voffB);
            PG8_BAR; PG8_WAIT_L(0); PG8_MMA(0, 1, At, B1); PG8_BAR;
            PG8_LDA(At, 1, 1); PG8_STAGE(PG8_SA(1, 0), a3, voffA);
            PG8_BAR; PG8_WAIT_L(0); PG8_MMA(1, 0, At, B0); PG8_BAR; PG8_SCHED;
            PG8_STAGE(PG8_SB(1, 1), b3 + hstepB, voffB);
            PG8_WAIT_V(6); PG8_BAR; PG8_MMA(1, 1, At, B1); PG8_BAR;
        }
        E(acc, cur, wr, wc, fr, fq);
        if (!has_next) break;
#pragma unroll
        for (int a = 0; a < 2; ++a)
#pragma unroll
            for (int b = 0; b < 2; ++b)
#pragma unroll
                for (int m = 0; m < 4; ++m)
#pragma unroll
                    for (int n = 0; n < 2; ++n) acc[a][b][m][n] = (f32x4){0.f, 0.f, 0.f, 0.f};
        cur = nxt; cA = nA; cB = nB; ++ui;
    }
    PG8_WAIT_V(0);
    if (wr == 0) PG8_BAR;
    PG8_BAR;
#undef PG8_SA
#undef PG8_SB
#undef PG8_STAGE
#undef PG8_LDA
#undef PG8_LDB
#undef PG8_MMA
#undef PG8_WAIT_V
#undef PG8_WAIT_L
#undef PG8_BAR
#undef PG8_SCHED
}

template <class F> __device__ __forceinline__ void walk8(const f32x4 (&acc)[2][2][4][2], const Unit& u, int wr, int wc, int fr, int fq, F f) {
    const int row0 = u.pm * BM + wr * 64 + fr, col0 = u.pn * BM + wc * 32 + 8 * fq;
#pragma unroll
    for (int ai = 0; ai < 2; ++ai)
#pragma unroll
        for (int m = 0; m < 4; ++m)
#pragma unroll
            for (int bj = 0; bj < 2; ++bj) f(row0 + ai * HALF + m * 16, col0 + bj * HALF, acc[ai][bj][m][0], acc[ai][bj][m][1]);
}
template <class F> __device__ __forceinline__ void walk4(const f32x4 (&acc)[2][2][4][2], const Unit& u, int wr, int wc, int fr, int fq, F f) {
    const int row0 = u.pm * BM + wr * 64 + fr, col0 = u.pn * BM + wc * 32 + 4 * fq;
#pragma unroll
    for (int ai = 0; ai < 2; ++ai)
#pragma unroll
        for (int m = 0; m < 4; ++m)
#pragma unroll
            for (int bj = 0; bj < 2; ++bj)
#pragma unroll
                for (int n = 0; n < 2; ++n) f(row0 + ai * HALF + m * 16, col0 + bj * HALF + n * 16, acc[ai][bj][m][n]);
}
}
using pg8::Unit;
typedef f32x4 AccT[2][2][4][2];

__device__ __forceinline__ u32x4 pack8v(f32x4 a, f32x4 b) { u32x4 w; w.x = pk2(a[0], a[1]); w.y = pk2(a[2], a[3]); w.z = pk2(b[0], b[1]); w.w = pk2(b[2], b[3]); return w; }

struct EpiWin {
    static constexpr bool PERM = true;
    bf16_t* ZS; bf16_t* G;
    __device__ __forceinline__ void operator()(const AccT& acc, const Unit& u, int wr, int wc, int fr, int fq) const {
        if (u.pn < 19) {
            bf16_t* z = ZS;
            pg8::walk8(acc, u, wr, wc, fr, fq, [&](int row, int col, f32x4 a, f32x4 b) { *(u32x4*)(z + (size_t)row * ZW + col) = pack8v(a, b); });
        } else {
            bf16_t* g = G;
            pg8::walk8(acc, u, wr, wc, fr, fq, [&](int row, int col, f32x4 a, f32x4 b) {
#pragma unroll
                for (int k = 0; k < 4; ++k) { a[k] = sigmoidf_(a[k]); b[k] = sigmoidf_(b[k]); }
                *(u32x4*)(g + (size_t)row * GW + (col - ZW)) = pack8v(a, b); });
        }
    }
};
struct EpiBf16 {
    static constexpr bool PERM = true;
    bf16_t* O; int ldo;
    __device__ __forceinline__ void operator()(const AccT& acc, const Unit& u, int wr, int wc, int fr, int fq) const {
        bf16_t* o = O; const int ld = ldo;
        pg8::walk8(acc, u, wr, wc, fr, fq, [&](int row, int col, f32x4 a, f32x4 b) { *(u32x4*)(o + (size_t)row * ld + col) = pack8v(a, b); });
    }
};
struct EpiLora {
    static constexpr bool PERM = false;
    const float* w0; const float* a0; const float* k_a;
    const bf16_t* RK; const float* RKK; float* DEC; float* BB; bf16_t* KD; bf16_t* GRW;
    __device__ __forceinline__ void operator()(const AccT& acc, const Unit& u, int wr, int wc, int fr, int fq) const {
        const int seg = u.pn >> 1;
        pg8::walk4(acc, u, wr, wc, fr, fq, [&](int row, int col, f32x4 v) {
            const int c = col & 511; const size_t o = (size_t)row * 512 + c;
            if (seg < 2) {
                const f32x4 wv = *(const f32x4*)(w0 + seg * 512 + c); f32x4 r;
#pragma unroll
                for (int k = 0; k < 4; ++k) { const float w = wv[k] + v[k]; const float x = -w; const float sp = fmaxf(x, 0.f) + __logf(1.0f + __expf(-fabsf(x))); r[k] = __expf(-__expf(-sp - 0.5f)); }
                *(f32x4*)(DEC + (size_t)seg * TT * 512 + o) = r;
            } else if (seg < 4) {
                const int d = seg - 2;
                const f32x4 av = *(const f32x4*)(a0 + d * 512 + c), kav = *(const f32x4*)(k_a + c), kk = *(const f32x4*)(RKK + o);
                const u32x2 kw = *(const u32x2*)(RK + o);
                float kf[4] = { __uint_as_float(kw.x << 16), __uint_as_float(kw.x & 0xffff0000u), __uint_as_float(kw.y << 16), __uint_as_float(kw.y & 0xffff0000u) };
                f32x4 bb; float kd[4];
#pragma unroll
                for (int k = 0; k < 4; ++k) { const float a = sigmoidf_(av[k] + v[k]); kd[k] = kf[k] * (1.0f + (a - 1.0f) * kav[k]); bb[k] = kk[k] * a; }
                *(f32x4*)(BB + (size_t)d * TT * 512 + o) = bb;
                u32x2 w; w.x = pk2(kd[0], kd[1]); w.y = pk2(kd[2], kd[3]);
                *(u32x2*)(KD + (size_t)d * TT * 512 + o) = w;
            } else {
                u32x2 w; w.x = pk2(v[0], v[1]); w.y = pk2(v[2], v[3]);
                *(u32x2*)(GRW + o) = w;
            }
        });
    }
};
struct EpiFourChan {
    static constexpr bool PERM = true;
    bf16_t* XCS; bf16_t* XCSC;
    __device__ __forceinline__ void operator()(const AccT& acc, const Unit& u, int wr, int wc, int fr, int fq) const {
        pg8::walk8(acc, u, wr, wc, fr, fq, [&](int row, int col, f32x4 a, f32x4 b) {
            const int gc = row >> 1, cs = row & 1;
            if (col < T) { const int bb = col >> 11, n = col & 2047; *(u32x4*)(XCS + ((size_t)((bb * 512 + gc) * 2 + cs)) * 2048 + n) = pack8v(a, b); }
            else { const int cc = col - T, bb = cc >> 8, n = cc & 255; *(u32x4*)(XCSC + ((size_t)((bb * 512 + gc) * 2 + cs)) * 256 + n) = pack8v(a, b); }
        });
    }
};
struct EpiFourSeq {
    static constexpr bool PERM = true;
    bf16_t* Y; int rowbase, seqlen; float scale;
    __device__ __forceinline__ void operator()(const AccT& acc, const Unit& u, int wr, int wc, int fr, int fq) const {
        pg8::walk8(acc, u, wr, wc, fr, fq, [&](int row, int col, f32x4 a, f32x4 b) {
            const int bb = col >> 9, ch = col & 511;
            a *= scale; b *= scale;
            *(u32x4*)(Y + (size_t)(rowbase + bb * seqlen + row) * 2048 + ch) = pack8v(a, b);
        });
    }
};
struct EpiMerge {
    static constexpr bool PERM = true;
    const bf16_t* G; float* ACC; bf16_t* ACCB;
    __device__ __forceinline__ void operator()(const AccT& acc, const Unit& u, int wr, int wc, int fr, int fq) const {
        const int br = u.aux;
        pg8::walk8(acc, u, wr, wc, fr, fq, [&](int row, int col, f32x4 a, f32x4 b) {
            float g[8]; load8(G + (size_t)row * GW + br * 2048 + col, g);
            float* ap = ACC + (size_t)row * 2048 + col;
            f32x4 t0 = {0.f, 0.f, 0.f, 0.f}, t1 = {0.f, 0.f, 0.f, 0.f};
            if (br > 0) { t0 = *(const f32x4*)ap; t1 = *(const f32x4*)(ap + 4); }
#pragma unroll
            for (int k = 0; k < 4; ++k) { t0[k] += g[k] * a[k]; t1[k] += g[4 + k] * b[k]; }
            if (br < 3) { *(f32x4*)ap = t0; *(f32x4*)(ap + 4) = t1; }
            else *(u32x4*)(ACCB + (size_t)row * 2048 + col) = pack8v(t0, t1);
        });
    }
};
struct EpiWout {
    static constexpr bool PERM = false;
    float* X; const float* MODL;
    __device__ __forceinline__ void operator()(const AccT& acc, const Unit& u, int wr, int wc, int fr, int fq) const {
        pg8::walk4(acc, u, wr, wc, fr, fq, [&](int row, int col, f32x4 v) {
            const f32x4 g = *(const f32x4*)(MODL + (size_t)row_s(row) * 12288 + 2 * 2048 + col);
            float* xp = X + (size_t)row * 2048 + col;
            f32x4 x = *(const f32x4*)xp; x += g * v; *(f32x4*)xp = x;
        });
    }
};
struct EpiSwiglu {
    static constexpr bool PERM = true;
    bf16_t* HH;
    __device__ __forceinline__ void operator()(const AccT& acc, const Unit& u, int wr, int wc, int fr, int fq) const {
        const int row0 = u.pm * 256 + wr * 64 + fr, col0 = u.pn * 128 + wc * 32 + 8 * fq;
#pragma unroll
        for (int ai = 0; ai < 2; ++ai)
#pragma unroll
            for (int m = 0; m < 4; ++m) {
                f32x4 o0, o1;
#pragma unroll
                for (int k = 0; k < 4; ++k) {
                    const float a0 = acc[ai][0][m][0][k], u0 = acc[ai][1][m][0][k], a1 = acc[ai][0][m][1][k], u1 = acc[ai][1][m][1][k];
                    o0[k] = a0 * sigmoidf_(a0) * u0; o1[k] = a1 * sigmoidf_(a1) * u1;
                }
                *(u32x4*)(HH + (size_t)(row0 + ai * 128 + m * 16) * EFF + col0) = pack8v(o0, o1);
            }
    }
};
struct EpiMoeOut {
    static constexpr bool PERM = true;
    bf16_t* YE; const float* GATEV;
    __device__ __forceinline__ void operator()(const AccT& acc, const Unit& u, int wr, int wc, int fr, int fq) const {
        pg8::walk8(acc, u, wr, wc, fr, fq, [&](int row, int col, f32x4 a, f32x4 b) {
            const float g = GATEV[row]; a *= g; b *= g;
            *(u32x4*)(YE + (size_t)row * 2048 + col) = pack8v(a, b);
        });
    }
};

#define TID ((int)threadIdx.x)
#define WID ((int)(threadIdx.x >> 6))
#define LANE ((int)(threadIdx.x & 63))
#define GWAVE ((int)(blockIdx.x * 8 + (threadIdx.x >> 6)))
#define NWAVE ((int)(gridDim.x * 8))

__device__ __forceinline__ void ph_adaln_partial(const Params& p, LAS unsigned char* lds) {
    LAS float* sv = (LAS float*)lds;
    const float* c = p.in[1]; const float* cc = p.in[3]; const float* ada_w = p.in[4];
    for (int u = blockIdx.x; u < 192; u += gridDim.x) {
        const int dc = u % 16, jc = (u / 16) % 6, l = u / 96;
        __syncthreads();
        for (int i = TID; i < 9 * 128; i += 512) { const int s = i / 128, d = dc * 128 + (i % 128); const float cv = s < 8 ? c[s * 2048 + d] : cc[d]; sv[i] = cv / (1.0f + __expf(-cv)); }
        __syncthreads();
        const float* w = ada_w + ((size_t)l * 2048 + dc * 128) * 12288 + jc * 2048 + TID * 4;
        f32x4 acc[9];
#pragma unroll
        for (int s = 0; s < 9; ++s) acc[s] = (f32x4){0.f, 0.f, 0.f, 0.f};
        for (int d = 0; d < 128; ++d) {
            const f32x4 w4 = *(const f32x4*)(w + (size_t)d * 12288);
#pragma unroll
            for (int s = 0; s < 9; ++s) acc[s] += sv[s * 128 + d] * w4;
        }
#pragma unroll
        for (int s = 0; s < 9; ++s) *(f32x4*)(p.MODP + (((size_t)dc * 2 + l) * 9 + s) * 12288 + jc * 2048 + TID * 4) = acc[s];
    }
}
__device__ __forceinline__ void ph_adaln_reduce(const Params& p) {
    const float* ada_b = p.in[5];
    for (int i = blockIdx.x * 512 + TID; i < 2 * 9 * 12288; i += gridDim.x * 512) {
        const int j = i % 12288, l = i / (9 * 12288);
        float a = ada_b[l * 12288 + j];
        for (int dc = 0; dc < 16; ++dc) a += p.MODP[(size_t)dc * 2 * 9 * 12288 + i];
        p.MOD[i] = a;
    }
}

struct CvtJob { const float* src; bf16_t* dst; int R, C, dst_ld, map, nb; long src_bs, dst_bs; };
__device__ __forceinline__ int cvt_map(int map, int c) {
    if (map == 1) return c < 4640 ? c : c + 224;
    if (map == 2) return (c >> 7) * 256 + (c & 127);
    if (map == 3) return (c >> 7) * 256 + 128 + (c & 127);
    return c;
}
__device__ __forceinline__ void cvt_run(const CvtJob J, LAS unsigned char* lds) {
    LAS float* tile = (LAS float*)lds;
    const int nct = J.C / 32, tpb = (J.R / 64) * nct, total = J.nb * tpb;
    for (int t = blockIdx.x; t < total; t += gridDim.x) {
        const int bi = t / tpb, r2 = t % tpb, rt = r2 / nct, ct = r2 % nct;
        const int tr = TID >> 3, tc = TID & 7;
        const f32x4 v = *(const f32x4*)(J.src + (size_t)bi * J.src_bs + (size_t)(rt * 64 + tr) * J.C + ct * 32 + tc * 4);
        __syncthreads();
#pragma unroll
        for (int k = 0; k < 4; ++k) tile[(tc * 4 + k) * 65 + tr] = v[k];
        __syncthreads();
        if (TID < 256) {
            const int c = TID >> 3, r8 = TID & 7; float f[8];
#pragma unroll
            for (int k = 0; k < 8; ++k) f[k] = tile[c * 65 + r8 * 8 + k];
            store8(J.dst + (size_t)bi * J.dst_bs + (size_t)cvt_map(J.map, ct * 32 + c) * J.dst_ld + rt * 64 + r8 * 8, f);
        }
    }
}
__device__ __forceinline__ void ph_cvt_mixer(const Params& p, int l, LAS unsigned char* lds) {
    cvt_run(CvtJob{p.in[8] + (size_t)l * 2048 * 12832, p.WIN_T, 2048, 12832, 2048, 1, 1, 0, 0}, lds);
    cvt_run(CvtJob{p.in[30] + (size_t)l * 4 * 512 * 2048, p.WBR_T, 512, 2048, 512, 0, 4, 512 * 2048, 2048 * 512}, lds);
    cvt_run(CvtJob{p.in[31] + (size_t)l * 2048 * 2048, p.WOUT_T, 2048, 2048, 2048, 0, 1, 0, 0}, lds);
    cvt_run(CvtJob{p.in[14] + (size_t)l * 512 * 768, p.WUQ_T, 512, 768, 512, 0, 1, 0, 0}, lds);
    cvt_run(CvtJob{p.in[15] + (size_t)l * 256 * 1024, p.WUKV_T, 256, 1024, 256, 0, 1, 0, 0}, lds);
    for (int i = blockIdx.x * 512 + TID; i < 224 * 2048 / 8; i += gridDim.x * 512) *(u32x4*)(p.WIN_T + (size_t)4640 * 2048 + (size_t)i * 8) = (u32x4){0u, 0u, 0u, 0u};
    const float* w2 = p.in[21] + (size_t)l * 2 * 32 * 512; const float* a2 = p.in[23] + (size_t)l * 2 * 32 * 512; const float* g2 = p.in[24] + (size_t)l * 96 * 512;
    for (int i = blockIdx.x * 512 + TID; i < 2560 * 256; i += gridDim.x * 512) {
        const int n = i >> 8, k = i & 255, seg = n >> 9, c = n & 511; float v = 0.f;
        if (seg == 0 && k < 32) v = w2[(0 * 32 + k) * 512 + c];
        else if (seg == 1 && k >= 32 && k < 64) v = w2[(1 * 32 + (k - 32)) * 512 + c];
        else if (seg == 2 && k >= 64 && k < 96) v = a2[(0 * 32 + (k - 64)) * 512 + c];
        else if (seg == 3 && k >= 96 && k < 128) v = a2[(1 * 32 + (k - 96)) * 512 + c];
        else if (seg == 4 && k >= 128 && k < 224) v = g2[(k - 128) * 512 + c];
        p.WLORA_T[i] = f2bf(v);
    }
}
__device__ __forceinline__ void ph_cvt_moe(const Params& p, int l, LAS unsigned char* lds) {
    cvt_run(CvtJob{p.in[33] + (size_t)l * 16 * 2048 * 1024, p.W13T, 2048, 1024, 2048, 2, 16, 2048 * 1024, 2048 * 2048}, lds);
    cvt_run(CvtJob{p.in[34] + (size_t)l * 16 * 2048 * 1024, p.W13T, 2048, 1024, 2048, 3, 16, 2048 * 1024, 2048 * 2048}, lds);
    cvt_run(CvtJob{p.in[35] + (size_t)l * 16 * 1024 * 2048, p.W2T, 1024, 2048, 1024, 0, 16, 1024 * 2048, 2048 * 1024}, lds);
}
__device__ __forceinline__ void ph_const(const Params& p) {
    const int gt = blockIdx.x * 512 + TID, gn = gridDim.x * 512;
    for (int i = gt; i < 1024 * 512; i += gn) {
        const int m = i >> 9, k = i & 511, g = m >> 8, cp = (m >> 1) & 127, cs = m & 1, g2 = k >> 7, c = k & 127; float v = 0.f;
        if (g == g2) { const int mm = (c * cp) & 127; const float x = (float)mm * (2.0f / 128.0f); v = cs ? sinpif(x) : cospif(x); }
        p.WFC[i] = f2bf(v);
    }
    for (int i = gt; i < 2048 * 4096; i += gn) {
        const int k = i >> 12, r = i & 4095, cs = r >> 11, n = r & 2047; const int mm = (k * n) & 2047; const float x = (float)mm * (2.0f / 2048.0f);
        p.ADFT[i] = f2bf(cs ? -sinpif(x) : cospif(x));
    }
    for (int i = gt; i < 256 * 512; i += gn) {
        const int k = i >> 9, r = i & 511, cs = r >> 8, n = r & 255; const int mm = (k * n) & 255; const float x = (float)mm * (2.0f / 256.0f);
        p.ADFTC[i] = f2bf(cs ? -sinpif(x) : cospif(x));
    }
}

__device__ __forceinline__ void ph_modulate(const Params& p, int l, bf16_t* dst) {
    const float* g = p.in[6] + l * 2048;
    const float* modl = p.MOD + (size_t)l * 9 * 12288;
    for (int r = GWAVE; r < TT; r += NWAVE) {
        const float* src = (l == 0) ? (r < T ? p.in[0] + (size_t)r * 2048 : p.in[2] + (size_t)(r - T) * 2048) : p.XCUR + (size_t)r * 2048;
        f32x4 v[8]; float ss = 0.f;
#pragma unroll
        for (int i = 0; i < 8; ++i) { v[i] = *(const f32x4*)(src + i * 256 + LANE * 4); ss += v[i][0] * v[i][0] + v[i][1] * v[i][1] + v[i][2] * v[i][2] + v[i][3] * v[i][3]; }
        ss = wave_sum(ss);
        const float rs = rsqrtf(ss * (1.0f / 2048.0f) + NORM_EPS);
        const float* ms = modl + (size_t)row_s(r) * 12288;
#pragma unroll
        for (int i = 0; i < 8; ++i) {
            const int c = i * 256 + LANE * 4;
            if (l == 0) *(f32x4*)(p.XCUR + (size_t)r * 2048 + c) = v[i];
            const f32x4 gg = *(const f32x4*)(g + c), sh = *(const f32x4*)(ms + c), sc = *(const f32x4*)(ms + 2048 + c);
            f32x4 y = v[i] * rs * gg * (1.0f + sc) + sh;
            u32x2 w; w.x = pk2(y[0], y[1]); w.y = pk2(y[2], y[3]);
            *(u32x2*)(dst + (size_t)r * 2048 + c) = w;
        }
    }
}

__device__ __forceinline__ void shiftmix8(const bf16_t* z, bool hp, bool hn, const float* mu, float* o) {
    float a[8], b[8], c[8];
    load8(z, a);
    if (hp) load8(z - ZW, b); else { for (int k = 0; k < 8; ++k) b[k] = 0.f; }
    if (hn) load8(z + ZW, c); else { for (int k = 0; k < 8; ++k) c[k] = 0.f; }
#pragma unroll
    for (int k = 0; k < 8; ++k) o[k] = a[k] + (0.5f * (b[k] + c[k]) - a[k]) * mu[k];
}
__device__ __forceinline__ void ph_prepA(const Params& p, int l) {
    const float* qn = p.in[9] + l * 64; const float* kn = p.in[10] + l * 64;
    const float* cqn = p.in[12] + l * 512; const float* ckvn = p.in[13] + l * 256;
    const float* mu_ks = p.in[18] + l * 1152; const float* mu_qs = p.in[19] + l * 608;
    const float* k_k = p.in[25] + l * 512;
    const int lane = LANE;
    for (int r = GWAVE; r < TT; r += NWAVE) {
        const bf16_t* z = p.ZS + (size_t)r * ZW;
        int pos, len; if (r < T) { pos = r & 2047; len = 2048; } else { pos = (r - T) & 255; len = 256; }
        const bool hp = pos > 0, hn = pos < len - 1;
        float v[8], o[8];
        load8(z + 2496 + 8 * lane, v);
        { float ss = 0.f; for (int k = 0; k < 8; ++k) ss += v[k] * v[k]; ss = sum8(ss); const float rs = rsqrtf(ss * (1.0f / 64.0f) + NORM_EPS) * 0.125f;
          for (int k = 0; k < 8; ++k) o[k] = v[k] * rs * qn[(8 * lane + k) & 63]; store8(p.NQ + (size_t)r * 512 + 8 * lane, o); }
        load8(z + 8 * lane, v);
        { float ss = 0.f; for (int k = 0; k < 8; ++k) ss += v[k] * v[k]; ss = sum8(ss); const float rs = rsqrtf(ss * (1.0f / 64.0f) + NORM_EPS);
          for (int k = 0; k < 8; ++k) o[k] = v[k] * rs * kn[(8 * lane + k) & 63]; store8(p.NK + (size_t)r * 512 + 8 * lane, o); }
        load8(z + 3008 + 8 * lane, v);
        { float ss = 0.f; for (int k = 0; k < 8; ++k) ss += v[k] * v[k]; ss = wave_sum(ss); const float rs = rsqrtf(ss * (1.0f / 512.0f) + NORM_EPS);
          for (int k = 0; k < 8; ++k) o[k] = v[k] * rs * cqn[8 * lane + k]; store8(p.CQN + (size_t)r * 512 + 8 * lane, o); }
        { float ss = 0.f; if (lane < 32) { load8(z + 1024 + 8 * lane, v); for (int k = 0; k < 8; ++k) ss += v[k] * v[k]; }
          ss = wave_sum(ss); const float rs = rsqrtf(ss * (1.0f / 256.0f) + NORM_EPS);
          if (lane < 32) { for (int k = 0; k < 8; ++k) o[k] = v[k] * rs * ckvn[8 * lane + k]; store8(p.CKVN + (size_t)r * 256 + 8 * lane, o); } }
        float mu[8];
        for (int k = 0; k < 8; ++k) mu[k] = mu_ks[8 * lane + k];
        shiftmix8(z + 1344 + 8 * lane, hp, hn, mu, o);
        store8(p.RK + (size_t)r * 512 + 8 * lane, o);
        { float t[8], ss = 0.f; for (int k = 0; k < 8; ++k) { t[k] = o[k] * k_k[8 * lane + k]; ss += t[k] * t[k]; } ss = sum8(ss);
          const float inv = 1.0f / fmaxf(sqrtf(ss), 1e-12f);
          f32x4 k0 = {t[0] * inv, t[1] * inv, t[2] * inv, t[3] * inv}, k1 = {t[4] * inv, t[5] * inv, t[6] * inv, t[7] * inv};
          *(f32x4*)(p.RKK + (size_t)r * 512 + 8 * lane) = k0; *(f32x4*)(p.RKK + (size_t)r * 512 + 8 * lane + 4) = k1; }
        for (int k = 0; k < 8; ++k) mu[k] = mu_ks[512 + 8 * lane + k];
        shiftmix8(z + 1856 + 8 * lane, hp, hn, mu, o);
        store8(p.RV + (size_t)r * 512 + 8 * lane, o);
        for (int k = 0; k < 8; ++k) mu[k] = mu_qs[8 * lane + k];
        shiftmix8(z + 3520 + 8 * lane, hp, hn, mu, o);
        store8(p.RR + (size_t)r * 512 + 8 * lane, o);
        if (lane < 16) {
            for (int k = 0; k < 8; ++k) mu[k] = mu_ks[1024 + 8 * lane + k];
            shiftmix8(z + 2368 + 8 * lane, hp, hn, mu, o);
            if (lane < 8) for (int k = 0; k < 8; ++k) o[k] = tanhf(o[k]);
            store8(p.LA + (size_t)r * 256 + 8 * lane, o);
        } else if (lane < 28) {
            const int j = lane - 16;
            for (int k = 0; k < 8; ++k) mu[k] = mu_qs[512 + 8 * j + k];
            shiftmix8(z + 4032 + 8 * j, hp, hn, mu, o);
            for (int k = 0; k < 8; ++k) o[k] = sigmoidf_(o[k]);
            store8(p.LA + (size_t)r * 256 + 128 + 8 * j, o);
        } else if (lane < 32) {
            for (int k = 0; k < 8; ++k) o[k] = 0.f;
            store8(p.LA + (size_t)r * 256 + 128 + 8 * (lane - 16), o);
        }
    }
}

__device__ __forceinline__ float rope_lane(float x, int lane, int pos) {
    const int blk = lane >> 5, jj = lane & 31, i = jj & 15;
    const int pp = blk ? (pos & 63) : (pos >> 6);
    const float freq = exp2f(-(float)i * (13.287712379549449f / 16.0f));
    const float ang = (float)pp * freq;
    float s, c; sincosf(ang, &s, &c);
    const float xp = __shfl_xor(x, 16);
    return (jj < 16) ? (x * c - xp * s) : (xp * s + x * c);
}
__device__ __forceinline__ void ph_prepB(const Params& p, int l) {
    const float* qg = p.in[16] + l * 192; const float* kg = p.in[17] + l * 192;
    const int lane = LANE;
    const float MLA_SCALE = 0.07216878364870323f;
    for (int it = GWAVE; it < TT * 4; it += NWAVE) {
        const int r = it >> 2, h = it & 3;
        {
            const bf16_t* q = p.Q0 + (size_t)r * 768 + h * 192;
            float x0 = bf2f(q[lane]), x1 = bf2f(q[lane + 64]), x2 = bf2f(q[lane + 128]);
            const float ss = wave_sum(x0 * x0 + x1 * x1 + x2 * x2), rs = rsqrtf(ss * (1.0f / 192.0f) + NORM_EPS);
            x0 *= rs * qg[lane]; x1 *= rs * qg[lane + 64]; x2 *= rs * qg[lane + 128];
            if (r < T) x2 = rope_lane(x2, lane, r & 2047);
            bf16_t* o = p.MQ + ((size_t)r * 4 + h) * 192;
            o[lane] = f2bf(x0 * MLA_SCALE); o[lane + 64] = f2bf(x1 * MLA_SCALE); o[lane + 128] = f2bf(x2 * MLA_SCALE);
        }
        {
            const bf16_t* kv = p.KV0 + (size_t)r * 1024 + h * 256;
            float x0 = bf2f(kv[lane]), x1 = bf2f(kv[lane + 64]), x2 = bf2f(p.ZS[(size_t)r * ZW + 1280 + lane]);
            const float ss = wave_sum(x0 * x0 + x1 * x1 + x2 * x2), rs = rsqrtf(ss * (1.0f / 192.0f) + NORM_EPS);
            x0 *= rs * kg[lane]; x1 *= rs * kg[lane + 64]; x2 *= rs * kg[lane + 128];
            if (r < T) x2 = rope_lane(x2, lane, r & 2047);
            bf16_t* o = p.MK + ((size_t)r * 4 + h) * 192;
            o[lane] = f2bf(x0); o[lane + 64] = f2bf(x1); o[lane + 128] = f2bf(x2);
        }
    }
}

__device__ __forceinline__ void ph_mla_naive(const Params& p, int l, LAS unsigned char* lds) {
    const int lane = LANE, wid = WID;
    LAS float* qs = (LAS float*)lds + wid * 2560;
    LAS float* sc = qs + 192;
    const int nlat = NB * 4 * 256, nctx = (l == 0) ? NB * 4 * 32 : 0;
    for (int it = blockIdx.x; it < nlat + nctx; it += gridDim.x) {
        int b, h, q, qrow, nk; bool isctx = it >= nlat;
        if (!isctx) { b = it >> 10; h = (it >> 8) & 3; q = (it & 255) * 8 + wid; qrow = b * 2048 + q; nk = 2304; }
        else { const int j = it - nlat; b = j >> 7; h = (j >> 5) & 3; q = (j & 31) * 8 + wid; qrow = T + b * 256 + q; nk = 256; }
        const bf16_t* qp = p.MQ + ((size_t)qrow * 4 + h) * 192;
        __syncthreads();
        qs[lane] = bf2f(qp[lane]); qs[lane + 64] = bf2f(qp[lane + 64]); qs[lane + 128] = bf2f(qp[lane + 128]);
        __syncthreads();
        float mx = -3.0e38f;
        for (int j0 = 0; j0 < nk; j0 += 64) {
            const int j = j0 + lane;
            const int krow = isctx ? (T + b * 256 + j) : (j < 2048 ? b * 2048 + j : T + b * 256 + (j - 2048));
            const bf16_t* kp = p.MK + ((size_t)krow * 4 + h) * 192;
            float d = 0.f;
            for (int c = 0; c < 24; ++c) { float kf[8]; load8(kp + c * 8, kf);
                const f32x4 q0 = *(const LAS f32x4*)(qs + c * 8), q1 = *(const LAS f32x4*)(qs + c * 8 + 4);
                d += kf[0] * q0[0] + kf[1] * q0[1] + kf[2] * q0[2] + kf[3] * q0[3] + kf[4] * q1[0] + kf[5] * q1[1] + kf[6] * q1[2] + kf[7] * q1[3]; }
            sc[j] = d; mx = fmaxf(mx, d);
        }
        mx = wave_max(mx);
        float sum = 0.f;
        for (int j0 = 0; j0 < nk; j0 += 64) { const float e = __expf(sc[j0 + lane] - mx); sc[j0 + lane] = e; sum += e; }
        sum = wave_sum(sum);
        __syncthreads();
        float a0 = 0.f, a1 = 0.f;
        for (int j = 0; j < nk; ++j) {
            const int krow = isctx ? (T + b * 256 + j) : (j < 2048 ? b * 2048 + j : T + b * 256 + (j - 2048));
            const unsigned vv = *(const unsigned*)(p.KV0 + (size_t)krow * 1024 + h * 256 + 128 + 2 * lane);
            const float pj = sc[j];
            a0 += pj * __uint_as_float(vv << 16); a1 += pj * __uint_as_float(vv & 0xffff0000u);
        }
        const float inv = 1.0f / sum;
        *(unsigned*)(p.Y + (size_t)qrow * 2048 + 1024 + h * 128 + 2 * lane) = pk2(a0 * inv, a1 * inv);
    }
}

__device__ __forceinline__ void ph_na_naive(const Params& p, int l, LAS unsigned char* lds) {
    const int lane = LANE, wid = WID;
    LAS float* qs = (LAS float*)lds + wid * 512;
    LAS float* pb = qs + 64;
    const float* rpb = p.in[11] + (size_t)l * 8 * 15 * 31;
    const int nlat = NB * 8 * 256, nctx = (l == 0) ? NB * 8 * 32 : 0;
    for (int it = blockIdx.x; it < nlat + nctx; it += gridDim.x) {
        int b, h, q, qrow; const bool isctx = it >= nlat;
        if (!isctx) { b = it >> 11; h = (it >> 8) & 7; q = (it & 255) * 8 + wid; qrow = b * 2048 + q; }
        else { const int j = it - nlat; b = j >> 8; h = (j >> 5) & 7; q = (j & 31) * 8 + wid; qrow = T + b * 256 + q; }
        const int r = q >> 6, qc = q & 63;
        const int rs = min(max(r - 4, 0), 24), cs = min(max(qc - 8, 0), 48);
        __syncthreads();
        qs[lane] = bf2f(p.NQ[(size_t)qrow * 512 + h * 64 + lane]);
        __syncthreads();
        const int nit = isctx ? 4 : 6;
        float sv[6]; float mx = -3.0e38f;
#pragma unroll
        for (int t = 0; t < 6; ++t) {
            sv[t] = -3.0e38f; if (t >= nit) continue;
            const int kidx = lane + 64 * t; int krow; float bias = 0.f;
            if (isctx) krow = T + b * 256 + kidx;
            else if (kidx < 128) { const int kr = rs + (kidx >> 4), kc = cs + (kidx & 15); krow = b * 2048 + kr * 64 + kc; bias = rpb[(h * 15 + (kr - r + 7)) * 31 + (kc - qc + 15)]; }
            else krow = T + b * 256 + (kidx - 128);
            const bf16_t* kp = p.NK + (size_t)krow * 512 + h * 64;
            float d = 0.f;
            for (int c = 0; c < 8; ++c) { float kf[8]; load8(kp + c * 8, kf);
                const f32x4 q0 = *(const LAS f32x4*)(qs + c * 8), q1 = *(const LAS f32x4*)(qs + c * 8 + 4);
                d += kf[0] * q0[0] + kf[1] * q0[1] + kf[2] * q0[2] + kf[3] * q0[3] + kf[4] * q1[0] + kf[5] * q1[1] + kf[6] * q1[2] + kf[7] * q1[3]; }
            sv[t] = d + bias; mx = fmaxf(mx, sv[t]);
        }
        mx = wave_max(mx);
        float sum = 0.f;
#pragma unroll
        for (int t = 0; t < 6; ++t) { if (t < nit) { const float e = __expf(sv[t] - mx); pb[lane + 64 * t] = e; sum += e; } }
        sum = wave_sum(sum);
        __syncthreads();
        float a = 0.f;
        const int nk = nit * 64;
        for (int j = 0; j < nk; ++j) {
            int krow;
            if (isctx) krow = T + b * 256 + j;
            else if (j < 128) krow = b * 2048 + (rs + (j >> 4)) * 64 + cs + (j & 15);
            else krow = T + b * 256 + (j - 128);
            a += pb[j] * bf2f(p.ZS[(size_t)krow * ZW + 512 + h * 64 + lane]);
        }
        p.Y[(size_t)qrow * 2048 + 512 + h * 64 + lane] = f2bf(a / sum);
    }
}

__device__ __forceinline__ int scan_row(int b, int d, int s) {
    if (d == 0) return s < 256 ? (T + b * 256 + s) : (b * 2048 + (s - 256));
    return s < 256 ? (T + b * 256 + (255 - s)) : (b * 2048 + (2047 - (s - 256)));
}
__device__ __forceinline__ void ph_scan_naive(const Params& p, LAS unsigned char* lds) {
    if (WID != 0) return;
    const int lane = LANE;
    LAS float* L = (LAS float*)lds;
    for (int sid = blockIdx.x; sid < 128; sid += gridDim.x) {
        const int b = sid >> 4, h = (sid >> 1) & 7, d = sid & 1;
        float S[64];
#pragma unroll
        for (int j = 0; j < 64; ++j) S[j] = 0.f;
        const float* DEC = p.DEC + (size_t)d * TT * 512; const float* BB = p.BB + (size_t)d * TT * 512; const bf16_t* KD = p.KD + (size_t)d * TT * 512;
        float* YS = p.YS + (size_t)d * TT * 512;
        constexpr int PF = 2;
        float pw[PF], pkk[PF], pbb[PF], pk[PF], pr[PF], pv[PF];
#pragma unroll
        for (int u = 0; u < PF; ++u) { const size_t o = (size_t)scan_row(b, d, u) * 512 + h * 64 + lane;
            pw[u] = DEC[o]; pkk[u] = p.RKK[o]; pbb[u] = BB[o]; pk[u] = bf2f(KD[o]); pr[u] = bf2f(p.RR[o]); pv[u] = bf2f(p.RV[o]); }
        for (int s0 = 0; s0 < 2304; s0 += PF) {
#pragma unroll
            for (int u = 0; u < PF; ++u) {
                const int s = s0 + u;
                const float v = pv[u];
                L[lane] = pw[u]; L[64 + lane] = pkk[u]; L[128 + lane] = pbb[u]; L[192 + lane] = pk[u]; L[256 + lane] = pr[u];
                if (s + PF < 2304) { const size_t o = (size_t)scan_row(b, d, s + PF) * 512 + h * 64 + lane;
                    pw[u] = DEC[o]; pkk[u] = p.RKK[o]; pbb[u] = BB[o]; pk[u] = bf2f(KD[o]); pr[u] = bf2f(p.RR[o]); pv[u] = bf2f(p.RV[o]); }
                float sa = 0.f;
#pragma unroll
                for (int j = 0; j < 64; j += 4) { const f32x4 kk = *(const LAS f32x4*)(L + 64 + j); sa += S[j] * kk[0] + S[j + 1] * kk[1] + S[j + 2] * kk[2] + S[j + 3] * kk[3];
                    if ((j & 15) == 12) asm volatile("" : "+v"(sa) :: "memory"); }
                float y = 0.f;
#pragma unroll
                for (int j = 0; j < 64; j += 4) {
                    const f32x4 w = *(const LAS f32x4*)(L + j), bb = *(const LAS f32x4*)(L + 128 + j), kd = *(const LAS f32x4*)(L + 192 + j), rr = *(const LAS f32x4*)(L + 256 + j);
#pragma unroll
                    for (int k = 0; k < 4; ++k) { S[j + k] = S[j + k] * w[k] + (v * kd[k] - sa * bb[k]); y += S[j + k] * rr[k]; }
                    if ((j & 7) == 4) asm volatile("" : "+v"(y) :: "memory");
                }
                YS[(size_t)scan_row(b, d, s) * 512 + h * 64 + lane] = y;
            }
        }
    }
}
__device__ __forceinline__ void ph_rwkv_out(const Params& p, int l) {
    const float* r_k = p.in[27] + l * 512; const float* ln_w = p.in[28] + l * 512; const float* ln_b = p.in[29] + l * 512;
    const int lane = LANE;
    for (int r = GWAVE; r < TT; r += NWAVE) {
        const size_t o = (size_t)r * 512 + 8 * lane;
        float y[8];
        { const f32x4 a0 = *(const f32x4*)(p.YS + o), a1 = *(const f32x4*)(p.YS + o + 4), b0 = *(const f32x4*)(p.YS + (size_t)TT * 512 + o), b1 = *(const f32x4*)(p.YS + (size_t)TT * 512 + o + 4);
          for (int k = 0; k < 4; ++k) { y[k] = a0[k] + b0[k]; y[4 + k] = a1[k] + b1[k]; } }
        float s = 0.f; for (int k = 0; k < 8; ++k) s += y[k]; s = sum8(s); const float mu = s * (1.0f / 64.0f);
        float q = 0.f; for (int k = 0; k < 8; ++k) { const float dlt = y[k] - mu; q += dlt * dlt; } q = sum8(q);
        const float rstd = rsqrtf(q * (1.0f / 64.0f) + 64e-5f);
        float rr[8], kf[8], kb[8], vv[8], gg[8];
        load8(p.RR + o, rr); load8(p.KD + o, kf); load8(p.KD + (size_t)TT * 512 + o, kb); load8(p.RV + o, vv); load8(p.GRW + o, gg);
        float bc = 0.f; for (int k = 0; k < 8; ++k) bc += rr[k] * (kf[k] + kb[k]) * r_k[8 * lane + k]; bc = sum8(bc);
        float out[8];
        for (int k = 0; k < 8; ++k) out[k] = ((y[k] - mu) * rstd * ln_w[8 * lane + k] + ln_b[8 * lane + k] + bc * vv[k]) * gg[k];
        store8(p.Y + (size_t)r * 2048 + 1536 + 8 * lane, out);
    }
}

__device__ __forceinline__ void ph_moe_router(const Params& p, int l, LAS unsigned char* lds) {
    LAS float* wr = (LAS float*)lds;
    const float* wsrc = p.in[32] + (size_t)l * 2048 * 16;
    for (int i = TID; i < 2048 * 16; i += 512) { const int c = i >> 4, e = i & 15; wr[e * 2048 + c] = wsrc[i]; }
    __syncthreads();
    const float* g = p.in[7] + l * 2048;
    const float* modl = p.MOD + (size_t)l * 9 * 12288;
    const int lane = LANE;
    const int nrows = (l == 0) ? TT : T;
    for (int r = GWAVE; r < nrows; r += NWAVE) {
        const float* src = p.XCUR + (size_t)r * 2048;
        f32x4 v[8]; float ss = 0.f;
#pragma unroll
        for (int i = 0; i < 8; ++i) { v[i] = *(const f32x4*)(src + i * 256 + lane * 4); ss += v[i][0] * v[i][0] + v[i][1] * v[i][1] + v[i][2] * v[i][2] + v[i][3] * v[i][3]; }
        ss = wave_sum(ss);
        const float rs = rsqrtf(ss * (1.0f / 2048.0f) + NORM_EPS);
        const float* ms = modl + (size_t)row_s(r) * 12288;
#pragma unroll
        for (int i = 0; i < 8; ++i) {
            const int c = i * 256 + lane * 4;
            const f32x4 gg = *(const f32x4*)(g + c), sh = *(const f32x4*)(ms + 3 * 2048 + c), sc = *(const f32x4*)(ms + 4 * 2048 + c);
            v[i] = v[i] * rs * gg * (1.0f + sc) + sh;
            u32x2 w; w.x = pk2(v[i][0], v[i][1]); w.y = pk2(v[i][2], v[i][3]);
            *(u32x2*)(p.H2 + (size_t)r * 2048 + c) = w;
        }
        float lg = -3.0e38f;
#pragma unroll 1
        for (int e = 0; e < 16; ++e) {
            float a = 0.f;
#pragma unroll
            for (int i = 0; i < 8; ++i) { const f32x4 w4 = *(const LAS f32x4*)(wr + e * 2048 + i * 256 + lane * 4); a += v[i][0] * w4[0] + v[i][1] * w4[1] + v[i][2] * w4[2] + v[i][3] * w4[3]; }
            a = wave_sum(a);
            lg = (lane == e) ? a : lg;
        }
        float mx = lg;
        mx = fmaxf(mx, __shfl_xor(mx, 1)); mx = fmaxf(mx, __shfl_xor(mx, 2)); mx = fmaxf(mx, __shfl_xor(mx, 4)); mx = fmaxf(mx, __shfl_xor(mx, 8));
        const float ex = (lane < 16) ? expf(lg - mx) : 0.f;
        float sum = ex;
        sum += __shfl_xor(sum, 1); sum += __shfl_xor(sum, 2); sum += __shfl_xor(sum, 4); sum += __shfl_xor(sum, 8);
        const float mine = ex / sum;
        if (lane < 16) {
            if (r < T) p.AFFT[((size_t)((r >> 11) * 16 + lane)) * 2048 + (r & 2047)] = mine;
            else p.AFFC[((size_t)(((r - T) >> 8) * 16 + lane)) * 256 + ((r - T) & 255)] = mine;
        }
    }
}
__device__ __forceinline__ void ph_topk(const Params& p, int l, LAS unsigned char* lds) {
    LAS float* a = (LAS float*)lds;
    const int nun = (l == 0) ? 256 : 128;
    for (int u = blockIdx.x; u < nun; u += gridDim.x) {
        const bool isctx = u >= 128; const int be = u & 127, b = be >> 4, e = be & 15;
        const int N = isctx ? 256 : 2048, cap = isctx ? 32 : 256;
        const float* src = isctx ? p.AFFC + (size_t)be * 256 : p.AFFT + (size_t)be * 2048;
        __syncthreads();
        for (int i = TID; i < N; i += 512) a[i] = src[i];
        __syncthreads();
        for (int i = TID; i < N; i += 512) {
            const float ai = a[i]; int rank = 0;
            for (int j = 0; j < N; j += 4) { const f32x4 aj = *(const LAS f32x4*)(a + j);
#pragma unroll
                for (int k = 0; k < 4; ++k) rank += (aj[k] > ai || (aj[k] == ai && (j + k) < i)) ? 1 : 0; }
            const int trow = isctx ? (T + b * 256 + i) : (b * 2048 + i);
            int xrow = -1;
            if (rank < cap) { xrow = isctx ? ((128 + e) * 256 + b * 32 + rank) : ((e * 8 + b) * 256 + rank); p.IDXROW[xrow] = trow; p.GATEV[xrow] = ai; }
            p.SEL[(size_t)trow * 16 + e] = xrow;
        }
    }
}
__device__ __forceinline__ void ph_gather(const Params& p, int l) {
    const int nrows = (l == 0) ? XE_ROWS : 128 * 256; const int lane = LANE;
    for (int r = GWAVE; r < nrows; r += NWAVE) {
        const bf16_t* src = p.H2 + (size_t)p.IDXROW[r] * 2048; bf16_t* dst = p.XE + (size_t)r * 2048;
#pragma unroll
        for (int k = 0; k < 4; ++k) *(u32x4*)(dst + (k * 64 + lane) * 8) = *(const u32x4*)(src + (k * 64 + lane) * 8);
    }
}
__device__ __forceinline__ void ph_combine(const Params& p, int l) {
    const float* modl = p.MOD + (size_t)l * 9 * 12288; const int lane = LANE;
    const int nrows = (l == 0) ? TT : T;
    for (int r = GWAVE; r < nrows; r += NWAVE) {
        const int selv = (lane < 16) ? p.SEL[(size_t)r * 16 + lane] : -1;
        float acc[32];
#pragma unroll
        for (int k = 0; k < 32; ++k) acc[k] = 0.f;
        for (int e = 0; e < 16; ++e) {
            const int xr = __shfl(selv, e);
            if (xr >= 0) {
                const bf16_t* ye = p.YE + (size_t)xr * 2048;
#pragma unroll
                for (int i = 0; i < 4; ++i) { float f[8]; load8(ye + i * 512 + lane * 8, f);
#pragma unroll
                    for (int k = 0; k < 8; ++k) acc[i * 8 + k] += f[k]; }
            }
        }
        const float* g2 = modl + (size_t)row_s(r) * 12288 + 5 * 2048;
        float* xp = p.XCUR + (size_t)r * 2048;
#pragma unroll
        for (int i = 0; i < 4; ++i)
#pragma unroll
            for (int hh = 0; hh < 2; ++hh) {
                const int c = i * 512 + lane * 8 + hh * 4;
                f32x4 x = *(const f32x4*)(xp + c); const f32x4 g = *(const f32x4*)(g2 + c);
#pragma unroll
                for (int k = 0; k < 4; ++k) x[k] += g[k] * acc[i * 8 + hh * 4 + k];
                if (l == DEPTH - 1) *(f32x4*)(p.out + (size_t)r * 2048 + c) = x; else *(f32x4*)(xp + c) = x;
            }
    }
}

enum { PH_ADALN_P = 0, PH_ADALN_R, PH_CONST, PH_CVT_MIX, PH_MODULATE, PH_GEMM_WIN, PH_PREPA, PH_GEMM_LORA, PH_GEMM_FCHAN, PH_GEMM_UQ, PH_GEMM_UKV, PH_PREPB,
       PH_MLA, PH_NA, PH_SCAN, PH_RWKV_OUT, PH_GEMM_FSEQ, PH_GEMM_FSEQC, PH_GEMM_MERGE, PH_GEMM_WOUT, PH_CVT_MOE, PH_ROUTER, PH_TOPK, PH_GATHER, PH_GEMM_MOE1, PH_GEMM_MOE2, PH_COMBINE };

template <int PH> __device__ __forceinline__ void run_phase(const Params& p, int l, LAS unsigned char* lds) {
    const int G = gridDim.x, c = blockIdx.x;
    if constexpr (PH == PH_ADALN_P) ph_adaln_partial(p, lds);
    else if constexpr (PH == PH_ADALN_R) ph_adaln_reduce(p);
    else if constexpr (PH == PH_CONST) ph_const(p);
    else if constexpr (PH == PH_CVT_MIX) ph_cvt_mixer(p, l, lds);
    else if constexpr (PH == PH_MODULATE) ph_modulate(p, l, p.H);
    else if constexpr (PH == PH_GEMM_WIN) {
        pg8::Sched2D S{(const char*)p.H, (const char*)p.WIN_T, 256L * 2048 * 2, 256L * 2048 * 2, 0, TT / 256, ZN / 256, G, c, 0};
        EpiWin E{p.ZS, p.G};
        pg8::gemm_phase(lds, 2048, 2048, 2048, S, E);
    } else if constexpr (PH == PH_PREPA) ph_prepA(p, l);
    else if constexpr (PH == PH_GEMM_LORA) {
        pg8::Sched2D S{(const char*)p.LA, (const char*)p.WLORA_T, 256L * 256 * 2, 256L * 256 * 2, 0, TT / 256, 2560 / 256, G, c, 0};
        EpiLora E{p.in[20] + l * 1024, p.in[22] + l * 1024, p.in[26] + l * 512, p.RK, p.RKK, p.DEC, p.BB, p.KD, p.GRW};
        pg8::gemm_phase(lds, 256, 256, 256, S, E);
    } else if constexpr (PH == PH_GEMM_FCHAN) {
        pg8::Sched2D S{(const char*)p.WFC, (const char*)(p.ZS + 4128), 256L * 512 * 2, 256L * ZW * 2, 0, 1024 / 256, TT / 256, G, c, 0};
        EpiFourChan E{p.XCS, p.XCSC};
        pg8::gemm_phase(lds, 512, 512, ZW, S, E);
    } else if constexpr (PH == PH_GEMM_UQ) {
        pg8::Sched2D S{(const char*)p.CQN, (const char*)p.WUQ_T, 256L * 512 * 2, 256L * 512 * 2, 0, TT / 256, 768 / 256, G, c, 0};
        EpiBf16 E{p.Q0, 768};
        pg8::gemm_phase(lds, 512, 512, 512, S, E);
    } else if constexpr (PH == PH_GEMM_UKV) {
        pg8::Sched2D S{(const char*)p.CKVN, (const char*)p.WUKV_T, 256L * 256 * 2, 256L * 256 * 2, 0, TT / 256, 1024 / 256, G, c, 0};
        EpiBf16 E{p.KV0, 1024};
        pg8::gemm_phase(lds, 256, 256, 256, S, E);
    } else if constexpr (PH == PH_PREPB) ph_prepB(p, l);
    else if constexpr (PH == PH_MLA) ph_mla_naive(p, l, lds);
    else if constexpr (PH == PH_NA) ph_na_naive(p, l, lds);
    else if constexpr (PH == PH_SCAN) ph_scan_naive(p, lds);
    else if constexpr (PH == PH_RWKV_OUT) ph_rwkv_out(p, l);
    else if constexpr (PH == PH_GEMM_FSEQ) {
        pg8::Sched2D S{(const char*)p.ADFT, (const char*)p.XCS, 256L * 4096 * 2, 256L * 4096 * 2, 0, 2048 / 256, 4096 / 256, G, c, 0};
        EpiFourSeq E{p.Y, 0, 2048, 1.0f / 512.0f};
        pg8::gemm_phase(lds, 4096, 4096, 4096, S, E);
    } else if constexpr (PH == PH_GEMM_FSEQC) {
        pg8::Sched2D S{(const char*)p.ADFTC, (const char*)p.XCSC, 256L * 512 * 2, 256L * 512 * 2, 0, 1, 4096 / 256, G, c, 0};
        EpiFourSeq E{p.Y, T, 256, 0.005524271728019903f};
        pg8::gemm_phase(lds, 512, 512, 512, S, E);
    } else if constexpr (PH == PH_GEMM_MERGE) {
        pg8::SchedMerge S{(const char*)p.Y, (const char*)p.WBR_T, TT / 256, 2048 / 256, G, c};
        EpiMerge E{p.G, p.ACC, p.ACCB};
        pg8::gemm_phase(lds, 512, 2048, 512, S, E);
    } else if constexpr (PH == PH_GEMM_WOUT) {
        pg8::Sched2D S{(const char*)p.ACCB, (const char*)p.WOUT_T, 256L * 2048 * 2, 256L * 2048 * 2, 0, TT / 256, 2048 / 256, G, c, 0};
        EpiWout E{p.XCUR, p.MOD + (size_t)l * 9 * 12288};
        pg8::gemm_phase(lds, 2048, 2048, 2048, S, E);
    } else if constexpr (PH == PH_CVT_MOE) ph_cvt_moe(p, l, lds);
    else if constexpr (PH == PH_ROUTER) ph_moe_router(p, l, lds);
    else if constexpr (PH == PH_TOPK) ph_topk(p, l, lds);
    else if constexpr (PH == PH_GATHER) ph_gather(p, l);
    else if constexpr (PH == PH_GEMM_MOE1) {
        pg8::Sched2D S{(const char*)p.XE, (const char*)p.W13T, 256L * 2048 * 2, 256L * 2048 * 2, 2048L * 2048 * 2, (l == 0) ? 144 : 128, 2048 / 256, G, c, 1};
        EpiSwiglu E{p.HH};
        pg8::gemm_phase(lds, 2048, 2048, 2048, S, E);
    } else if constexpr (PH == PH_GEMM_MOE2) {
        pg8::Sched2D S{(const char*)p.HH, (const char*)p.W2T, 256L * 1024 * 2, 256L * 1024 * 2, 2048L * 1024 * 2, (l == 0) ? 144 : 128, 2048 / 256, G, c, 1};
        EpiMoeOut E{p.YE, p.GATEV};
        pg8::gemm_phase(lds, 1024, 1024, 1024, S, E);
    } else if constexpr (PH == PH_COMBINE) ph_combine(p, l);
}

template <int PH> __global__ void __launch_bounds__(512, 2) k_phase(Params p, int l) {
    extern __shared__ __attribute__((aligned(16))) unsigned char shm[];
    run_phase<PH>(p, l, (LAS unsigned char*)shm);
}

constexpr int LDS_BYTES = 147456;
static inline size_t al256(size_t x) { return (x + 255) & ~(size_t)255; }

template <int PH> static void launch(const Params& p, int l, hipStream_t st) {
    static bool attr = false;
    if (!attr) { (void)hipFuncSetAttribute((const void*)k_phase<PH>, hipFuncAttributeMaxDynamicSharedMemorySize, LDS_BYTES); attr = true; }
    hipLaunchKernelGGL((k_phase<PH>), dim3(256), dim3(512), LDS_BYTES, st, p, l);
}

extern "C" void kernel_launch(void* const* d_in, const int* in_sizes, int n_in, void* d_out, int out_size, void* d_ws, size_t ws_size, hipStream_t stream) {
    Params p;
    memset(&p, 0, sizeof(p));
    for (int i = 0; i < 36; ++i) p.in[i] = (const float*)d_in[i];
    p.out = (float*)d_out;
    char* ws = (char*)d_ws; size_t off = 0;
    auto take = [&](size_t bytes) { char* r = ws + off; off = al256(off + bytes); return r; };
    p.bar = (unsigned*)take(16384);
    p.MOD = (float*)take((size_t)2 * 9 * 12288 * 4);
    p.MODP = (float*)take((size_t)16 * 2 * 9 * 12288 * 4);
    p.XCUR = (float*)take((size_t)TT * 2048 * 4);
    p.WIN_T = (bf16_t*)take((size_t)ZN * 2048 * 2);
    p.WBR_T = (bf16_t*)take((size_t)4 * 2048 * 512 * 2);
    p.WOUT_T = (bf16_t*)take((size_t)2048 * 2048 * 2);
    p.WUQ_T = (bf16_t*)take((size_t)768 * 512 * 2);
    p.WUKV_T = (bf16_t*)take((size_t)1024 * 256 * 2);
    p.WLORA_T = (bf16_t*)take((size_t)2560 * 256 * 2);
    p.WFC = (bf16_t*)take((size_t)1024 * 512 * 2);
    p.ADFT = (bf16_t*)take((size_t)2048 * 4096 * 2);
    p.ADFTC = (bf16_t*)take((size_t)256 * 512 * 2);
    const size_t base = off;
    p.Y = (bf16_t*)take((size_t)TT * 2048 * 2); p.H = p.Y;
    p.ZS = (bf16_t*)take((size_t)TT * ZW * 2); p.ACC = (float*)p.ZS;
    p.G = (bf16_t*)take((size_t)TT * GW * 2);
    p.NQ = (bf16_t*)take((size_t)TT * 512 * 2);
    p.NK = (bf16_t*)take((size_t)TT * 512 * 2);
    const size_t scan_base = off;
    p.RKK = (float*)take((size_t)TT * 512 * 4);
    p.DEC = (float*)take((size_t)2 * TT * 512 * 4);
    p.BB = (float*)take((size_t)2 * TT * 512 * 4);
    p.KD = (bf16_t*)take((size_t)2 * TT * 512 * 2);
    p.RV = (bf16_t*)take((size_t)TT * 512 * 2);
    p.RR = (bf16_t*)take((size_t)TT * 512 * 2);
    p.GRW = (bf16_t*)take((size_t)TT * 512 * 2);
    p.YS = (float*)take((size_t)2 * TT * 512 * 4);
    const size_t scan_end = off;
    p.CQN = (bf16_t*)take((size_t)TT * 512 * 2);
    p.CKVN = (bf16_t*)take((size_t)TT * 256 * 2);
    p.LA = (bf16_t*)take((size_t)TT * 256 * 2);
    p.RK = (bf16_t*)take((size_t)TT * 512 * 2);
    p.Q0 = (bf16_t*)take((size_t)TT * 768 * 2);
    p.KV0 = (bf16_t*)take((size_t)TT * 1024 * 2);
    p.MQ = (bf16_t*)take((size_t)TT * 768 * 2);
    p.MK = (bf16_t*)take((size_t)TT * 768 * 2);
    p.XCS = (bf16_t*)take((size_t)4096 * 2 * 2048 * 2);
    p.XCSC = (bf16_t*)take((size_t)4096 * 2 * 256 * 2);
    const size_t mix_end = off;
    p.ACCB = (bf16_t*)(ws + scan_base);
    size_t moff = scan_base + al256((size_t)TT * 2048 * 2);
    p.W13T = (bf16_t*)(ws + moff); moff = al256(moff + (size_t)16 * 2048 * 2048 * 2);
    p.W2T = (bf16_t*)(ws + moff); moff = al256(moff + (size_t)16 * 2048 * 1024 * 2);
    if (moff > scan_end) { fprintf(stderr, "kernel_launch: moe weights overflow scan region (%zu > %zu)\n", moff, scan_end); }
    size_t aoff = base;
    auto atake = [&](size_t bytes) { char* r = ws + aoff; aoff = al256(aoff + bytes); return r; };
    p.H2 = (bf16_t*)atake((size_t)TT * 2048 * 2);
    p.XE = (bf16_t*)atake((size_t)XE_ROWS * 2048 * 2);
    p.HH = (bf16_t*)atake((size_t)XE_ROWS * 1024 * 2);
    p.YE = (bf16_t*)atake((size_t)XE_ROWS * 2048 * 2);
    p.AFFT = (float*)atake((size_t)128 * 2048 * 4);
    p.AFFC = (float*)atake((size_t)128 * 256 * 4);
    p.IDXROW = (int*)atake((size_t)XE_ROWS * 4);
    p.GATEV = (float*)atake((size_t)XE_ROWS * 4);
    p.SEL = (int*)atake((size_t)TT * 16 * 4);
    if (aoff > scan_base) fprintf(stderr, "kernel_launch: moe activations overflow (%zu > %zu)\n", aoff, scan_base);
    if (mix_end > ws_size) { fprintf(stderr, "kernel_launch: workspace too small: need %zu have %zu\n", mix_end, ws_size); return; }

    launch<PH_ADALN_P>(p, 0, stream);
    launch<PH_CONST>(p, 0, stream);
    launch<PH_ADALN_R>(p, 0, stream);
    for (int l = 0; l < DEPTH; ++l) {
        launch<PH_CVT_MIX>(p, l, stream);
        launch<PH_MODULATE>(p, l, stream);
        launch<PH_GEMM_WIN>(p, l, stream);
        launch<PH_PREPA>(p, l, stream);
        launch<PH_GEMM_LORA>(p, l, stream);
        launch<PH_GEMM_FCHAN>(p, l, stream);
        launch<PH_GEMM_UQ>(p, l, stream);
        launch<PH_GEMM_UKV>(p, l, stream);
        launch<PH_PREPB>(p, l, stream);
        launch<PH_MLA>(p, l, stream);
        launch<PH_NA>(p, l, stream);
        launch<PH_SCAN>(p, l, stream);
        launch<PH_RWKV_OUT>(p, l, stream);
        launch<PH_GEMM_FSEQ>(p, l, stream);
        if (l == 0) launch<PH_GEMM_FSEQC>(p, l, stream);
        launch<PH_GEMM_MERGE>(p, l, stream);
        launch<PH_GEMM_WOUT>(p, l, stream);
        launch<PH_CVT_MOE>(p, l, stream);
        launch<PH_ROUTER>(p, l, stream);
        launch<PH_TOPK>(p, l, stream);
        launch<PH_GATHER>(p, l, stream);
        launch<PH_GEMM_MOE1>(p, l, stream);
        launch<PH_GEMM_MOE2>(p, l, stream);
        launch<PH_COMBINE>(p, l, stream);
    }
}
```

```cpp
#include <hip/hip_runtime.h>
#include <stdint.h>
#include <stdio.h>
#include <string.h>

#define LAS __attribute__((address_space(3)))
#define PROBE_DUP 0
typedef unsigned short bf16_t;
typedef short bf16x8 __attribute__((ext_vector_type(8)));
typedef float f32x4 __attribute__((ext_vector_type(4)));
typedef float f32x2 __attribute__((ext_vector_type(2)));
typedef unsigned u32x4 __attribute__((ext_vector_type(4)));
typedef unsigned u32x2 __attribute__((ext_vector_type(2)));

constexpr int NB = 8, SEQ = 2048, DM = 2048, CTXL = 256, DEPTH = 2;
constexpr int T = NB * SEQ, TC = NB * CTXL, TT = T + TC;
constexpr int ZW = 4864;
constexpr int GW = 8192;
constexpr int ZN = ZW + GW;
constexpr int NEXP = 16, EFF = 1024;
constexpr int XE_ROWS = 128 * 256 + 16 * 256;
constexpr float NORM_EPS = 1e-6f;
constexpr int R1B = 640, R2B = 512;

struct Params {
    const float* in[36];
    float* out;
    unsigned* bar;
    float* MOD;
    float* MODP;
    float* XCUR;
    bf16_t* WIN_T;
    bf16_t* WBR_T;
    bf16_t* WOUT_T;
    bf16_t* WUQ_T;
    bf16_t* WUKV_T;
    bf16_t* WLORA_T;
    bf16_t* WFC;
    bf16_t* ADFT;
    bf16_t* ADFTC;
    bf16_t* H;
    bf16_t* Y;
    bf16_t* ZS;
    bf16_t* G;
    bf16_t* NQ;
    bf16_t* NK;
    bf16_t* CQN;
    bf16_t* CKVN;
    bf16_t* LA;
    bf16_t* RK;
    int*    RBP;
    char*   R1;
    char*   R2;
    bf16_t* GRW;
    float*  YS;
    float*  PMAT;
    float*  QMAT;
    float*  SMAT;
    bf16_t* Q0;
    bf16_t* KV0;
    bf16_t* ZB;
    bf16_t* MQ;
    bf16_t* MK;
    bf16_t* MVT;
    bf16_t* NVT;
    bf16_t* XCS;
    bf16_t* XCSC;
    float*  ACC;
    bf16_t* ACCB;
    bf16_t* W13T;
    bf16_t* W2T;
    bf16_t* H2;
    float*  AFFT;
    float*  AFFC;
    int*    IDXROW;
    float*  GATEV;
    int*    SEL;
    bf16_t* XE;
    bf16_t* HH;
    bf16_t* YE;
};

__device__ __forceinline__ float bf2f(bf16_t h) { return __uint_as_float(((unsigned)h) << 16); }
typedef float f32x2_t __attribute__((ext_vector_type(2)));
typedef __bf16 bf16x2_t __attribute__((ext_vector_type(2)));
__device__ __forceinline__ unsigned pk2(float lo, float hi) { const f32x2_t v = {lo, hi}; return __builtin_bit_cast(unsigned, __builtin_convertvector(v, bf16x2_t)); }
__device__ __forceinline__ bf16_t f2bf(float f) { return (bf16_t)(pk2(f, f) & 0xffffu); }
__device__ __forceinline__ void unpack8(u32x4 w, float* v) {
    v[0] = __uint_as_float(w.x << 16); v[1] = __uint_as_float(w.x & 0xffff0000u);
    v[2] = __uint_as_float(w.y << 16); v[3] = __uint_as_float(w.y & 0xffff0000u);
    v[4] = __uint_as_float(w.z << 16); v[5] = __uint_as_float(w.z & 0xffff0000u);
    v[6] = __uint_as_float(w.w << 16); v[7] = __uint_as_float(w.w & 0xffff0000u);
}
__device__ __forceinline__ u32x4 pack8(const float* v) { u32x4 w; w.x = pk2(v[0], v[1]); w.y = pk2(v[2], v[3]); w.z = pk2(v[4], v[5]); w.w = pk2(v[6], v[7]); return w; }
__device__ __forceinline__ void load8(const bf16_t* p, float* v) { unpack8(*(const u32x4*)p, v); }
__device__ __forceinline__ void store8(bf16_t* p, const float* v) { *(u32x4*)p = pack8(v); }
__device__ __forceinline__ float wave_sum(float v) {
#pragma unroll
    for (int o = 32; o; o >>= 1) v += __shfl_xor(v, o);
    return v;
}
__device__ __forceinline__ float wave_max(float v) {
#pragma unroll
    for (int o = 32; o; o >>= 1) v = fmaxf(v, __shfl_xor(v, o));
    return v;
}
__device__ __forceinline__ float sum8(float v) { v += __shfl_xor(v, 1); v += __shfl_xor(v, 2); v += __shfl_xor(v, 4); return v; }
__device__ __forceinline__ float sigmoidf_(float x) { return __builtin_amdgcn_rcpf(1.0f + __expf(-x)); }
__device__ __forceinline__ int opaque_lane() { unsigned m = ~0u; asm volatile("" : "+s"(m)); return (int)__builtin_amdgcn_mbcnt_hi(m, __builtin_amdgcn_mbcnt_lo(m, 0u)); }
__device__ __forceinline__ int row_s(int r) { return r < T ? (r >> 11) : 8; }
__device__ __forceinline__ void row_bpos(int r, int& b, int& pf) { if (r < T) { b = r >> 11; pf = 256 + (r & 2047); } else { b = (r - T) >> 8; pf = (r - T) & 255; } }
__device__ __forceinline__ int pos_rev(int pf) { return pf < 256 ? 255 - pf : 2559 - pf; }

__device__ __forceinline__ u32x4 pack8v(f32x4 a, f32x4 b) { u32x4 w; w.x = pk2(a[0], a[1]); w.y = pk2(a[2], a[3]); w.z = pk2(b[0], b[1]); w.w = pk2(b[2], b[3]); return w; }

namespace pg8 {
constexpr int BM = 256, BK = 64, HALF = 128, HTB = HALF * BK * 2, STAGE_BYTES = 8 * HTB, NXCD = 8, WGM = 8;
__host__ __device__ __forceinline__ int lds_byte(int r, int c) { const int st = (r >> 4) * 2 + (c >> 5), rr = r & 15, cc = c & 31, ob = rr * 64 + cc * 2; return st * 1024 + (ob ^ (((ob >> 9) & 1) << 5)); }
__host__ __device__ __forceinline__ void stage_rc(int b, int& R, int& C) { const int st = b / 1024, sb = b % 1024, swz = sb ^ (((sb >> 9) & 1) << 5); R = (st >> 1) * 16 + swz / 64; C = (st & 1) * 32 + (swz % 64) / 2; }
__host__ __device__ __forceinline__ int perm32(int rho) { const int n = rho >> 4, i = rho & 15; return 8 * (i >> 2) + 4 * n + (i & 3); }

struct Unit { int pm, pn, aux, pad; const char* a; const char* b; };

__device__ __forceinline__ bool tile_of(long L, int nM, int nN, int& pm, int& pn) {
    const int nwg = nM * nN; if (L >= nwg || L < 0) return false;
    int wgid = (int)L; { const int q = nwg / NXCD, r = nwg % NXCD, xcd = wgid % NXCD, off = wgid / NXCD; wgid = (xcd < r ? xcd * (q + 1) : r * (q + 1) + (xcd - r) * q) + off; }
    const int nig = WGM * nN, gid = wgid / nig, fm = gid * WGM, gsz = (nM - fm) < WGM ? (nM - fm) : WGM;
    pm = fm + ((wgid % nig) % gsz); pn = (wgid % nig) / gsz; return true;
}

struct Sched2D {
    const char* A; const char* B; long a_tile, b_tile, b_grp; int nM, nN, G, c, moe;
    int nMb = 0, nNb = 0, pm0b = 0;
    __device__ __forceinline__ bool next(int i, Unit& u) const {
        int pm, pn; const long L = (long)i * G + c; const int n1 = nM * nN;
        if (L < n1) { if (!tile_of(L, nM, nN, pm, pn)) return false; }
        else { if (!tile_of(L - n1, nMb, nNb, pm, pn)) return false; pm += pm0b; }
        u.pm = pm; u.pn = pn; u.aux = 0; u.pad = 0;
        u.a = A + (long)pm * a_tile;
        const int e = moe ? (pm < 128 ? (pm >> 3) : (pm - 128)) : 0;
        u.b = B + (long)pn * b_tile + (long)e * b_grp;
        return true;
    }
};
struct SchedMerge {
    const char* A; const char* B; int nM, nN, G, c;
    __device__ __forceinline__ bool next(int i, Unit& u) const {
        int pm, pn; if (!tile_of((long)(i >> 2) * G + c, nM, nN, pm, pn)) return false;
        const int br = i & 3;
        u.pm = pm; u.pn = pn; u.aux = br; u.pad = 0;
        u.a = A + ((long)pm * 256 * 2048 + br * 512) * 2;
        u.b = B + ((long)br * 2048 * 512 + (long)pn * 256 * 512) * 2;
        return true;
    }
};

template <class Epi, class Sched, bool GATHER = false>
__device__ __forceinline__ void gemm_phase(const int wid0, LAS unsigned char* lds, const int K, const int lda, const int ldb, const Sched& S, const Epi& E, const int* gidx = nullptr) {
    int tid = (wid0 << 6) | opaque_lane(); asm volatile("" : "+v"(tid));
    const int wid = __builtin_amdgcn_readfirstlane(tid >> 6), lane = tid & 63, wr = wid >> 2, wc = wid & 3, fr = lane & 15, fq = lane >> 4;
    const int nt = K / BK;
    unsigned voffA[2], voffB[2]; int gR[2], gC[2];
#pragma unroll
    for (int i = 0; i < 2; ++i) { int R, C; stage_rc(tid * 16 + i * 8192, R, C); const int Rb = Epi::PERM ? ((R & ~31) + perm32(R & 31)) : R;
        voffA[i] = (unsigned)(R * lda + C) * 2u; voffB[i] = (unsigned)(Rb * ldb + C) * 2u; gR[i] = R; gC[i] = C; }
    unsigned vA0c[2] = {0u, 0u}, vA1c[2] = {0u, 0u}, vA0n[2] = {0u, 0u}, vA1n[2] = {0u, 0u};
#define PG8_GIDX(dst0, dst1, pm_) do { _Pragma("unroll") for (int _i = 0; _i < 2; ++_i) { dst0[_i] = (unsigned)(gidx[(pm_) * 256 + gR[_i]] * lda + gC[_i]) * 2u; dst1[_i] = (unsigned)(gidx[(pm_) * 256 + 128 + gR[_i]] * lda + gC[_i]) * 2u; } } while (0)
    const size_t kstep = (size_t)(BK * 2);
    const size_t hstepA = (size_t)HALF * lda * 2, hstepB = (size_t)HALF * ldb * 2;
    const unsigned ldsw = (unsigned)wid * 1024u;
    const int aoff = lds_byte(wr * 64 + fr, fq * 8), boff = lds_byte(wc * 32 + fr, fq * 8);
#define PG8_SA(b, h) (((b) * 2 + (h)) * HTB)
#define PG8_SB(b, h) ((4 + (b) * 2 + (h)) * HTB)
#define PG8_STAGE(bufoff, gbase, voff) do { _Pragma("unroll") for (int _i = 0; _i < 2; ++_i) \
        __builtin_amdgcn_global_load_lds((const unsigned*)((const char*)(gbase) + (voff)[_i]), (LAS unsigned*)(lds + (bufoff) + ldsw + _i * 8192), 16, 0, 0); } while (0)
#define PG8_LDA(dst, b, h) do { _Pragma("unroll") for (int m = 0; m < 4; ++m) _Pragma("unroll") for (int k = 0; k < 2; ++k) dst[m][k] = *(const LAS bf16x8*)(lds + PG8_SA(b, h) + aoff + m * 2048 + k * 1024); } while (0)
#define PG8_LDB(dst, b, h) do { _Pragma("unroll") for (int n = 0; n < 2; ++n) _Pragma("unroll") for (int k = 0; k < 2; ++k) dst[n][k] = *(const LAS bf16x8*)(lds + PG8_SB(b, h) + boff + n * 2048 + k * 1024); } while (0)
#define PG8_MMA(ai, bj, At, Bt) do { __builtin_amdgcn_s_setprio(1); _Pragma("unroll") for (int m = 0; m < 4; ++m) _Pragma("unroll") for (int n = 0; n < 2; ++n) _Pragma("unroll") for (int k = 0; k < 2; ++k) \
        acc[ai][bj][m][n] = __builtin_amdgcn_mfma_f32_16x16x32_bf16(Bt[n][k], At[m][k], acc[ai][bj][m][n], 0, 0, 0); __builtin_amdgcn_s_setprio(0); } while (0)
#define PG8_WAIT_V(n) asm volatile("s_waitcnt vmcnt(" #n ")" ::: "memory")
#define PG8_WAIT_L(n) asm volatile("s_waitcnt lgkmcnt(" #n ")" ::: "memory")
#define PG8_BAR __builtin_amdgcn_s_barrier()
#define PG8_SCHED __builtin_amdgcn_sched_barrier(0)
    Unit cur, nxt; int ui = 0;
    if (!S.next(0, cur)) return;
    f32x4 acc[2][2][4][2];
#pragma unroll
    for (int a = 0; a < 2; ++a)
#pragma unroll
        for (int b = 0; b < 2; ++b)
#pragma unroll
            for (int m = 0; m < 4; ++m)
#pragma unroll
                for (int n = 0; n < 2; ++n) acc[a][b][m][n] = (f32x4){0.f, 0.f, 0.f, 0.f};
    bf16x8 At[4][2], B0[2][2], B1[2][2];
    const char* cA = cur.a; const char* cB = cur.b;
    if constexpr (GATHER) { PG8_GIDX(vA0c, vA1c, cur.pm); }
    const size_t hA = GATHER ? (size_t)0 : hstepA;
#define PG8_STAGEA(bufoff, gbase, h_, nx_) do { _Pragma("unroll") for (int _i = 0; _i < 2; ++_i) { \
        const unsigned _o = !GATHER ? voffA[_i] : ((h_) ? ((nx_) ? vA1n[_i] : vA1c[_i]) : ((nx_) ? vA0n[_i] : vA0c[_i])); \
        __builtin_amdgcn_global_load_lds((const unsigned*)((const char*)(gbase) + _o), (LAS unsigned*)(lds + (bufoff) + ldsw + _i * 8192), 16, 0, 0); } } while (0)
    PG8_STAGE(PG8_SB(0, 0), cB, voffB); PG8_STAGEA(PG8_SA(0, 0), cA, 0, false); PG8_STAGE(PG8_SB(0, 1), cB + hstepB, voffB); PG8_STAGEA(PG8_SA(0, 1), cA + hA, 1, false);
    if (wr == 1) PG8_BAR;
    PG8_WAIT_V(4); PG8_BAR;
    PG8_STAGE(PG8_SB(1, 0), cB + kstep, voffB); PG8_STAGEA(PG8_SA(1, 0), cA + kstep, 0, false); PG8_STAGE(PG8_SB(1, 1), cB + hstepB + kstep, voffB);
    PG8_WAIT_V(6); PG8_BAR;
    for (;;) {
        const bool has_next = S.next(ui + 1, nxt);
        const char* nA = has_next ? nxt.a : cA; const char* nB = has_next ? nxt.b : cB;
        if constexpr (GATHER) { if (has_next) { PG8_GIDX(vA0n, vA1n, nxt.pm); } else { vA0n[0] = vA0c[0]; vA0n[1] = vA0c[1]; vA1n[0] = vA1c[0]; vA1n[1] = vA1c[1]; } }
        for (int t = 0; t < nt; t += 2) {
            const bool last = (t == nt - 2);
            const char* a1 = cA + (size_t)(t + 1) * kstep;
            const char* a2 = last ? nA : cA + (size_t)(t + 2) * kstep; const char* b2 = last ? nB : cB + (size_t)(t + 2) * kstep;
            const char* a3 = a2 + kstep; const char* b3 = b2 + kstep;
            PG8_LDB(B0, 0, 0); PG8_SCHED; PG8_LDA(At, 0, 0); PG8_STAGEA(PG8_SA(1, 1), a1 + hA, 1, false);
            PG8_WAIT_L(8); PG8_BAR; PG8_WAIT_L(0); PG8_MMA(0, 0, At, B0); PG8_BAR; PG8_SCHED;
            PG8_LDB(B1, 0, 1); PG8_STAGE(PG8_SB(0, 0), b2, voffB);
            PG8_BAR; PG8_WAIT_L(0); PG8_MMA(0, 1, At, B1); PG8_BAR;
            PG8_LDA(At, 0, 1); PG8_STAGEA(PG8_SA(0, 0), a2, 0, last);
            PG8_BAR; PG8_WAIT_L(0); PG8_MMA(1, 0, At, B0); PG8_BAR; PG8_SCHED;
            PG8_STAGE(PG8_SB(0, 1), b2 + hstepB, voffB);
            PG8_WAIT_V(6); PG8_BAR; PG8_MMA(1, 1, At, B1); PG8_BAR;
            PG8_LDB(B0, 1, 0); PG8_SCHED; PG8_LDA(At, 1, 0); PG8_STAGEA(PG8_SA(0, 1), a2 + hA, 1, last);
            PG8_WAIT_L(8); PG8_BAR; PG8_WAIT_L(0); PG8_MMA(0, 0, At, B0); PG8_BAR; PG8_SCHED;
            PG8_LDB(B1, 1, 1); PG8_STAGE(PG8_SB(1, 0), b3, voffB);
            PG8_BAR; PG8_WAIT_L(0); PG8_MMA(0, 1, At, B1); PG8_BAR;
            PG8_LDA(At, 1, 1); PG8_STAGEA(PG8_SA(1, 0), a3, 0, last);
            PG8_BAR; PG8_WAIT_L(0); PG8_MMA(1, 0, At, B0); PG8_BAR; PG8_SCHED;
            PG8_STAGE(PG8_SB(1, 1), b3 + hstepB, voffB);
            PG8_WAIT_V(6); PG8_BAR; PG8_MMA(1, 1, At, B1); PG8_BAR;
        }
        E(acc, cur, wr, wc, fr, fq);
        if (!has_next) break;
#pragma unroll
        for (int a = 0; a < 2; ++a)
#pragma unroll
            for (int b = 0; b < 2; ++b)
#pragma unroll
                for (int m = 0; m < 4; ++m)
#pragma unroll
                    for (int n = 0; n < 2; ++n) acc[a][b][m][n] = (f32x4){0.f, 0.f, 0.f, 0.f};
        cur = nxt; cA = nA; cB = nB; ++ui;
        if constexpr (GATHER) { vA0c[0] = vA0n[0]; vA0c[1] = vA0n[1]; vA1c[0] = vA1n[0]; vA1c[1] = vA1n[1]; }
    }
    PG8_WAIT_V(0);
    if (wr == 0) PG8_BAR;
    PG8_BAR;
#undef PG8_GIDX
#undef PG8_STAGEA
#undef PG8_SA
#undef PG8_SB
#undef PG8_STAGE
#undef PG8_LDA
#undef PG8_LDB
#undef PG8_MMA
#undef PG8_WAIT_V
#undef PG8_WAIT_L
#undef PG8_BAR
#undef PG8_SCHED
}


struct SchedRects {
    const char* A; const char* B; long a_tile, b_tile; int G, c;
    int r[3][4];
    __device__ __forceinline__ bool next(int i, Unit& u) const {
        long L = (long)i * G + c; int pm = 0, pn = 0; bool ok = false;
#pragma unroll
        for (int k = 0; k < 3; ++k) { const int n = r[k][1] * r[k][3]; if (!ok) { if (L < n) { ok = tile_of(L, r[k][1], r[k][3], pm, pn); pm += r[k][0]; pn += r[k][2]; } else L -= n; } }
        if (!ok) return false;
        u.pm = pm; u.pn = pn; u.aux = 0; u.pad = 0; u.a = A + (long)pm * a_tile; u.b = B + (long)pn * b_tile; return true;
    }
};
__device__ __forceinline__ void gemm_merge(const int wid0, LAS unsigned char* lds, const bf16_t* Y, const bf16_t* WBR, const bf16_t* G, bf16_t* ACCB, int nM, int Gn, int c) {
    int tid = (wid0 << 6) | opaque_lane(); asm volatile("" : "+v"(tid));
    const int wid = __builtin_amdgcn_readfirstlane(tid >> 6), lane = tid & 63, wr = wid >> 2, wc = wid & 3, fr = lane & 15, fq = lane >> 4;
    constexpr int K = 2048, lda = 2048, ldb = 2048, nt = K / BK, nN = 8;
    unsigned voffA[2], voffB[2];
#pragma unroll
    for (int i = 0; i < 2; ++i) { int R, C; stage_rc(tid * 16 + i * 8192, R, C); const int Rb = (R & ~31) + perm32(R & 31);
        voffA[i] = (unsigned)(R * lda + C) * 2u; voffB[i] = (unsigned)(Rb * ldb + C) * 2u; }
    const size_t kstep = (size_t)(BK * 2);
    const size_t hstepA = (size_t)HALF * lda * 2, hstepB = (size_t)HALF * ldb * 2;
    const unsigned ldsw = (unsigned)wid * 1024u;
    const int aoff = lds_byte(wr * 64 + fr, fq * 8), boff = lds_byte(wc * 32 + fr, fq * 8);
#define PG8_SA(b, h) (((b) * 2 + (h)) * HTB)
#define PG8_SB(b, h) ((4 + (b) * 2 + (h)) * HTB)
#define PG8_STAGE(bufoff, gbase, voff) do { _Pragma("unroll") for (int _i = 0; _i < 2; ++_i) \
        __builtin_amdgcn_global_load_lds((const unsigned*)((const char*)(gbase) + (voff)[_i]), (LAS unsigned*)(lds + (bufoff) + ldsw + _i * 8192), 16, 0, 0); } while (0)
#define PG8_LDA(dst, b, h) do { _Pragma("unroll") for (int m = 0; m < 4; ++m) _Pragma("unroll") for (int k = 0; k < 2; ++k) dst[m][k] = *(const LAS bf16x8*)(lds + PG8_SA(b, h) + aoff + m * 2048 + k * 1024); } while (0)
#define PG8_LDB(dst, b, h) do { _Pragma("unroll") for (int n = 0; n < 2; ++n) _Pragma("unroll") for (int k = 0; k < 2; ++k) dst[n][k] = *(const LAS bf16x8*)(lds + PG8_SB(b, h) + boff + n * 2048 + k * 1024); } while (0)
#define PG8_MMA(ai, bj, At, Bt) do { __builtin_amdgcn_s_setprio(1); _Pragma("unroll") for (int m = 0; m < 4; ++m) _Pragma("unroll") for (int n = 0; n < 2; ++n) _Pragma("unroll") for (int k = 0; k < 2; ++k) \
        acc[ai][bj][m][n] = __builtin_amdgcn_mfma_f32_16x16x32_bf16(Bt[n][k], At[m][k], acc[ai][bj][m][n], 0, 0, 0); __builtin_amdgcn_s_setprio(0); } while (0)
#define PG8_WAIT_V(n) asm volatile("s_waitcnt vmcnt(" #n ")" ::: "memory")
#define PG8_WAIT_L(n) asm volatile("s_waitcnt lgkmcnt(" #n ")" ::: "memory")
#define PG8_BAR __builtin_amdgcn_s_barrier()
#define PG8_SCHED __builtin_amdgcn_sched_barrier(0)
    int ui = 0, pm, pn;
    if (!tile_of((long)c, nM, nN, pm, pn)) return;
    f32x4 acc[2][2][4][2];
#pragma unroll
    for (int a = 0; a < 2; ++a)
#pragma unroll
        for (int b = 0; b < 2; ++b)
#pragma unroll
            for (int m = 0; m < 4; ++m)
#pragma unroll
                for (int n = 0; n < 2; ++n) acc[a][b][m][n] = (f32x4){0.f, 0.f, 0.f, 0.f};
    bf16x8 At[4][2], B0[2][2], B1[2][2];
    const char* cA = (const char*)Y + (size_t)pm * 256 * lda * 2; const char* cB = (const char*)WBR + (size_t)pn * 256 * ldb * 2;
    PG8_STAGE(PG8_SB(0, 0), cB, voffB); PG8_STAGE(PG8_SA(0, 0), cA, voffA); PG8_STAGE(PG8_SB(0, 1), cB + hstepB, voffB); PG8_STAGE(PG8_SA(0, 1), cA + hstepA, voffA);
    if (wr == 1) PG8_BAR;
    PG8_WAIT_V(4); PG8_BAR;
    PG8_STAGE(PG8_SB(1, 0), cB + kstep, voffB); PG8_STAGE(PG8_SA(1, 0), cA + kstep, voffA); PG8_STAGE(PG8_SB(1, 1), cB + hstepB + kstep, voffB);
    PG8_WAIT_V(6); PG8_BAR;
    for (;;) {
        int npm, npn; const bool has_next = tile_of((long)(ui + 1) * Gn + c, nM, nN, npm, npn);
        const char* nA = has_next ? (const char*)Y + (size_t)npm * 256 * lda * 2 : cA; const char* nB = has_next ? (const char*)WBR + (size_t)npn * 256 * ldb * 2 : cB;
        const int row0 = pm * 256 + wr * 64 + fr, col0 = pn * 256 + wc * 32 + 8 * fq;
        for (int t = 0; t < nt; t += 2) {
            if (t != 0 && (t & 7) == 0) {
                const int br = (t >> 3) - 1;
#pragma unroll
                for (int ai = 0; ai < 2; ++ai)
#pragma unroll
                    for (int m = 0; m < 4; ++m)
#pragma unroll
                        for (int bj = 0; bj < 2; ++bj) {
                            const bf16_t* gp = G + (size_t)(row0 + ai * 128 + m * 16) * GW + br * 2048 + col0 + bj * 128;
                            float g0[8], g1[8]; load8(gp, g0); load8(gp + 2048, g1);
#pragma unroll
                            for (int k = 0; k < 4; ++k) { acc[ai][bj][m][0][k] *= g0[k] * __builtin_amdgcn_rcpf(fmaxf(g1[k], 1e-30f)); acc[ai][bj][m][1][k] *= g0[4 + k] * __builtin_amdgcn_rcpf(fmaxf(g1[4 + k], 1e-30f)); }
                        }
            }
            const bool last = (t == nt - 2);
            const char* a1 = cA + (size_t)(t + 1) * kstep;
            const char* a2 = last ? nA : cA + (size_t)(t + 2) * kstep; const char* b2 = last ? nB : cB + (size_t)(t + 2) * kstep;
            const char* a3 = a2 + kstep; const char* b3 = b2 + kstep;
            PG8_LDB(B0, 0, 0); PG8_SCHED; PG8_LDA(At, 0, 0); PG8_STAGE(PG8_SA(1, 1), a1 + hstepA, voffA);
            PG8_WAIT_L(8); PG8_BAR; PG8_WAIT_L(0); PG8_MMA(0, 0, At, B0); PG8_BAR; PG8_SCHED;
            PG8_LDB(B1, 0, 1); PG8_STAGE(PG8_SB(0, 0), b2, voffB);
            PG8_BAR; PG8_WAIT_L(0); PG8_MMA(0, 1, At, B1); PG8_BAR;
            PG8_LDA(At, 0, 1); PG8_STAGE(PG8_SA(0, 0), a2, voffA);
            PG8_BAR; PG8_WAIT_L(0); PG8_MMA(1, 0, At, B0); PG8_BAR; PG8_SCHED;
            PG8_STAGE(PG8_SB(0, 1), b2 + hstepB, voffB);
            PG8_WAIT_V(6); PG8_BAR; PG8_MMA(1, 1, At, B1); PG8_BAR;
            PG8_LDB(B0, 1, 0); PG8_SCHED; PG8_LDA(At, 1, 0); PG8_STAGE(PG8_SA(0, 1), a2 + hstepA, voffA);
            PG8_WAIT_L(8); PG8_BAR; PG8_WAIT_L(0); PG8_MMA(0, 0, At, B0); PG8_BAR; PG8_SCHED;
            PG8_LDB(B1, 1, 1); PG8_STAGE(PG8_SB(1, 0), b3, voffB);
            PG8_BAR; PG8_WAIT_L(0); PG8_MMA(0, 1, At, B1); PG8_BAR;
            PG8_LDA(At, 1, 1); PG8_STAGE(PG8_SA(1, 0), a3, voffA);
            PG8_BAR; PG8_WAIT_L(0); PG8_MMA(1, 0, At, B0); PG8_BAR; PG8_SCHED;
            PG8_STAGE(PG8_SB(1, 1), b3 + hstepB, voffB);
            PG8_WAIT_V(6); PG8_BAR; PG8_MMA(1, 1, At, B1); PG8_BAR;
        }
#pragma unroll
        for (int ai = 0; ai < 2; ++ai)
#pragma unroll
            for (int m = 0; m < 4; ++m)
#pragma unroll
                for (int bj = 0; bj < 2; ++bj) {
                    const int row = row0 + ai * 128 + m * 16, col = col0 + bj * 128;
                    float g[8]; load8(G + (size_t)row * GW + 3 * 2048 + col, g);
                    f32x4 o0, o1;
#pragma unroll
                    for (int k = 0; k < 4; ++k) { o0[k] = acc[ai][bj][m][0][k] * g[k]; o1[k] = acc[ai][bj][m][1][k] * g[4 + k]; }
                    *(u32x4*)(ACCB + (size_t)row * 2048 + col) = pack8v(o0, o1);
                    acc[ai][bj][m][0] = (f32x4){0.f, 0.f, 0.f, 0.f}; acc[ai][bj][m][1] = (f32x4){0.f, 0.f, 0.f, 0.f};
                }
        if (!has_next) break;
        pm = npm; pn = npn; cA = nA; cB = nB; ++ui;
    }
    PG8_WAIT_V(0);
    if (wr == 0) PG8_BAR;
    PG8_BAR;
#undef PG8_SA
#undef PG8_SB
#undef PG8_STAGE
#undef PG8_LDA
#undef PG8_LDB
#undef PG8_MMA
#undef PG8_WAIT_V
#undef PG8_WAIT_L
#undef PG8_BAR
#undef PG8_SCHED
}

template <class F> __device__ __forceinline__ void walk8(const f32x4 (&acc)[2][2][4][2], const Unit& u, int wr, int wc, int fr, int fq, F f) {
    const int row0 = u.pm * BM + wr * 64 + fr, col0 = u.pn * BM + wc * 32 + 8 * fq;
#pragma unroll
    for (int ai = 0; ai < 2; ++ai)
#pragma unroll
        for (int m = 0; m < 4; ++m)
#pragma unroll
            for (int bj = 0; bj < 2; ++bj) f(row0 + ai * HALF + m * 16, col0 + bj * HALF, acc[ai][bj][m][0], acc[ai][bj][m][1]);
}
template <class F> __device__ __forceinline__ void walk4(const f32x4 (&acc)[2][2][4][2], const Unit& u, int wr, int wc, int fr, int fq, F f) {
    const int row0 = u.pm * BM + wr * 64 + fr, col0 = u.pn * BM + wc * 32 + 4 * fq;
#pragma unroll
    for (int ai = 0; ai < 2; ++ai)
#pragma unroll
        for (int m = 0; m < 4; ++m)
#pragma unroll
            for (int bj = 0; bj < 2; ++bj)
#pragma unroll
                for (int n = 0; n < 2; ++n) f(row0 + ai * HALF + m * 16, col0 + bj * HALF + n * 16, acc[ai][bj][m][n]);
}
}
using pg8::Unit;
typedef f32x4 AccT[2][2][4][2];


struct EpiWin {
    static constexpr bool PERM = true;
    bf16_t* ZS; bf16_t* G;
    __device__ __forceinline__ void operator()(const AccT& acc, const Unit& u, int wr, int wc, int fr, int fq) const {
        if (u.pn < 19) {
            bf16_t* z = ZS;
            pg8::walk8(acc, u, wr, wc, fr, fq, [&](int row, int col, f32x4 a, f32x4 b) { *(u32x4*)(z + (size_t)row * ZW + col) = pack8v(a, b); });
        } else {
            bf16_t* g = G;
            pg8::walk8(acc, u, wr, wc, fr, fq, [&](int row, int col, f32x4 a, f32x4 b) {
#pragma unroll
                for (int k = 0; k < 4; ++k) { a[k] = sigmoidf_(a[k]); b[k] = sigmoidf_(b[k]); }
                *(u32x4*)(g + (size_t)row * GW + (col - ZW)) = pack8v(a, b); });
        }
    }
};
struct EpiBf16 {
    static constexpr bool PERM = true;
    bf16_t* O; int ldo;
    __device__ __forceinline__ void operator()(const AccT& acc, const Unit& u, int wr, int wc, int fr, int fq) const {
        bf16_t* o = O; const int ld = ldo;
        pg8::walk8(acc, u, wr, wc, fr, fq, [&](int row, int col, f32x4 a, f32x4 b) { *(u32x4*)(o + (size_t)row * ld + col) = pack8v(a, b); });
    }
};
struct EpiLora {
    static constexpr bool PERM = false;
    const float* w0; const float* a0; const float* k_a;
    const bf16_t* RK; const char* R1; char* R2; bf16_t* GRW; const int* RBP;
    __device__ __forceinline__ void operator()(const AccT& acc, const Unit& u, int wr, int wc, int fr, int fq) const {
        const int seg = u.pn >> 1;
        const int row0 = u.pm * 256 + wr * 64 + fr, col0 = u.pn * 256 + wc * 32 + 4 * fq;
        if (seg == 4) {
#pragma unroll
            for (int ai = 0; ai < 2; ++ai)
#pragma unroll
                for (int m = 0; m < 4; ++m)
#pragma unroll
                    for (int bj = 0; bj < 2; ++bj)
#pragma unroll
                        for (int n = 0; n < 2; ++n) { const f32x4 v = acc[ai][bj][m][n]; const int row = row0 + ai * 128 + m * 16, c = (col0 + bj * 128 + n * 16) & 511;
                            u32x2 w; w.x = pk2(v[0], v[1]); w.y = pk2(v[2], v[3]); *(u32x2*)(GRW + (size_t)row * 512 + c) = w; }
            return;
        }
        const int d = seg & 1;
        int rb1[8], rbd[8];
#pragma unroll
        for (int i = 0; i < 8; ++i) { const int row = row0 + (i >> 2) * 128 + (i & 3) * 16; rb1[i] = RBP[row * 4]; rbd[i] = RBP[row * 4 + 1 + d]; }
        if (seg < 2) {
#pragma unroll
            for (int j = 0; j < 4; ++j) {
                const int c = (col0 + (j >> 1) * 128 + (j & 1) * 16) & 511, hd = c >> 6, c64 = c & 63;
                const f32x4 cw = *(const f32x4*)(w0 + d * 512 + c);
#pragma unroll
                for (int i = 0; i < 8; ++i) {
                    const f32x4 v = acc[i >> 2][j >> 1][i & 3][j & 1]; f32x4 r;
#pragma unroll
                    for (int k = 0; k < 4; ++k) { const float w = cw[k] + v[k]; r[k] = __expf(-0.6065306597126334f * sigmoidf_(w)); }
                    *(f32x4*)(R2 + (size_t)(rbd[i] + (hd * 2 + d) * 2304) * R2B + c64 * 4) = r;
                }
            }
        } else {
#pragma unroll
            for (int j = 0; j < 4; ++j) {
                const int c = (col0 + (j >> 1) * 128 + (j & 1) * 16) & 511, hd = c >> 6, c64 = c & 63;
                const f32x4 cw = *(const f32x4*)(a0 + d * 512 + c), ck = *(const f32x4*)(k_a + c);
#pragma unroll
                for (int ih = 0; ih < 2; ++ih) {
                    f32x4 kk[4]; u32x2 kw[4];
#pragma unroll
                    for (int ii = 0; ii < 4; ++ii) { const int i = ih * 4 + ii; const int row = row0 + (i >> 2) * 128 + (i & 3) * 16; kk[ii] = *(const f32x4*)(R1 + (size_t)(rb1[i] + hd * 2304) * R1B + c64 * 4); kw[ii] = *(const u32x2*)(RK + (size_t)row * 512 + c); }
#pragma unroll
                    for (int ii = 0; ii < 4; ++ii) {
                        const int i = ih * 4 + ii;
                        const f32x4 v = acc[i >> 2][j >> 1][i & 3][j & 1];
                        const float kf[4] = { __uint_as_float(kw[ii].x << 16), __uint_as_float(kw[ii].x & 0xffff0000u), __uint_as_float(kw[ii].y << 16), __uint_as_float(kw[ii].y & 0xffff0000u) };
                        f32x4 bb, kd;
#pragma unroll
                        for (int k = 0; k < 4; ++k) { const float a = sigmoidf_(cw[k] + v[k]); kd[k] = kf[k] * (1.0f + (a - 1.0f) * ck[k]); bb[k] = -(kk[ii][k] * a); }
                        char* rec = R2 + (size_t)(rbd[i] + (hd * 2 + d) * 2304) * R2B + c64 * 2;
                        { u32x2 wb; wb.x = pk2(bb[0], bb[1]); wb.y = pk2(bb[2], bb[3]); *(u32x2*)(rec + 256) = wb; u32x2 wk; wk.x = pk2(kd[0], kd[1]); wk.y = pk2(kd[2], kd[3]); *(u32x2*)(rec + 384) = wk; }
                    }
                }
            }
        }
    }
};
struct EpiFourChan {
    static constexpr bool PERM = true;
    bf16_t* XCS; bf16_t* XCSC;
    __device__ __forceinline__ void operator()(const AccT& acc, const Unit& u, int wr, int wc, int fr, int fq) const {
        pg8::walk8(acc, u, wr, wc, fr, fq, [&](int row, int col, f32x4 a, f32x4 b) {
            const int gc = row >> 1, cs = row & 1;
            if (col < T) { const int bb = col >> 11, n = col & 2047; *(u32x4*)(XCS + ((size_t)((bb * 512 + gc) * 2 + cs)) * 2048 + n) = pack8v(a, b); }
            else { const int cc = col - T, bb = cc >> 8, n = cc & 255; *(u32x4*)(XCSC + ((size_t)((bb * 512 + gc) * 2 + cs)) * 256 + n) = pack8v(a, b); }
        });
    }
};
struct EpiFourSeq {
    static constexpr bool PERM = true;
    bf16_t* Y; int rowbase, seqlen; float scale;
    __device__ __forceinline__ void operator()(const AccT& acc, const Unit& u, int wr, int wc, int fr, int fq) const {
        pg8::walk8(acc, u, wr, wc, fr, fq, [&](int row, int col, f32x4 a, f32x4 b) {
            const int bb = col >> 9, ch = col & 511;
            a *= scale; b *= scale;
            *(u32x4*)(Y + (size_t)(rowbase + bb * seqlen + row) * 2048 + ch) = pack8v(a, b);
        });
    }
};
struct EpiMerge {
    static constexpr bool PERM = true;
    const bf16_t* G; float* ACC; bf16_t* ACCB;
    __device__ __forceinline__ void operator()(const AccT& acc, const Unit& u, int wr, int wc, int fr, int fq) const {
        const int br = u.aux;
        pg8::walk8(acc, u, wr, wc, fr, fq, [&](int row, int col, f32x4 a, f32x4 b) {
            float g[8]; load8(G + (size_t)row * GW + br * 2048 + col, g);
            float* ap = ACC + (size_t)row * 2048 + col;
            f32x4 t0 = {0.f, 0.f, 0.f, 0.f}, t1 = {0.f, 0.f, 0.f, 0.f};
            if (br > 0) { t0 = *(const f32x4*)ap; t1 = *(const f32x4*)(ap + 4); }
#pragma unroll
            for (int k = 0; k < 4; ++k) { t0[k] += g[k] * a[k]; t1[k] += g[4 + k] * b[k]; }
            if (br < 3) { *(f32x4*)ap = t0; *(f32x4*)(ap + 4) = t1; }
            else *(u32x4*)(ACCB + (size_t)row * 2048 + col) = pack8v(t0, t1);
        });
    }
};
struct EpiWout {
    static constexpr bool PERM = false;
    float* X; const float* MODL;
    const float* Xlat; const float* Xctx;
    __device__ __forceinline__ void operator()(const AccT& acc, const Unit& u, int wr, int wc, int fr, int fq) const {
        const int row0 = u.pm * 256 + wr * 64 + fr, col0 = u.pn * 256 + wc * 32 + 4 * fq;
        const float* XS = (u.pm < T / 256) ? Xlat : Xctx;
        const float* gp = MODL + (size_t)row_s(u.pm * 256) * 12288 + 2 * 2048 + col0;
        f32x4 g[4];
#pragma unroll
        for (int j = 0; j < 4; ++j) g[j] = *(const f32x4*)(gp + (j >> 1) * 128 + (j & 1) * 16);
#pragma unroll
        for (int h2 = 0; h2 < 2; ++h2) {
            f32x4 xv[4][4];
#pragma unroll
            for (int ii = 0; ii < 4; ++ii) { const int i = h2 * 4 + ii; const float* xp = XS + (size_t)(row0 + (i >> 2) * 128 + (i & 3) * 16) * 2048 + col0;
#pragma unroll
                for (int j = 0; j < 4; ++j) xv[ii][j] = *(const f32x4*)(xp + (j >> 1) * 128 + (j & 1) * 16); }
#pragma unroll
            for (int ii = 0; ii < 4; ++ii) { const int i = h2 * 4 + ii; float* xp = X + (size_t)(row0 + (i >> 2) * 128 + (i & 3) * 16) * 2048 + col0;
#pragma unroll
                for (int j = 0; j < 4; ++j) *(f32x4*)(xp + (j >> 1) * 128 + (j & 1) * 16) = xv[ii][j] + g[j] * acc[i >> 2][j >> 1][i & 3][j & 1]; }
        }
    }
};
struct EpiSwiglu {
    static constexpr bool PERM = true;
    bf16_t* HH;
    __device__ __forceinline__ void operator()(const AccT& acc, const Unit& u, int wr, int wc, int fr, int fq) const {
        const int row0 = u.pm * 256 + wr * 64 + fr, col0 = u.pn * 128 + wc * 32 + 8 * fq;
#pragma unroll
        for (int ai = 0; ai < 2; ++ai)
#pragma unroll
            for (int m = 0; m < 4; ++m) {
                f32x4 o0, o1;
#pragma unroll
                for (int k = 0; k < 4; ++k) {
                    const float a0 = acc[ai][0][m][0][k], u0 = acc[ai][1][m][0][k], a1 = acc[ai][0][m][1][k], u1 = acc[ai][1][m][1][k];
                    o0[k] = a0 * sigmoidf_(a0) * u0; o1[k] = a1 * sigmoidf_(a1) * u1;
                }
                *(u32x4*)(HH + (size_t)(row0 + ai * 128 + m * 16) * EFF + col0) = pack8v(o0, o1);
            }
    }
};
struct EpiMoeOut {
    static constexpr bool PERM = true;
    bf16_t* YE; const float* GATEV;
    __device__ __forceinline__ void operator()(const AccT& acc, const Unit& u, int wr, int wc, int fr, int fq) const {
        const int row0 = u.pm * 256 + wr * 64 + fr, col0 = u.pn * 256 + wc * 32 + 8 * fq;
        float gt[8];
#pragma unroll
        for (int i = 0; i < 8; ++i) gt[i] = GATEV[row0 + (i >> 2) * 128 + (i & 3) * 16];
#pragma unroll
        for (int i = 0; i < 8; ++i)
#pragma unroll
            for (int bj = 0; bj < 2; ++bj) {
                f32x4 a = acc[i >> 2][bj][i & 3][0], b = acc[i >> 2][bj][i & 3][1]; a *= gt[i]; b *= gt[i];
                *(u32x4*)(YE + (size_t)(row0 + (i >> 2) * 128 + (i & 3) * 16) * 2048 + col0 + bj * 128) = pack8v(a, b);
            }
    }
};

__device__ __forceinline__ int opaque_tid(int wid0) { int t = (wid0 << 6) | opaque_lane(); asm volatile("" : "+v"(t)); return t; }
#define PH_PROLOG const int _tid = opaque_tid(wid0)
#define TID (_tid)
#define WID (_tid >> 6)
#define LANE (_tid & 63)
#define GWAVE ((int)(blockIdx.x * 8) + (_tid >> 6))
#define NWAVE ((int)(gridDim.x * 8))

__device__ __forceinline__ void ph_adaln_partial(const int wid0, const Params& p, LAS unsigned char* lds) {
    PH_PROLOG;
    LAS float* sv = (LAS float*)lds;
    const float* c = p.in[1]; const float* cc = p.in[3]; const float* ada_w = p.in[4];
    for (int u = blockIdx.x; u < 192; u += gridDim.x) {
        const int dc = u % 16, jc = (u / 16) % 6, l = u / 96;
        __syncthreads();
        for (int i = TID; i < 9 * 128; i += 512) { const int s = i / 128, d = dc * 128 + (i % 128); const float cv = s < 8 ? c[s * 2048 + d] : cc[d]; sv[i] = cv / (1.0f + __expf(-cv)); }
        __syncthreads();
        const float* w = ada_w + ((size_t)l * 2048 + dc * 128) * 12288 + jc * 2048 + TID * 4;
        f32x4 acc[9];
#pragma unroll
        for (int s = 0; s < 9; ++s) acc[s] = (f32x4){0.f, 0.f, 0.f, 0.f};
        for (int d0 = 0; d0 < 128; d0 += 8) {
            f32x4 w4[8];
#pragma unroll
            for (int j = 0; j < 8; ++j) w4[j] = *(const f32x4*)(w + (size_t)(d0 + j) * 12288);
#pragma unroll
            for (int j = 0; j < 8; ++j)
#pragma unroll
                for (int s = 0; s < 9; ++s) acc[s] += sv[s * 128 + d0 + j] * w4[j];
        }
#pragma unroll
        for (int s = 0; s < 9; ++s) *(f32x4*)(p.MODP + (((size_t)dc * 2 + l) * 9 + s) * 12288 + jc * 2048 + TID * 4) = acc[s];
    }
}
__device__ __forceinline__ void ph_adaln_reduce(const int wid0, const Params& p) {
    PH_PROLOG;
    const float* ada_b = p.in[5];
    for (int i = blockIdx.x * 512 + TID; i < 2 * 9 * 12288; i += gridDim.x * 512) {
        const int j = i % 12288, l = i / (9 * 12288);
        float a = ada_b[l * 12288 + j];
        for (int dc = 0; dc < 16; ++dc) a += p.MODP[(size_t)dc * 2 * 9 * 12288 + i];
        p.MOD[i] = a;
    }
}

struct CvtJob { const float* src; bf16_t* dst; int R, C, dst_ld, map, nb; long src_bs, dst_bs; };
__device__ __forceinline__ int cvt_map(int map, int c) {
    if (map == 1) return c < 4640 ? c : c + 224;
    if (map == 2) return (c >> 7) * 256 + (c & 127);
    if (map == 3) return (c >> 7) * 256 + 128 + (c & 127);
    return c;
}
__device__ __forceinline__ void cvt_run(const int wid0, const CvtJob J, LAS unsigned char* lds, const int vb, const int nb) {
    PH_PROLOG;
    LAS float* tile = (LAS float*)lds;
    const int nct = J.C / 32, nct4 = (nct + 3) >> 2, tpb = (J.R / 64) * nct4, total = J.nb * tpb;
    const int tr = TID >> 3, tc = TID & 7;
    for (int t = vb; t < total; t += nb) {
        const int bi = t / tpb, r2 = t % tpb, rt = r2 / nct4, c4 = r2 % nct4;
        const float* src = J.src + (size_t)bi * J.src_bs + (size_t)(rt * 64 + tr) * J.C + c4 * 128 + tc * 4;
        f32x4 v[4];
#pragma unroll
        for (int q = 0; q < 4; ++q) v[q] = (c4 * 4 + q < nct) ? *(const f32x4*)(src + q * 32) : (f32x4){0.f, 0.f, 0.f, 0.f};
        __syncthreads();
#pragma unroll
        for (int q = 0; q < 4; ++q)
#pragma unroll
            for (int k = 0; k < 4; ++k) tile[(q * 32 + tc * 4 + k) * 65 + tr] = v[q][k];
        __syncthreads();
#pragma unroll
        for (int i = 0; i < 2; ++i) {
            const int pz = TID + 512 * i, c = pz >> 3, r8 = pz & 7;
            if (c4 * 4 + (c >> 5) < nct) {
                float f[8];
#pragma unroll
                for (int k = 0; k < 8; ++k) f[k] = tile[c * 65 + r8 * 8 + k];
                store8(J.dst + (size_t)bi * J.dst_bs + (size_t)cvt_map(J.map, c4 * 128 + c) * J.dst_ld + rt * 64 + r8 * 8, f);
            }
        }
    }
}
__device__ __forceinline__ void ph_cvt_mixer(const int wid0, const Params& p, int l, LAS unsigned char* lds, const int parts, const int vb, const int nb) {
    PH_PROLOG;
    if (parts & 1) {
        cvt_run(wid0, CvtJob{p.in[8] + (size_t)l * 2048 * 12832, p.WIN_T, 2048, 12832, 2048, 1, 1, 0, 0}, lds, vb, nb);
        for (int i = vb * 512 + TID; i < 224 * 2048 / 8; i += nb * 512) *(u32x4*)(p.WIN_T + (size_t)4640 * 2048 + (size_t)i * 8) = (u32x4){0u, 0u, 0u, 0u};
    }
    if (parts & 2) {
        cvt_run(wid0, CvtJob{p.in[30] + (size_t)l * 4 * 512 * 2048, p.WBR_T, 512, 2048, 2048, 0, 4, 512 * 2048, 512}, lds, vb, nb);
        cvt_run(wid0, CvtJob{p.in[31] + (size_t)l * 2048 * 2048, p.WOUT_T, 2048, 2048, 2048, 0, 1, 0, 0}, lds, vb, nb);
        cvt_run(wid0, CvtJob{p.in[14] + (size_t)l * 512 * 768, p.WUQ_T, 512, 768, 512, 0, 1, 0, 0}, lds, vb, nb);
        cvt_run(wid0, CvtJob{p.in[15] + (size_t)l * 256 * 1024, p.WUKV_T, 256, 1024, 256, 0, 1, 0, 0}, lds, vb, nb);
        const float* w2 = p.in[21] + (size_t)l * 2 * 32 * 512; const float* a2 = p.in[23] + (size_t)l * 2 * 32 * 512; const float* g2 = p.in[24] + (size_t)l * 96 * 512;
        for (int i = vb * 512 + TID; i < 2560 * 256; i += nb * 512) {
            const int n = i >> 8, k = i & 255, seg = n >> 9, c = n & 511; float v = 0.f;
            if (seg == 0 && k < 32) v = w2[(0 * 32 + k) * 512 + c];
            else if (seg == 1 && k >= 32 && k < 64) v = w2[(1 * 32 + (k - 32)) * 512 + c];
            else if (seg == 2 && k >= 64 && k < 96) v = a2[(0 * 32 + (k - 64)) * 512 + c];
            else if (seg == 3 && k >= 96 && k < 128) v = a2[(1 * 32 + (k - 96)) * 512 + c];
            else if (seg == 4 && k >= 128 && k < 224) v = g2[(k - 128) * 512 + c];
            p.WLORA_T[i] = f2bf(v);
        }
    }
}
__device__ __forceinline__ void ph_cvt_moe(const int wid0, const Params& p, int l, LAS unsigned char* lds, const int parts, const int vb, const int nb) {
    if (parts & 1) cvt_run(wid0, CvtJob{p.in[33] + (size_t)l * 16 * 2048 * 1024, p.W13T, 2048, 1024, 2048, 2, 16, 2048 * 1024, 2048 * 2048}, lds, vb, nb);
    if (parts & 2) cvt_run(wid0, CvtJob{p.in[34] + (size_t)l * 16 * 2048 * 1024, p.W13T, 2048, 1024, 2048, 3, 16, 2048 * 1024, 2048 * 2048}, lds, vb, nb);
    if (parts & 4) cvt_run(wid0, CvtJob{p.in[35] + (size_t)l * 16 * 1024 * 2048, p.W2T, 1024, 2048, 1024, 0, 16, 1024 * 2048, 2048 * 1024}, lds, vb, nb);
}
__device__ __forceinline__ void ph_const(const int wid0, const Params& p) {
    PH_PROLOG;
    const int gt = blockIdx.x * 512 + TID, gn = gridDim.x * 512;
    for (int i = gt; i < 1024 * 512; i += gn) {
        const int m = i >> 9, k = i & 511, g = m >> 8, cp = (m >> 1) & 127, cs = m & 1, g2 = k >> 7, c = k & 127; float v = 0.f;
        if (g == g2) { const int mm = (c * cp) & 127; const float x = (float)mm * (2.0f / 128.0f); v = cs ? sinpif(x) : cospif(x); }
        p.WFC[i] = f2bf(v);
    }
    for (int i = gt; i < 2048 * 4096; i += gn) {
        const int k = i >> 12, r = i & 4095, cs = r >> 11, n = r & 2047; const int mm = (k * n) & 2047; const float x = (float)mm * (2.0f / 2048.0f);
        p.ADFT[i] = f2bf(cs ? -sinpif(x) : cospif(x));
    }
    for (int i = gt; i < TT; i += gn) { int b, pf; row_bpos(i, b, pf); const int pr = pos_rev(pf); int* q = p.RBP + (size_t)i * 4; q[0] = b * 8 * 2304 + pf; q[1] = b * 16 * 2304 + pf; q[2] = b * 16 * 2304 + pr; q[3] = 0; }
    for (int i = gt; i < 256 * 512; i += gn) {
        const int k = i >> 9, r = i & 511, cs = r >> 8, n = r & 255; const int mm = (k * n) & 255; const float x = (float)mm * (2.0f / 256.0f);
        p.ADFTC[i] = f2bf(cs ? -sinpif(x) : cospif(x));
    }
}

__device__ __forceinline__ void ph_modulate(const int wid0, const Params& p, int l, bf16_t* dst) {
    PH_PROLOG;
    const float* g = p.in[6] + l * 2048;
    const float* modl = p.MOD + (size_t)l * 9 * 12288;
    for (int r = GWAVE; r < TT; r += NWAVE) {
        const float* src = (l == 0) ? (r < T ? p.in[0] + (size_t)r * 2048 : p.in[2] + (size_t)(r - T) * 2048) : p.XCUR + (size_t)r * 2048;
        f32x4 v[8]; float ss = 0.f;
#pragma unroll
        for (int i = 0; i < 8; ++i) { v[i] = *(const f32x4*)(src + i * 256 + LANE * 4); ss += v[i][0] * v[i][0] + v[i][1] * v[i][1] + v[i][2] * v[i][2] + v[i][3] * v[i][3]; }
        ss = wave_sum(ss);
        const float rs = rsqrtf(ss * (1.0f / 2048.0f) + NORM_EPS);
        const float* ms = modl + (size_t)row_s(r) * 12288;
        u32x2 w[8];
#pragma unroll
        for (int i = 0; i < 8; ++i) {
            const int c = i * 256 + LANE * 4;
            const f32x4 gg = *(const f32x4*)(g + c), sh = *(const f32x4*)(ms + c), sc = *(const f32x4*)(ms + 2048 + c);
            f32x4 y = v[i] * rs * gg * (1.0f + sc) + sh;
            w[i].x = pk2(y[0], y[1]); w[i].y = pk2(y[2], y[3]);
        }
#pragma unroll
        for (int i = 0; i < 8; ++i) *(u32x2*)(dst + (size_t)r * 2048 + i * 256 + LANE * 4) = w[i];
    }
}

__device__ __forceinline__ void shiftmix8(const bf16_t* z, bool hp, bool hn, const float* mu, float* o) {
    float a[8], b[8], c[8];
    load8(z, a);
    if (hp) load8(z - ZW, b); else { for (int k = 0; k < 8; ++k) b[k] = 0.f; }
    if (hn) load8(z + ZW, c); else { for (int k = 0; k < 8; ++k) c[k] = 0.f; }
#pragma unroll
    for (int k = 0; k < 8; ++k) o[k] = a[k] + (0.5f * (b[k] + c[k]) - a[k]) * mu[k];
}
__device__ __forceinline__ void smix8(const u32x4 wa, const u32x4 wb, const u32x4 wc, bool hp, bool hn, const float* mu, float* o) {
    float a[8], b[8], c[8];
    unpack8(wa, a); unpack8(wb, b); unpack8(wc, c);
#pragma unroll
    for (int k = 0; k < 8; ++k) { const float bb = hp ? b[k] : 0.f, cc = hn ? c[k] : 0.f; o[k] = a[k] + (0.5f * (bb + cc) - a[k]) * mu[k]; }
}
__device__ __forceinline__ void ldf8(const float* p, float* v) { const f32x4 a = *(const f32x4*)p, b = *(const f32x4*)(p + 4); v[0] = a[0]; v[1] = a[1]; v[2] = a[2]; v[3] = a[3]; v[4] = b[0]; v[5] = b[1]; v[6] = b[2]; v[7] = b[3]; }
__device__ __forceinline__ void ph_prepA(const int wid0, const Params& p, int l) {
    PH_PROLOG;
    const float* qn = p.in[9] + l * 64; const float* kn = p.in[10] + l * 64;
    const float* cqn = p.in[12] + l * 512; const float* ckvn = p.in[13] + l * 256;
    const float* mu_ks = p.in[18] + l * 1152; const float* mu_qs = p.in[19] + l * 608;
    const float* k_k = p.in[25] + l * 512;
    const int lane = LANE;
    float c_qn[8], c_kn[8], c_cqn[8], c_ckvn[8], c_muk[8], c_muv[8], c_mur[8], c_mul[8], c_kk[8];
    ldf8(qn + ((8 * lane) & 63), c_qn); ldf8(kn + ((8 * lane) & 63), c_kn); ldf8(cqn + 8 * lane, c_cqn); ldf8(ckvn + 8 * (lane & 31), c_ckvn);
    ldf8(mu_ks + 8 * lane, c_muk); ldf8(mu_ks + 512 + 8 * lane, c_muv); ldf8(mu_qs + 8 * lane, c_mur); ldf8(k_k + 8 * lane, c_kk);
    const int lj = lane < 16 ? lane : min(lane - 16, 11);
    ldf8(lane < 16 ? mu_ks + 1024 + 8 * lj : mu_qs + 512 + 8 * lj, c_mul);
    const int lcol = lane < 16 ? 2368 + 8 * lj : 4032 + 8 * lj;
    for (int r = GWAVE; r < TT; r += NWAVE) {
        const bf16_t* z = p.ZS + (size_t)r * ZW;
        int pos, len; if (r < T) { pos = r & 2047; len = 2048; } else { pos = (r - T) & 255; len = 256; }
        const bool hp = pos > 0, hn = pos < len - 1;
        const bool qside = !(l == DEPTH - 1 && r >= T);
        const bf16_t* zp = hp ? z - ZW : z; const bf16_t* zn = hn ? z + ZW : z;
        const u32x4 w_nq = *(const u32x4*)(z + 2496 + 8 * lane), w_nk = *(const u32x4*)(z + 8 * lane), w_cq = *(const u32x4*)(z + 3008 + 8 * lane), w_ckv = *(const u32x4*)(z + 1024 + 8 * (lane & 31));
        const u32x4 w_k0 = *(const u32x4*)(z + 1344 + 8 * lane), w_k1 = *(const u32x4*)(zp + 1344 + 8 * lane), w_k2 = *(const u32x4*)(zn + 1344 + 8 * lane);
        const u32x4 w_v0 = *(const u32x4*)(z + 1856 + 8 * lane), w_v1 = *(const u32x4*)(zp + 1856 + 8 * lane), w_v2 = *(const u32x4*)(zn + 1856 + 8 * lane);
        const u32x4 w_r0 = *(const u32x4*)(z + 3520 + 8 * lane), w_r1 = *(const u32x4*)(zp + 3520 + 8 * lane), w_r2 = *(const u32x4*)(zn + 3520 + 8 * lane);
        const u32x4 w_l0 = *(const u32x4*)(z + lcol), w_l1 = *(const u32x4*)(zp + lcol), w_l2 = *(const u32x4*)(zn + lcol);
        float v[8], o[8];
        if (qside) {
            unpack8(w_nq, v);
            float ss = 0.f; for (int k = 0; k < 8; ++k) ss += v[k] * v[k]; ss = sum8(ss); const float rs = rsqrtf(ss * (1.0f / 64.0f) + NORM_EPS) * (0.125f * 1.4426950408889634f);
            for (int k = 0; k < 8; ++k) o[k] = v[k] * rs * c_qn[k]; store8(p.NQ + (size_t)r * 512 + 8 * lane, o);
        }
        { unpack8(w_nk, v);
          float ss = 0.f; for (int k = 0; k < 8; ++k) ss += v[k] * v[k]; ss = sum8(ss); const float rs = rsqrtf(ss * (1.0f / 64.0f) + NORM_EPS);
          for (int k = 0; k < 8; ++k) o[k] = v[k] * rs * c_kn[k]; store8(p.NK + (size_t)r * 512 + 8 * lane, o); }
        if (qside) {
            unpack8(w_cq, v);
            float ss = 0.f; for (int k = 0; k < 8; ++k) ss += v[k] * v[k]; ss = wave_sum(ss); const float rs = rsqrtf(ss * (1.0f / 512.0f) + NORM_EPS);
            for (int k = 0; k < 8; ++k) o[k] = v[k] * rs * c_cqn[k]; store8(p.CQN + (size_t)r * 512 + 8 * lane, o);
        }
        { unpack8(w_ckv, v);
          float ss = 0.f; if (lane < 32) { for (int k = 0; k < 8; ++k) ss += v[k] * v[k]; }
          ss = wave_sum(ss); const float rs = rsqrtf(ss * (1.0f / 256.0f) + NORM_EPS);
          if (lane < 32) { for (int k = 0; k < 8; ++k) o[k] = v[k] * rs * c_ckvn[k]; store8(p.CKVN + (size_t)r * 256 + 8 * lane, o); } }
        smix8(w_k0, w_k1, w_k2, hp, hn, c_muk, o);
        store8(p.RK + (size_t)r * 512 + 8 * lane, o);
        int sb_, pf_; row_bpos(r, sb_, pf_);
        char* rec1 = p.R1 + ((size_t)(sb_ * 8 + (lane >> 3)) * 2304 + pf_) * R1B; const int j0_ = (lane & 7) * 8;
        { float t[8], ss = 0.f; for (int k = 0; k < 8; ++k) { t[k] = o[k] * c_kk[k]; ss += t[k] * t[k]; } ss = sum8(ss);
          const float inv = 1.0f / fmaxf(sqrtf(ss), 1e-12f);
          f32x4 k0 = {t[0] * inv, t[1] * inv, t[2] * inv, t[3] * inv}, k1 = {t[4] * inv, t[5] * inv, t[6] * inv, t[7] * inv};
          *(f32x4*)(rec1 + j0_ * 4) = k0; *(f32x4*)(rec1 + j0_ * 4 + 16) = k1; }
        smix8(w_v0, w_v1, w_v2, hp, hn, c_muv, o);
        store8((bf16_t*)(rec1 + 512) + j0_, o);
        if (qside) smix8(w_r0, w_r1, w_r2, hp, hn, c_mur, o); else { for (int k = 0; k < 8; ++k) o[k] = 0.f; }
        { const f32x4 r0 = {o[0], o[1], o[2], o[3]}, r1 = {o[4], o[5], o[6], o[7]}; *(f32x4*)(rec1 + 256 + j0_ * 4) = r0; *(f32x4*)(rec1 + 256 + j0_ * 4 + 16) = r1; }
        if (lane < 16) {
            smix8(w_l0, w_l1, w_l2, hp, hn, c_mul, o);
            if (lane < 8) for (int k = 0; k < 8; ++k) o[k] = tanhf(o[k]);
            store8(p.LA + (size_t)r * 256 + 8 * lane, o);
        } else if (lane < 28) {
            const int j = lane - 16;
            if (qside) { smix8(w_l0, w_l1, w_l2, hp, hn, c_mul, o); for (int k = 0; k < 8; ++k) o[k] = sigmoidf_(o[k]); } else { for (int k = 0; k < 8; ++k) o[k] = 0.f; }
            store8(p.LA + (size_t)r * 256 + 128 + 8 * j, o);
        } else if (lane < 32) {
            for (int k = 0; k < 8; ++k) o[k] = 0.f;
            store8(p.LA + (size_t)r * 256 + 128 + 8 * (lane - 16), o);
        }
    }
}

__device__ __forceinline__ float rope_lane(float x, int lane, int pos) {
    const int blk = lane >> 5, jj = lane & 31, i = jj & 15;
    const int pp = blk ? (pos & 63) : (pos >> 6);
    const float freq = exp2f(-(float)i * (13.287712379549449f / 16.0f));
    const float ang = (float)pp * freq;
    float s, c; sincosf(ang, &s, &c);
    const float xp = __shfl_xor(x, 16);
    return (jj < 16) ? (x * c - xp * s) : (xp * s + x * c);
}
__device__ __forceinline__ void ph_prepB(const int wid0, const Params& p, int l) {
    PH_PROLOG;
    const float* qg = p.in[16] + l * 192; const float* kg = p.in[17] + l * 192;
    const int lane = LANE;
    const float MLA_SCALE = 0.07216878364870323f * 1.4426950408889634f;
    const float qg0 = qg[lane], qg1 = qg[lane + 64], qg2 = qg[lane + 128], kg0 = kg[lane], kg1 = kg[lane + 64], kg2 = kg[lane + 128];
    const float rfreq = exp2f(-(float)(lane & 15) * (13.287712379549449f / 16.0f));
    for (int r = GWAVE; r < TT; r += NWAVE) {
        const bf16_t* q = p.Q0 + (size_t)r * 768; const bf16_t* kv = p.KV0 + (size_t)r * 1024; const bf16_t* zr = p.ZS + (size_t)r * ZW + 1280 + lane;
        bf16_t qv[4][3], kw[4][2];
#pragma unroll
        for (int h = 0; h < 4; ++h) { qv[h][0] = q[h * 192 + lane]; qv[h][1] = q[h * 192 + lane + 64]; qv[h][2] = q[h * 192 + lane + 128]; kw[h][0] = kv[h * 256 + lane]; kw[h][1] = kv[h * 256 + lane + 64]; }
        const bf16_t k2 = zr[0];
        float rs_ = 0.f, rc_ = 1.f;
        if (r < T) { const int pos = r & 2047, pp = (lane >> 5) ? (pos & 63) : (pos >> 6); __sincosf((float)pp * rfreq, &rs_, &rc_); }
#pragma unroll
        for (int h = 0; h < 4; ++h) {
            {
                float x0 = bf2f(qv[h][0]), x1 = bf2f(qv[h][1]), x2 = bf2f(qv[h][2]);
                const float ss = wave_sum(x0 * x0 + x1 * x1 + x2 * x2), rs = rsqrtf(ss * (1.0f / 192.0f) + NORM_EPS);
                x0 *= rs * qg0; x1 *= rs * qg1; x2 *= rs * qg2;
                if (r < T) { const float xp = __shfl_xor(x2, 16); x2 = ((lane & 31) < 16) ? (x2 * rc_ - xp * rs_) : (xp * rs_ + x2 * rc_); }
                bf16_t* o = p.MQ + ((size_t)r * 4 + h) * 192;
                o[lane] = f2bf(x0 * MLA_SCALE); o[lane + 64] = f2bf(x1 * MLA_SCALE); o[lane + 128] = f2bf(x2 * MLA_SCALE);
            }
            {
                float x0 = bf2f(kw[h][0]), x1 = bf2f(kw[h][1]), x2 = bf2f(k2);
                const float ss = wave_sum(x0 * x0 + x1 * x1 + x2 * x2), rs = rsqrtf(ss * (1.0f / 192.0f) + NORM_EPS);
                x0 *= rs * kg0; x1 *= rs * kg1; x2 *= rs * kg2;
                if (r < T) { const float xp = __shfl_xor(x2, 16); x2 = ((lane & 31) < 16) ? (x2 * rc_ - xp * rs_) : (xp * rs_ + x2 * rc_); }
                bf16_t* o = p.MK + ((size_t)r * 4 + h) * 192;
                o[lane] = f2bf(x0); o[lane + 64] = f2bf(x1); o[lane + 128] = f2bf(x2);
            }
        }
    }
    for (int it = GWAVE; it < 8 * 4 * 36 + 8 * 8 * 36; it += NWAVE) {
        const bool na = it >= 8 * 4 * 36; const int j = na ? it - 8 * 4 * 36 : it;
        const int g = j % 36, bh = j / 36, nh = na ? 8 : 4, b = bh / nh, h = bh % nh;
        const int kk = 64 * g + lane, krow = kk < 2048 ? b * 2048 + kk : T + b * 256 + (kk - 2048);
        const int kap = kk & 15, slot = (kk & ~15) + 8 * ((kap >> 2) & 1) + (kap & 3) + 4 * (kap >> 3);
        if (!na) {
            const bf16_t* src = p.KV0 + (size_t)krow * 1024 + h * 256 + 128; bf16_t* dst = p.MVT + ((size_t)(b * 4 + h) * 128) * 2304 + slot;
            u32x4 wv[16];
#pragma unroll
            for (int i = 0; i < 16; ++i) wv[i] = *(const u32x4*)(src + 8 * i);
#pragma unroll
            for (int i = 0; i < 16; ++i) { const unsigned ww[4] = {wv[i].x, wv[i].y, wv[i].z, wv[i].w};
#pragma unroll
                for (int k = 0; k < 8; ++k) dst[(size_t)(8 * i + k) * 2304] = (bf16_t)((ww[k >> 1] >> ((k & 1) * 16)) & 0xffffu); }
        } else {
            const bf16_t* src = p.ZS + (size_t)krow * ZW + 512 + h * 64; bf16_t* dst = p.NVT + ((size_t)(b * 8 + h) * 64) * 2304 + slot;
            u32x4 wv[8];
#pragma unroll
            for (int i = 0; i < 8; ++i) wv[i] = *(const u32x4*)(src + 8 * i);
#pragma unroll
            for (int i = 0; i < 8; ++i) { const unsigned ww[4] = {wv[i].x, wv[i].y, wv[i].z, wv[i].w};
#pragma unroll
                for (int k = 0; k < 8; ++k) dst[(size_t)(8 * i + k) * 2304] = (bf16_t)((ww[k >> 1] >> ((k & 1) * 16)) & 0xffffu); }
        }
    }
}

typedef float f32x16 __attribute__((ext_vector_type(16)));
__device__ __forceinline__ unsigned cvtpk(float lo, float hi) { return pk2(lo, hi); }
#define MFMA32(a, b, c) __builtin_amdgcn_mfma_f32_32x32x16_bf16((a), (b), (c), 0, 0, 0)
template <int NDB> __device__ __forceinline__ void softmax_step(f32x16& x0, f32x16& x1, float& m, float& lsum, f32x16 (&O)[NDB], bf16x8 (&pf)[4]) {
    float mx = x0[0];
#pragma unroll
    for (int r = 1; r < 16; ++r) mx = fmaxf(mx, x0[r]);
#pragma unroll
    for (int r = 0; r < 16; ++r) mx = fmaxf(mx, x1[r]);
    { auto rr = __builtin_amdgcn_permlane32_swap(__float_as_uint(mx), __float_as_uint(mx), false, false); mx = fmaxf(__uint_as_float(rr[0]), __uint_as_float(rr[1])); }
    const float mn = fmaxf(m, mx), alpha = __builtin_amdgcn_exp2f(m - mn); m = mn;
    float ps = 0.f;
#pragma unroll
    for (int r = 0; r < 16; ++r) { x0[r] = __builtin_amdgcn_exp2f(x0[r] - mn); ps += x0[r]; }
#pragma unroll
    for (int r = 0; r < 16; ++r) { x1[r] = __builtin_amdgcn_exp2f(x1[r] - mn); ps += x1[r]; }
    lsum = lsum * alpha + ps;
#pragma unroll
    for (int d = 0; d < NDB; ++d) O[d] *= alpha;
    u32x4 w;
    w.x = cvtpk(x0[0], x0[1]); w.y = cvtpk(x0[2], x0[3]); w.z = cvtpk(x0[4], x0[5]); w.w = cvtpk(x0[6], x0[7]); pf[0] = *reinterpret_cast<bf16x8*>(&w);
    w.x = cvtpk(x0[8], x0[9]); w.y = cvtpk(x0[10], x0[11]); w.z = cvtpk(x0[12], x0[13]); w.w = cvtpk(x0[14], x0[15]); pf[1] = *reinterpret_cast<bf16x8*>(&w);
    w.x = cvtpk(x1[0], x1[1]); w.y = cvtpk(x1[2], x1[3]); w.z = cvtpk(x1[4], x1[5]); w.w = cvtpk(x1[6], x1[7]); pf[2] = *reinterpret_cast<bf16x8*>(&w);
    w.x = cvtpk(x1[8], x1[9]); w.y = cvtpk(x1[10], x1[11]); w.z = cvtpk(x1[12], x1[13]); w.w = cvtpk(x1[14], x1[15]); pf[3] = *reinterpret_cast<bf16x8*>(&w);
}
template <int NDB> __device__ __forceinline__ void attn_store(const f32x16 (&O)[NDB], float lsum, bf16_t* yrow, int hh) {
    { auto rr = __builtin_amdgcn_permlane32_swap(__float_as_uint(lsum), __float_as_uint(lsum), false, false); lsum = __uint_as_float(rr[0]) + __uint_as_float(rr[1]); }
    const float inv = 1.0f / lsum;
#pragma unroll
    for (int d = 0; d < NDB; ++d)
#pragma unroll
        for (int g = 0; g < 4; ++g) {
            u32x2 w; w.x = cvtpk(O[d][4 * g] * inv, O[d][4 * g + 1] * inv); w.y = cvtpk(O[d][4 * g + 2] * inv, O[d][4 * g + 3] * inv);
            *(u32x2*)(yrow + d * 32 + 8 * g + 4 * hh) = w;
        }
}

__device__ __forceinline__ void ph_mla_flash(const int wid0, const Params& p, int l, LAS unsigned char* lds) {
    PH_PROLOG;
    const int tid = TID, wid = __builtin_amdgcn_readfirstlane(tid >> 6), lane = tid & 63, r = lane & 31, hh = lane >> 5;
    constexpr int KP = 400, VP = 144, KBUF = 64 * KP, VBUF = 128 * VP, BUF = KBUF + VBUF;
    const int nunits = 256 + (l == 0 ? 32 : 0);
    const int vblk = (gridDim.x == 256) ? (int)((blockIdx.x & 7) * 32 + (blockIdx.x >> 3)) : (int)blockIdx.x;
    for (int u = vblk; u < nunits; u += gridDim.x) {
        int b, h, qrow0, nkt; bool ctxonly;
        if (u < 256) { b = u >> 5; h = (u >> 3) & 3; qrow0 = b * 2048 + (u & 7) * 256; nkt = 36; ctxonly = false; }
        else { const int j = u - 256; b = j >> 2; h = j & 3; qrow0 = T + b * 256; nkt = 4; ctxonly = true; }
        bf16x8 qf[12];
        { const bf16_t* qp = p.MQ + ((size_t)(qrow0 + wid * 32 + r) * 4 + h) * 192 + 8 * hh;
#pragma unroll
          for (int s = 0; s < 12; ++s) qf[s] = *(const bf16x8*)(qp + 16 * s); }
        f32x16 O[4];
#pragma unroll
        for (int d = 0; d < 4; ++d)
#pragma unroll
            for (int k = 0; k < 16; ++k) O[d][k] = 0.f;
        float m = -1.0e30f, lsum = 0.f;
        u32x4 kreg[3], vreg[2];
        const bf16_t* vtb = p.MVT + ((size_t)(b * 4 + h) * 128) * 2304;
#define MLA_LOAD(t) do { const int _t = (t); \
            const int krow0 = ctxonly ? (T + b * 256 + 64 * _t) : (_t < 32 ? b * 2048 + 64 * _t : T + b * 256 + 64 * (_t - 32)); \
            const int slot0 = ctxonly ? 2048 + 64 * _t : 64 * _t; \
            _Pragma("unroll") for (int i = 0; i < 3; ++i) { const int q = tid + 512 * i, row = q / 24, c = q % 24; kreg[i] = *(const u32x4*)(p.MK + ((size_t)(krow0 + row) * 4 + h) * 192 + c * 8); } \
            _Pragma("unroll") for (int i = 0; i < 2; ++i) { const int q = tid + 512 * i, d = q >> 3, c = q & 7; vreg[i] = *(const u32x4*)(vtb + (size_t)d * 2304 + slot0 + c * 8); } } while (0)
#define MLA_STORE(buf) do { LAS unsigned char* kb_ = lds + (buf) * BUF; \
            _Pragma("unroll") for (int i = 0; i < 3; ++i) { const int q = tid + 512 * i, row = q / 24, c = q % 24; *(LAS u32x4*)(kb_ + row * KP + c * 16) = kreg[i]; } \
            _Pragma("unroll") for (int i = 0; i < 2; ++i) { const int q = tid + 512 * i, d = q >> 3, c = q & 7; *(LAS u32x4*)(kb_ + KBUF + d * VP + c * 16) = vreg[i]; } } while (0)
        __syncthreads();
        MLA_LOAD(0); MLA_STORE(0);
        __syncthreads();
        for (int t = 0; t < nkt; ++t) {
            if (t + 1 < nkt) MLA_LOAD(t + 1);
            const LAS unsigned char* kb = lds + (t & 1) * BUF; const LAS unsigned char* vb = kb + KBUF;
            f32x16 x0, x1;
#pragma unroll
            for (int k = 0; k < 16; ++k) { x0[k] = 0.f; x1[k] = 0.f; }
#pragma unroll
            for (int s = 0; s < 12; s += 3) {
                bf16x8 a0[3], a1[3];
#pragma unroll
                for (int q = 0; q < 3; ++q) { a0[q] = *(const LAS bf16x8*)(kb + r * KP + (16 * (s + q) + 8 * hh) * 2); a1[q] = *(const LAS bf16x8*)(kb + (32 + r) * KP + (16 * (s + q) + 8 * hh) * 2); }
                __builtin_amdgcn_sched_barrier(0);
#pragma unroll
                for (int q = 0; q < 3; ++q) { x0 = MFMA32(a0[q], qf[s + q], x0); x1 = MFMA32(a1[q], qf[s + q], x1); }
                __builtin_amdgcn_sched_barrier(0);
            }
            bf16x8 pf[4];
            softmax_step<4>(x0, x1, m, lsum, O, pf);
#pragma unroll
            for (int d = 0; d < 4; ++d) {
                bf16x8 a[4];
#pragma unroll
                for (int j = 0; j < 4; ++j) a[j] = *(const LAS bf16x8*)(vb + (d * 32 + r) * VP + (j * 16 + 8 * hh) * 2);
                __builtin_amdgcn_sched_barrier(0);
#pragma unroll
                for (int j = 0; j < 4; ++j) O[d] = MFMA32(a[j], pf[j], O[d]);
                __builtin_amdgcn_sched_barrier(0);
            }
            if (t + 1 < nkt) MLA_STORE((t + 1) & 1);
            __syncthreads();
        }
#undef MLA_LOAD
#undef MLA_STORE
        attn_store<4>(O, lsum, p.Y + (size_t)(qrow0 + wid * 32 + r) * 2048 + 1024 + h * 128, hh);
    }
}

__device__ __forceinline__ void ph_na_flash(const int wid0, const Params& p, int l, LAS unsigned char* lds) {
    PH_PROLOG;
    const int tid = TID, lane = tid & 63, r = lane & 31, hh = lane >> 5;
    LAS float* bt = (LAS float*)lds;
    { const float* rpb = p.in[11] + (size_t)l * 8 * 15 * 31; for (int i = tid; i < 8 * 15 * 31; i += 512) bt[i] = rpb[i] * 1.4426950408889634f; }
    __syncthreads();
    const int nitems = 4096 + (l == 0 ? 512 : 0);
    int c0, cend, cstep;
    if (gridDim.x == 256) {
        const int xcd = blockIdx.x & 7, j = blockIdx.x >> 3, nch = nitems >> 3;
        if ((j & 7) == 7) { c0 = 0; cend = 0; cstep = 256; }
        else { c0 = (7 - xcd) * 28 + j - (j >> 3); cend = nch; cstep = 224; }
    } else { c0 = (int)blockIdx.x; cend = nitems >> 3; cstep = (int)gridDim.x; }
    for (int ch = c0; ch < cend; ch += cstep) {
        const int it = ch * 8 + wid0;
        int b, h, gr = 0, w = 0, qrow0; const bool isctx = it >= 4096;
        if (!isctx) { b = it >> 9; h = (it >> 6) & 7; gr = (it >> 1) & 31; w = it & 1; qrow0 = b * 2048 + gr * 64 + w * 32; }
        else { const int j = it - 4096; b = j >> 6; h = (j >> 3) & 7; qrow0 = T + b * 256 + (j & 7) * 32; }
        bf16x8 qf[4];
        { const bf16_t* qp = p.NQ + (size_t)(qrow0 + r) * 512 + h * 64 + 8 * hh;
#pragma unroll
          for (int s = 0; s < 4; ++s) qf[s] = *(const bf16x8*)(qp + 16 * s); }
        const int qc = w * 32 + r, rs = min(max(gr - 4, 0), 24), cs = min(max(qc - 8, 0), 48);
        f32x16 O[2];
#pragma unroll
        for (int d = 0; d < 2; ++d)
#pragma unroll
            for (int k = 0; k < 16; ++k) O[d][k] = 0.f;
        float m = -1.0e30f, lsum = 0.f;
        const bf16_t* vtb = p.NVT + ((size_t)(b * 8 + h) * 64) * 2304;
        const int nsteps = isctx ? 4 : 12;
#define NA_KROW(st_) ((!isctx && (st_) < 8) ? b * 2048 + (rs + (st_)) * 64 : T + b * 256 + 64 * (isctx ? (st_) : (st_) - 8))
#define NA_LOADK(st_) do { const bf16_t* kp_ = p.NK + (size_t)(NA_KROW(st_) + r) * 512 + h * 64 + 8 * hh; \
            _Pragma("unroll") for (int s = 0; s < 4; ++s) { kf[2 * s] = *(const bf16x8*)(kp_ + 16 * s); kf[2 * s + 1] = *(const bf16x8*)(kp_ + 32 * 512 + 16 * s); } } while (0)
        bf16x8 kf[8];
        NA_LOADK(0);
        for (int st = 0; st < nsteps; ++st) {
            const bool local = !isctx && st < 8;
            int slot0, dr = 0;
            if (local) { const int kr = rs + st; slot0 = kr * 64; dr = kr - gr + 7; }
            else { const int c = isctx ? st : st - 8; slot0 = 2048 + 64 * c; }
            f32x16 x0, x1;
#pragma unroll
            for (int k = 0; k < 16; ++k) { x0[k] = 0.f; x1[k] = 0.f; }
            const bf16_t* vp = vtb + (size_t)r * 2304 + slot0 + 8 * hh;
            bf16x8 vf[8];
#pragma unroll
            for (int d = 0; d < 2; ++d)
#pragma unroll
                for (int j = 0; j < 4; ++j) vf[d * 4 + j] = *(const bf16x8*)(vp + (size_t)(d * 32) * 2304 + j * 16);
            __builtin_amdgcn_sched_barrier(0);
#pragma unroll
            for (int s = 0; s < 4; ++s) { x0 = MFMA32(kf[2 * s], qf[s], x0); x1 = MFMA32(kf[2 * s + 1], qf[s], x1); }
            __builtin_amdgcn_sched_barrier(0);
            if (st + 1 < nsteps) NA_LOADK(st + 1);
            __builtin_amdgcn_sched_barrier(0);
            if (local) {
                const LAS float* brow = bt + (h * 15 + dr) * 31;
                const int q15 = 15 - qc;
                {   float bv[16];
#pragma unroll
                    for (int k = 0; k < 16; ++k) { const int kc0 = (k & 3) + 8 * (k >> 2) + 4 * hh; bv[k] = brow[min(max(kc0 + q15, 0), 30)]; }
#pragma unroll
                    for (int k = 0; k < 16; ++k) { const int kc0 = (k & 3) + 8 * (k >> 2) + 4 * hh; x0[k] = ((unsigned)(kc0 - cs) < 16u) ? x0[k] + bv[k] : -3.0e38f; }
                }
                {   float bv[16];
#pragma unroll
                    for (int k = 0; k < 16; ++k) { const int kc1 = (k & 3) + 8 * (k >> 2) + 4 * hh + 32; bv[k] = brow[min(max(kc1 + q15, 0), 30)]; }
#pragma unroll
                    for (int k = 0; k < 16; ++k) { const int kc1 = (k & 3) + 8 * (k >> 2) + 4 * hh + 32; x1[k] = ((unsigned)(kc1 - cs) < 16u) ? x1[k] + bv[k] : -3.0e38f; }
                }
            }
            bf16x8 pf[4];
            softmax_step<2>(x0, x1, m, lsum, O, pf);
#pragma unroll
            for (int d = 0; d < 2; ++d)
#pragma unroll
                for (int j = 0; j < 4; ++j) O[d] = MFMA32(vf[d * 4 + j], pf[j], O[d]);
        }
#undef NA_LOADK
#undef NA_KROW
        attn_store<2>(O, lsum, p.Y + (size_t)(qrow0 + r) * 2048 + 512 + h * 64, hh);
    }
}

#define MFMA_F32(a, b, c) __builtin_amdgcn_mfma_f32_32x32x2f32((a), (b), (c), 0, 0, 0)
constexpr int SCAN_NCH = 16, SCAN_LC = 144;
static_assert(SCAN_LC % 32 == 16, "the fix-up pass assumes a 16-step tail block");
__device__ __forceinline__ float half_sum(float x) { auto rr = __builtin_amdgcn_permlane32_swap(__float_as_uint(x), __float_as_uint(x), false, false); return __uint_as_float(rr[0]) + __uint_as_float(rr[1]); }
#define X2(T_, i_) ((f32x2){(T_)[(i_)], (T_)[(i_) + 1]})
template <bool DOP> __device__ __forceinline__ void scan_dot(const f32x16 (&X)[2][2], const f32x16 (&Z)[2][2], const LAS float* vec, float& s0, float& s1, float& t0, float& t1) {
    f32x2 a0 = {0.f, 0.f}, a1 = {0.f, 0.f}, c0 = {0.f, 0.f}, c1 = {0.f, 0.f};
#pragma unroll
    for (int jb = 0; jb < 2; ++jb)
#pragma unroll
        for (int g = 0; g < 4; ++g) {
            const f32x4 u = *(const LAS f32x4*)(vec + jb * 32 + 8 * g);
            const f32x2 ul = {u[0], u[1]}, uh = {u[2], u[3]};
            a0 += X2(X[0][jb], 4 * g) * ul; a0 += X2(X[0][jb], 4 * g + 2) * uh;
            a1 += X2(X[1][jb], 4 * g) * ul; a1 += X2(X[1][jb], 4 * g + 2) * uh;
            if (DOP) {
                c0 += X2(Z[0][jb], 4 * g) * ul; c0 += X2(Z[0][jb], 4 * g + 2) * uh;
                c1 += X2(Z[1][jb], 4 * g) * ul; c1 += X2(Z[1][jb], 4 * g + 2) * uh;
            }
            if (g & 1) { if (DOP) asm volatile("" : "+v"(a0), "+v"(a1), "+v"(c0), "+v"(c1) :: "memory"); else asm volatile("" : "+v"(a0), "+v"(a1) :: "memory"); }
        }
    s0 = half_sum(a0[0] + a0[1]); s1 = half_sum(a1[0] + a1[1]);
    if (DOP) { t0 = half_sum(c0[0] + c0[1]); t1 = half_sum(c1[0] + c1[1]); }
}
#define MUL2(T_, i_, u_) do { const f32x2 _t = X2(T_, i_) * (u_); (T_)[(i_)] = _t[0]; (T_)[(i_) + 1] = _t[1]; } while (0)
template <bool DOP> __device__ __forceinline__ void scan_decay(f32x16 (&X)[2][2], f32x16 (&Z)[2][2], const LAS float* vec) {
#pragma unroll
    for (int jb = 0; jb < 2; ++jb)
#pragma unroll
        for (int g = 0; g < 4; ++g) {
            const f32x4 u = *(const LAS f32x4*)(vec + jb * 32 + 8 * g);
            const f32x2 ul = {u[0], u[1]}, uh = {u[2], u[3]};
            MUL2(X[0][jb], 4 * g, ul); MUL2(X[0][jb], 4 * g + 2, uh); MUL2(X[1][jb], 4 * g, ul); MUL2(X[1][jb], 4 * g + 2, uh);
            if (DOP) { MUL2(Z[0][jb], 4 * g, ul); MUL2(Z[0][jb], 4 * g + 2, uh); MUL2(Z[1][jb], 4 * g, ul); MUL2(Z[1][jb], 4 * g + 2, uh); }
            if (g & 1) asm volatile("" ::: "memory");
        }
}
constexpr int SCAN_D = 8, SCAN_SLOT = R1B + R2B, SCAN_RING = (SCAN_D + 1) * SCAN_SLOT;
template <bool DOP, bool DOY, bool DOZ = false>
__device__ __forceinline__ void scan_run(const Params& p, int b, int h, int d, int s0, int s1, f32x16 (&Q)[2][2], f32x16 (&P)[2][2], LAS unsigned char* ring, int lane) {
    const int half = lane >> 5, l32 = lane & 31;
    const char* g1 = p.R1 + (size_t)(b * 8 + h) * 2304 * R1B;
    const char* g2 = p.R2 + (size_t)((b * 8 + h) * 2 + d) * 2304 * R2B;
    float* YS = p.YS + (size_t)((b * 8 + h) * 2 + d) * 2304 * 64;
    bf16_t* ZB = p.ZB + (size_t)((b * 8 + h) * 2 + d) * 2304 * 64;
    const unsigned lo16 = (unsigned)lane * 16u, lo4 = (unsigned)lane * 4u;
#define SCAN_ISSUE(sidx, slot) do { const int _s = (sidx); const int _p1 = d ? pos_rev(_s) : _s; LAS unsigned char* _sl = ring + (slot) * SCAN_SLOT; \
        if (lane < 40) __builtin_amdgcn_global_load_lds((const unsigned*)(g1 + (size_t)_p1 * R1B + lo16), (LAS unsigned*)(_sl), 16, 0, 0); \
        if (lane < 32) __builtin_amdgcn_global_load_lds((const unsigned*)(g2 + (size_t)_s * R2B + lo16), (LAS unsigned*)(_sl + R1B), 16, 0, 0); } while (0)
    { LAS unsigned char* zs = ring + SCAN_D * SCAN_SLOT; *(LAS u32x4*)(zs + lo16) = (u32x4){0u, 0u, 0u, 0u}; if (lane < (SCAN_SLOT - 1024) / 16) *(LAS u32x4*)(zs + 1024 + lo16) = (u32x4){0u, 0u, 0u, 0u}; }
#pragma unroll
    for (int k = 0; k < SCAN_D - 1; ++k) SCAN_ISSUE(s0 + k, k);
    for (int sb = s0; sb < s1; sb += 2) {
#pragma unroll
        for (int uu = 0; uu < 2; ++uu) {
            const int s = sb + uu, u = (s - s0) & (SCAN_D - 1);
            SCAN_ISSUE(min(s + SCAN_D - 1, s1 - 1), (u + SCAN_D - 1) & (SCAN_D - 1));
            asm volatile("s_waitcnt vmcnt(14)" ::: "memory");
            const LAS unsigned char* sl = ring + u * SCAN_SLOT;
            const LAS float* Lh = (const LAS float*)sl + 4 * half;
            const LAS unsigned char* sh = (half ? ring + SCAN_D * SCAN_SLOT : sl) + l32 * 2;
            const unsigned kd0 = *(const LAS bf16_t*)(sh + R1B + 384), kd1 = *(const LAS bf16_t*)(sh + R1B + 384 + 64);
            const unsigned nb0 = *(const LAS bf16_t*)(sh + R1B + 256), nb1 = *(const LAS bf16_t*)(sh + R1B + 256 + 64);
            const unsigned vb0 = *(const LAS bf16_t*)(sh + 512), vb1 = *(const LAS bf16_t*)(sh + 512 + 64);
            float sq0, sq1, sp0 = 0.f, sp1 = 0.f;
            scan_dot<DOP>(Q, P, Lh, sq0, sq1, sp0, sp1);
            scan_decay<DOP>(Q, P, (const LAS float*)(sl + R1B) + 4 * half);
            u32x4 fa0 = {kd0 | (nb0 << 16), nb0, 0u, 0u}, fa1 = {kd1 | (nb1 << 16), nb1, 0u, 0u};
            const bf16x8 A0 = *reinterpret_cast<bf16x8*>(&fa0), A1 = *reinterpret_cast<bf16x8*>(&fa1);
#define SCAN_BFRAG(name, vb, sa) u32x4 name##_w = {0u, 0u, 0u, 0u}; { const unsigned _hi = (unsigned)f2bf(sa); const float _lo = (sa) - __uint_as_float(_hi << 16); \
                name##_w.x = (vb) | (_hi << 16); name##_w.y = (unsigned)f2bf(_lo); } const bf16x8 name = *reinterpret_cast<bf16x8*>(&name##_w)
            SCAN_BFRAG(B0q, vb0, sq0); SCAN_BFRAG(B1q, vb1, sq1);
            Q[0][0] = MFMA32(A0, B0q, Q[0][0]); Q[0][1] = MFMA32(A1, B0q, Q[0][1]);
            Q[1][0] = MFMA32(A0, B1q, Q[1][0]); Q[1][1] = MFMA32(A1, B1q, Q[1][1]);
            if (DOP) {
                SCAN_BFRAG(B0p, 0u, sp0); SCAN_BFRAG(B1p, 0u, sp1);
                P[0][0] = MFMA32(A0, B0p, P[0][0]); P[0][1] = MFMA32(A1, B0p, P[0][1]);
                P[1][0] = MFMA32(A0, B1p, P[1][0]); P[1][1] = MFMA32(A1, B1p, P[1][1]);
            }
#undef SCAN_BFRAG
            if (DOY) {
                float y0, y1, u0, u1; scan_dot<false>(Q, Q, Lh + 64, y0, y1, u0, u1);
                *(float*)((char*)(YS + (size_t)s * 64) + lo4) = half ? y1 : y0;
            }
            if (DOZ) {
                float y0, y1, z0, z1; scan_dot<true>(Q, P, Lh + 64, y0, y1, z0, z1);
                *(float*)((char*)(YS + (size_t)s * 64) + lo4) = half ? y1 : y0;
                *(bf16_t*)((char*)(ZB + (size_t)s * 64) + (lo4 >> 1)) = f2bf(half ? z1 : z0);
            }
        }
    }
    asm volatile("s_waitcnt vmcnt(0)" ::: "memory");
#undef SCAN_ISSUE
}
__device__ __forceinline__ void scan_zero(f32x16 (&X)[2][2]) {
#pragma unroll
    for (int a = 0; a < 2; ++a)
#pragma unroll
        for (int c = 0; c < 2; ++c)
#pragma unroll
            for (int k = 0; k < 16; ++k) X[a][c][k] = 0.f;
}
__device__ __forceinline__ void scan_store_acc(float* dst, const f32x16 (&X)[2][2], int lane) {
#pragma unroll
    for (int a = 0; a < 2; ++a)
#pragma unroll
        for (int c = 0; c < 2; ++c)
#pragma unroll
            for (int k = 0; k < 16; ++k) dst[((a * 2 + c) * 16 + k) * 64 + lane] = X[a][c][k];
}
__device__ __forceinline__ void scan_load_acc(const float* src, f32x16 (&X)[2][2], int lane) {
#pragma unroll
    for (int a = 0; a < 2; ++a)
#pragma unroll
        for (int c = 0; c < 2; ++c)
#pragma unroll
            for (int k = 0; k < 16; ++k) X[a][c][k] = src[((a * 2 + c) * 16 + k) * 64 + lane];
}
__device__ __forceinline__ void ph_scan_a(const int wid0, const Params& p, LAS unsigned char* lds) {
    PH_PROLOG;
    const int lane = LANE, wid = WID, half = lane >> 5, l32 = lane & 31;
    LAS unsigned char* L = lds + wid * SCAN_RING;
    for (int it = wid * (int)gridDim.x + (int)blockIdx.x; it < 128 * 16; it += NWAVE) {
        const int c = it >> 7, sid = it & 127, b = sid >> 4, h = (sid >> 1) & 7, d = sid & 1;
        f32x16 Q[2][2], P[2][2];
        scan_zero(Q);
        if (c == 0) {
            scan_run<false, true>(p, b, h, d, 0, SCAN_LC, Q, P, L, lane);
        } else {
#pragma unroll
            for (int a = 0; a < 2; ++a)
#pragma unroll
                for (int cc = 0; cc < 2; ++cc)
#pragma unroll
                    for (int k = 0; k < 16; ++k) P[a][cc][k] = (a == cc && l32 == ((k & 3) + 8 * (k >> 2) + 4 * half)) ? 1.f : 0.f;
            scan_run<true, false, true>(p, b, h, d, c * SCAN_LC, (c + 1) * SCAN_LC, Q, P, L, lane);
            if (c == 15) continue;
            float* pm = p.PMAT + ((size_t)sid * 16 + c) * 4096;
#pragma unroll
            for (int a = 0; a < 2; ++a)
#pragma unroll
                for (int cc = 0; cc < 2; ++cc)
#pragma unroll
                    for (int k = 0; k < 16; ++k)
                        pm[(cc * 32 + (k & 3) + 8 * (k >> 2) + 4 * half) * 64 + a * 32 + l32] = P[a][cc][k];
        }
        scan_store_acc(p.QMAT + ((size_t)sid * 16 + c) * 4096, Q, lane);
    }
}
__device__ __forceinline__ void ph_scan_b(const int wid0, const Params& p) {
    PH_PROLOG;
    const int lane = LANE, wid = WID, half = lane >> 5, l32 = lane & 31;
    const bool packed = gridDim.x == 256;
    if (packed && ((blockIdx.x >> 3) & 7) != 7) return;
    for (int it = packed ? (((int)blockIdx.x >> 6) * 8 + ((int)blockIdx.x & 7)) * 8 + wid : wid * (int)gridDim.x + (int)blockIdx.x; it < 256; it += packed ? 256 : NWAVE) {
        const int sid = it >> 1, ib = it & 1;
        f32x16 X[2];
        { const float* q0 = p.QMAT + ((size_t)sid * 16 + 0) * 4096;
#pragma unroll
          for (int c = 0; c < 2; ++c)
#pragma unroll
              for (int k = 0; k < 16; ++k) X[c][k] = q0[((ib * 2 + c) * 16 + k) * 64 + lane]; }
        for (int c = 1; c < 15; ++c) {
            const float* qc = p.QMAT + ((size_t)sid * 16 + c) * 4096 + lane; const float* pm = p.PMAT + ((size_t)sid * 16 + c) * 4096 + l32 * 64 + 4 * half;
            f32x16 N[2]; f32x4 A0[2][4], A1[2][4];
#pragma unroll
            for (int cc = 0; cc < 2; ++cc)
#pragma unroll
                for (int k = 0; k < 16; ++k) N[cc][k] = qc[((ib * 2 + cc) * 16 + k) * 64];
#pragma unroll
            for (int jb = 0; jb < 2; ++jb)
#pragma unroll
                for (int kq = 0; kq < 4; ++kq) { A0[jb][kq] = *(const f32x4*)(pm + jb * 32 + 8 * kq); A1[jb][kq] = *(const f32x4*)(pm + 32 * 64 + jb * 32 + 8 * kq); }
            float* sm = p.SMAT + ((size_t)sid * 16 + c) * 4096 + lane;
#pragma unroll
            for (int cc = 0; cc < 2; ++cc)
#pragma unroll
                for (int k = 0; k < 16; ++k) sm[((ib * 2 + cc) * 16 + k) * 64] = X[cc][k];
#pragma unroll
            for (int jb = 0; jb < 2; ++jb)
#pragma unroll
                for (int k = 0; k < 16; ++k) { N[0] = MFMA_F32(A0[jb][k >> 2][k & 3], X[jb][k], N[0]); N[1] = MFMA_F32(A1[jb][k >> 2][k & 3], X[jb][k], N[1]); }
            X[0] = N[0]; X[1] = N[1];
        }
        {   float* sm = p.SMAT + ((size_t)sid * 16 + 15) * 4096 + lane;
#pragma unroll
            for (int cc = 0; cc < 2; ++cc)
#pragma unroll
                for (int k = 0; k < 16; ++k) sm[((ib * 2 + cc) * 16 + k) * 64] = X[cc][k]; }
    }
}
__device__ __forceinline__ void ph_scan_c(const int wid0, const Params& p, LAS unsigned char* lds) {
    PH_PROLOG;
    (void)lds;
    const int lane = LANE, wid = WID, half = lane >> 5, l32 = lane & 31;
    for (int it = wid * (int)gridDim.x + (int)blockIdx.x; it < 128 * 15; it += NWAVE) {
        const int c = 1 + (it >> 7), sid = it & 127;
        f32x16 S[2][2];
        scan_load_acc(p.SMAT + ((size_t)sid * 16 + c) * 4096, S, lane);
        float* ys = p.YS + ((size_t)sid * 2304 + c * SCAN_LC) * 64;
        const bf16_t* zs = p.ZB + ((size_t)sid * 2304 + c * SCAN_LC) * 64;
#pragma unroll 1
        for (int tb = 0; tb < (SCAN_LC + 31) / 32; ++tb) {
            const int t = tb * 32 + l32;
            float za[2][16];
#pragma unroll
            for (int jb = 0; jb < 2; ++jb)
#pragma unroll
                for (int g = 0; g < 4; ++g) {
                    u32x2 w = *(const u32x2*)(zs + (size_t)min(t, SCAN_LC - 1) * 64 + jb * 32 + 8 * g + 4 * half);
                    if (t >= SCAN_LC) w = (u32x2){0u, 0u};
                    za[jb][4 * g] = __uint_as_float(w.x << 16); za[jb][4 * g + 1] = __uint_as_float(w.x & 0xffff0000u);
                    za[jb][4 * g + 2] = __uint_as_float(w.y << 16); za[jb][4 * g + 3] = __uint_as_float(w.y & 0xffff0000u);
                }
            f32x16 D[2];
#pragma unroll
            for (int ib = 0; ib < 2; ++ib)
#pragma unroll
                for (int k = 0; k < 16; ++k) { const int tk = tb * 32 + (k & 3) + 8 * (k >> 2) + 4 * half; D[ib][k] = ys[(size_t)min(tk, SCAN_LC - 1) * 64 + ib * 32 + l32]; }
#pragma unroll
            for (int ib = 0; ib < 2; ++ib)
#pragma unroll
                for (int jb = 0; jb < 2; ++jb)
#pragma unroll
                    for (int k = 0; k < 16; ++k) D[ib] = MFMA_F32(za[jb][k], S[ib][jb][k], D[ib]);
#pragma unroll
            for (int ib = 0; ib < 2; ++ib)
#pragma unroll
                for (int k = 0; k < 16; ++k) { const int tk = tb * 32 + (k & 3) + 8 * (k >> 2) + 4 * half; if (k < 8 || tb * 32 + 16 < SCAN_LC) ys[(size_t)tk * 64 + ib * 32 + l32] = D[ib][k]; }
        }
    }
}

__device__ __forceinline__ void ph_rwkv_out(const int wid0, const Params& p, int l) {
    PH_PROLOG;
    const float* r_k = p.in[27] + l * 512; const float* ln_w = p.in[28] + l * 512; const float* ln_b = p.in[29] + l * 512;
    const int lane = LANE, hd = lane >> 3, j0 = (lane & 7) * 8;
    const int nrows = (l == DEPTH - 1) ? T : TT;
    float c_rk[8], c_lw[8], c_lb[8];
    ldf8(r_k + 8 * lane, c_rk); ldf8(ln_w + 8 * lane, c_lw); ldf8(ln_b + 8 * lane, c_lb);
    for (int r0 = GWAVE; r0 < nrows; r0 += 2 * NWAVE) {
        f32x4 ya[2][2], yc[2][2], r4[2][2]; u32x4 wv[2], wkf[2], wkb[2], wg[2];
#pragma unroll
        for (int u = 0; u < 2; ++u) {
            const int r = min(r0 + u * NWAVE, nrows - 1);
            int b, pf; row_bpos(r, b, pf); const int pr = pos_rev(pf);
            const float* yf = p.YS + ((size_t)((b * 8 + hd) * 2 + 0) * 2304 + pf) * 64 + j0; const float* yb = p.YS + ((size_t)((b * 8 + hd) * 2 + 1) * 2304 + pr) * 64 + j0;
            const char* rec1 = p.R1 + ((size_t)(b * 8 + hd) * 2304 + pf) * R1B;
            const char* rf = p.R2 + ((size_t)((b * 8 + hd) * 2 + 0) * 2304 + pf) * R2B + 384; const char* rb = p.R2 + ((size_t)((b * 8 + hd) * 2 + 1) * 2304 + pr) * R2B + 384;
#pragma unroll
            for (int q = 0; q < 2; ++q) { ya[u][q] = *(const f32x4*)(yf + 4 * q); yc[u][q] = *(const f32x4*)(yb + 4 * q); r4[u][q] = *(const f32x4*)(rec1 + 256 + (j0 + 4 * q) * 4); }
            wv[u] = *(const u32x4*)((const bf16_t*)(rec1 + 512) + j0); wkf[u] = *(const u32x4*)((const bf16_t*)rf + j0); wkb[u] = *(const u32x4*)((const bf16_t*)rb + j0);
            wg[u] = *(const u32x4*)(p.GRW + (size_t)r * 512 + 8 * lane);
        }
#pragma unroll
        for (int u = 0; u < 2; ++u) {
            const int r = r0 + u * NWAVE;
            if (r < nrows) {
                float y[8], rr[8], kf[8], kb[8], vv[8], gg[8];
#pragma unroll
                for (int q = 0; q < 2; ++q)
#pragma unroll
                    for (int k = 0; k < 4; ++k) { y[4 * q + k] = ya[u][q][k] + yc[u][q][k]; rr[4 * q + k] = r4[u][q][k]; }
                unpack8(wv[u], vv); unpack8(wkf[u], kf); unpack8(wkb[u], kb); unpack8(wg[u], gg);
                float s = 0.f; for (int k = 0; k < 8; ++k) s += y[k]; s = sum8(s); const float mu = s * (1.0f / 64.0f);
                float q = 0.f; for (int k = 0; k < 8; ++k) { const float dlt = y[k] - mu; q += dlt * dlt; } q = sum8(q);
                const float rstd = rsqrtf(q * (1.0f / 64.0f) + 64e-5f);
                float bc = 0.f; for (int k = 0; k < 8; ++k) bc += rr[k] * (kf[k] + kb[k]) * c_rk[k]; bc = sum8(bc);
                float out[8];
                for (int k = 0; k < 8; ++k) out[k] = ((y[k] - mu) * rstd * c_lw[k] + c_lb[k] + bc * vv[k]) * gg[k];
                store8(p.Y + (size_t)r * 2048 + 1536 + 8 * lane, out);
            }
        }
    }
}

__device__ __forceinline__ void ph_moe_router(const int wid0, const Params& p, int l, LAS unsigned char* lds) {
    PH_PROLOG;
    LAS float* wr = (LAS float*)lds;
    const float* wsrc = p.in[32] + (size_t)l * 2048 * 16;
    for (int i = TID; i < 2048 * 16; i += 512) { const int c = i >> 4, e = i & 15; wr[e * 2048 + c] = wsrc[i]; }
    __syncthreads();
    const float* g = p.in[7] + l * 2048;
    const float* modl = p.MOD + (size_t)l * 9 * 12288;
    const int lane = LANE;
    const int nrows = (l == 0) ? TT : T;
    for (int r0 = GWAVE; r0 < nrows; r0 += 2 * NWAVE) {
        const int r1 = r0 + NWAVE; const bool has1 = r1 < nrows; const int r1c = has1 ? r1 : r0;
        const float* src0 = p.XCUR + (size_t)r0 * 2048; const float* src1 = p.XCUR + (size_t)r1c * 2048;
        f32x4 v0[8], v1[8]; float ss0 = 0.f, ss1 = 0.f;
#pragma unroll
        for (int i = 0; i < 8; ++i) { v0[i] = *(const f32x4*)(src0 + i * 256 + lane * 4); v1[i] = *(const f32x4*)(src1 + i * 256 + lane * 4); }
#pragma unroll
        for (int i = 0; i < 8; ++i) { ss0 += v0[i][0] * v0[i][0] + v0[i][1] * v0[i][1] + v0[i][2] * v0[i][2] + v0[i][3] * v0[i][3]; ss1 += v1[i][0] * v1[i][0] + v1[i][1] * v1[i][1] + v1[i][2] * v1[i][2] + v1[i][3] * v1[i][3]; }
        ss0 = wave_sum(ss0); ss1 = wave_sum(ss1);
        const float rs0 = rsqrtf(ss0 * (1.0f / 2048.0f) + NORM_EPS), rs1 = rsqrtf(ss1 * (1.0f / 2048.0f) + NORM_EPS);
        const float* ms0 = modl + (size_t)row_s(r0) * 12288; const float* ms1 = modl + (size_t)row_s(r1c) * 12288;
#pragma unroll
        for (int i = 0; i < 8; ++i) {
            const int c = i * 256 + lane * 4;
            const f32x4 gg = *(const f32x4*)(g + c);
            const f32x4 sh0 = *(const f32x4*)(ms0 + 3 * 2048 + c), sc0 = *(const f32x4*)(ms0 + 4 * 2048 + c), sh1 = *(const f32x4*)(ms1 + 3 * 2048 + c), sc1 = *(const f32x4*)(ms1 + 4 * 2048 + c);
            v0[i] = v0[i] * rs0 * gg * (1.0f + sc0) + sh0; v1[i] = v1[i] * rs1 * gg * (1.0f + sc1) + sh1;
        }
#pragma unroll
        for (int i = 0; i < 8; ++i) { u32x2 w; w.x = pk2(v0[i][0], v0[i][1]); w.y = pk2(v0[i][2], v0[i][3]); *(u32x2*)(p.H2 + (size_t)r0 * 2048 + i * 256 + lane * 4) = w; }
        if (has1) {
#pragma unroll
            for (int i = 0; i < 8; ++i) { u32x2 w; w.x = pk2(v1[i][0], v1[i][1]); w.y = pk2(v1[i][2], v1[i][3]); *(u32x2*)(p.H2 + (size_t)r1 * 2048 + i * 256 + lane * 4) = w; }
        }
        float a0[16], a1[16];
#pragma unroll
        for (int e = 0; e < 16; ++e) {
            float t0 = 0.f, t1 = 0.f;
#pragma unroll
            for (int i = 0; i < 8; ++i) { const f32x4 w4 = *(const LAS f32x4*)(wr + e * 2048 + i * 256 + lane * 4);
                t0 += v0[i][0] * w4[0] + v0[i][1] * w4[1] + v0[i][2] * w4[2] + v0[i][3] * w4[3]; t1 += v1[i][0] * w4[0] + v1[i][1] * w4[1] + v1[i][2] * w4[2] + v1[i][3] * w4[3]; }
            asm volatile("" : "+v"(t0), "+v"(t1) :: "memory");
            a0[e] = t0; a1[e] = t1;
        }
#pragma unroll
        for (int u = 0; u < 2; ++u) {
            if (u == 1 && !has1) break;
            const int r = u ? r1 : r0;
            float a[16];
#pragma unroll
            for (int e = 0; e < 16; ++e) a[e] = u ? a1[e] : a0[e];
#pragma unroll
            for (int j = 0; j < 8; ++j) { const bool hi = lane & 32; const float keep = hi ? a[j + 8] : a[j], send = hi ? a[j] : a[j + 8]; a[j] = keep + __shfl_xor(send, 32); }
#pragma unroll
            for (int j = 0; j < 4; ++j) { const bool hi = lane & 16; const float keep = hi ? a[j + 4] : a[j], send = hi ? a[j] : a[j + 4]; a[j] = keep + __shfl_xor(send, 16); }
#pragma unroll
            for (int j = 0; j < 2; ++j) { const bool hi = lane & 8; const float keep = hi ? a[j + 2] : a[j], send = hi ? a[j] : a[j + 2]; a[j] = keep + __shfl_xor(send, 8); }
            { const bool hi = lane & 4; const float keep = hi ? a[1] : a[0], send = hi ? a[0] : a[1]; a[0] = keep + __shfl_xor(send, 4); }
            float lg = a[0]; lg += __shfl_xor(lg, 2); lg += __shfl_xor(lg, 1);
            float mx = lg;
            mx = fmaxf(mx, __shfl_xor(mx, 4)); mx = fmaxf(mx, __shfl_xor(mx, 8)); mx = fmaxf(mx, __shfl_xor(mx, 16)); mx = fmaxf(mx, __shfl_xor(mx, 32));
            const float ex = expf(lg - mx);
            float sum = ex;
            sum += __shfl_xor(sum, 4); sum += __shfl_xor(sum, 8); sum += __shfl_xor(sum, 16); sum += __shfl_xor(sum, 32);
            const float mine = ex / sum;
            const int myexp = (lane >> 2) & 15;
            if ((lane & 3) == 0) {
                if (r < T) p.AFFT[((size_t)((r >> 11) * 16 + myexp)) * 2048 + (r & 2047)] = mine;
                else p.AFFC[((size_t)(((r - T) >> 8) * 16 + myexp)) * 256 + ((r - T) & 255)] = mine;
            }
        }
    }
}
__device__ __forceinline__ void ph_topk(const int wid0, const Params& p, int l, LAS unsigned char* lds) {
    PH_PROLOG;
    const int tid = TID, lane = tid & 63, wid = tid >> 6;
    LAS unsigned* keys = (LAS unsigned*)lds;
    LAS int* hist = (LAS int*)(lds + 8192);
    LAS int* hs2 = (LAS int*)(lds + 8192 + 1024);
    LAS int* ctl = (LAS int*)(lds + 8192 + 2048);
    LAS int* wsum = (LAS int*)(lds + 8192 + 2048 + 64);
    LAS int* lidx = (LAS int*)(lds + 8192 + 4096);
    const int nun = (l == 0) ? 256 : 128;
    for (int u = blockIdx.x; u < nun; u += gridDim.x) {
        const bool isctx = u >= 128; const int be = u & 127, b = be >> 4, e = be & 15;
        const int N = isctx ? 256 : 2048, cap = isctx ? 32 : 256;
        const float* src = isctx ? p.AFFC + (size_t)be * 256 : p.AFFT + (size_t)be * 2048;
        __syncthreads();
        for (int i = tid; i < N; i += 512) keys[i] = __float_as_uint(src[i]);
        if (tid == 0) { ctl[0] = 0; ctl[1] = cap; }
        __syncthreads();
        for (int pass = 0; pass < 4; ++pass) {
            const int shift = 24 - 8 * pass;
            if (tid < 256) hist[tid] = 0;
            __syncthreads();
            const unsigned prefix = (unsigned)ctl[0]; const int krem = ctl[1];
            for (int i = tid; i < N; i += 512) { const unsigned k = keys[i]; if (pass == 0 || (k >> (shift + 8)) == (prefix >> (shift + 8))) __hip_atomic_fetch_add(&hist[(k >> shift) & 255u], 1, __ATOMIC_RELAXED, __HIP_MEMORY_SCOPE_WORKGROUP); }
            __syncthreads();
            LAS int* a = hist; LAS int* bb = hs2;
            for (int off = 1; off < 256; off <<= 1) {
                if (tid < 256) bb[tid] = a[tid] + ((tid + off < 256) ? a[tid + off] : 0);
                __syncthreads();
                LAS int* t = a; a = bb; bb = t;
            }
            if (tid < 256) { const int S = a[tid], Sn = (tid < 255) ? a[tid + 1] : 0; if (S >= krem && Sn < krem) { ctl[0] = (int)(prefix | ((unsigned)tid << shift)); ctl[1] = krem - Sn; } }
            __syncthreads();
        }
        const unsigned Tk = (unsigned)ctl[0]; const int need = ctl[1], ngt = cap - need;
        const int per = isctx ? 1 : 4, i0 = tid * per;
        int cg = 0, ce = 0;
        if (i0 < N) for (int k = 0; k < per; ++k) { const unsigned kk = keys[i0 + k]; cg += (kk > Tk); ce += (kk == Tk); }
        int pk = cg | (ce << 16), incl = pk;
#pragma unroll
        for (int o = 1; o < 64; o <<= 1) { const int t = __shfl_up(incl, o); if (lane >= o) incl += t; }
        if (lane == 63) wsum[wid] = incl;
        __syncthreads();
        int base = 0;
        for (int w = 0; w < wid; ++w) base += wsum[w];
        int ex = base + incl - pk, pg = ex & 0xffff, pe = ex >> 16;
        if (i0 < N) for (int k = 0; k < per; ++k) {
            const int i = i0 + k; const unsigned kk = keys[i];
            const int trow = isctx ? (T + b * 256 + i) : (b * 2048 + i);
            int slot = -1;
            if (kk > Tk) { slot = pg; ++pg; } else if (kk == Tk) { if (pe < need) slot = ngt + pe; ++pe; }
            int xrow = -1;
            if (slot >= 0) { xrow = isctx ? ((128 + e) * 256 + b * 32 + slot) : ((e * 8 + b) * 256 + slot); p.IDXROW[xrow] = trow; p.GATEV[xrow] = __uint_as_float(kk); }
            p.SEL[(size_t)trow * 16 + e] = xrow;
        }
    }
}
__device__ __forceinline__ void ph_gather(const int wid0, const Params& p, int l) {
    PH_PROLOG;
    const int nrows = (l == 0) ? XE_ROWS : 128 * 256; const int lane = LANE;
    for (int r = GWAVE; r < nrows; r += NWAVE) {
        const bf16_t* src = p.H2 + (size_t)p.IDXROW[r] * 2048; bf16_t* dst = p.XE + (size_t)r * 2048;
#pragma unroll
        for (int k = 0; k < 4; ++k) *(u32x4*)(dst + (k * 64 + lane) * 8) = *(const u32x4*)(src + (k * 64 + lane) * 8);
    }
}
__device__ __forceinline__ void ph_combine(const int wid0, const Params& p, int l) {
    PH_PROLOG;
    const float* modl = p.MOD + (size_t)l * 9 * 12288; const int lane = LANE;
    const int nrows = (l == 0) ? TT : T;
    const float* g1n = p.in[6] + (l + 1 < DEPTH ? (l + 1) * 2048 : 0);
    const float* modn = p.MOD + (size_t)(l + 1 < DEPTH ? l + 1 : l) * 9 * 12288;
    int seln0 = (lane < 16 && GWAVE < nrows) ? p.SEL[(size_t)GWAVE * 16 + lane] : -1;
    int seln1 = (lane < 16 && GWAVE + NWAVE < nrows) ? p.SEL[(size_t)(GWAVE + NWAVE) * 16 + lane] : -1;
    for (int r0 = GWAVE; r0 < nrows; r0 += 2 * NWAVE) {
        const int r1 = r0 + NWAVE; const bool has1 = r1 < nrows; const int r1c = has1 ? r1 : r0;
        const int sel0 = seln0, sel1 = seln1;
        { const int ra = r0 + 2 * NWAVE, rb = r0 + 3 * NWAVE; seln0 = (lane < 16 && ra < nrows) ? p.SEL[(size_t)ra * 16 + lane] : -1; seln1 = (lane < 16 && rb < nrows) ? p.SEL[(size_t)rb * 16 + lane] : -1; }
        float* xp0 = p.XCUR + (size_t)r0 * 2048; float* xp1 = p.XCUR + (size_t)r1c * 2048;
        const float* g20 = modl + (size_t)row_s(r0) * 12288 + 5 * 2048; const float* g21 = modl + (size_t)row_s(r1c) * 12288 + 5 * 2048;
        f32x4 xv0[8], xv1[8];
#pragma unroll
        for (int i = 0; i < 8; ++i) { const int c = (i >> 1) * 512 + lane * 8 + (i & 1) * 4; xv0[i] = *(const f32x4*)(xp0 + c); xv1[i] = *(const f32x4*)(xp1 + c); }
        float acc0[32], acc1[32];
#pragma unroll
        for (int k = 0; k < 32; ++k) { acc0[k] = 0.f; acc1[k] = 0.f; }
        unsigned m0 = (unsigned)__ballot(sel0 >= 0) & 0xffffu, m1 = (unsigned)__ballot(sel1 >= 0) & 0xffffu;
        while (m0 | m1) {
            const bool h0 = m0 != 0, h1 = m1 != 0;
            const int e0 = h0 ? __builtin_ctz(m0) : 0, e1 = h1 ? __builtin_ctz(m1) : 0;
            m0 &= m0 - 1; m1 &= m1 - 1;
            const int x0 = __shfl(sel0, e0), x1 = __shfl(sel1, e1);
            const bf16_t* ya = p.YE + (size_t)(h0 ? x0 : 0) * 2048 + lane * 8; const bf16_t* yb = p.YE + (size_t)(h1 ? x1 : 0) * 2048 + lane * 8;
            u32x4 wa[4], wb[4];
#pragma unroll
            for (int i = 0; i < 4; ++i) { wa[i] = *(const u32x4*)(ya + i * 512); wb[i] = *(const u32x4*)(yb + i * 512); }
            if (h0) {
#pragma unroll
                for (int i = 0; i < 4; ++i) { float f[8]; unpack8(wa[i], f);
#pragma unroll
                    for (int k = 0; k < 8; ++k) acc0[i * 8 + k] += f[k]; }
            }
            if (h1) {
#pragma unroll
                for (int i = 0; i < 4; ++i) { float f[8]; unpack8(wb[i], f);
#pragma unroll
                    for (int k = 0; k < 8; ++k) acc1[i * 8 + k] += f[k]; }
            }
        }
#pragma unroll
        for (int u = 0; u < 2; ++u) {
            if (u == 1 && !has1) break;
            const int r = u ? r1 : r0; float* xp = u ? xp1 : xp0;
            float* acc = u ? acc1 : acc0;
            f32x4 gv[8];
            { const float* g2 = u ? g21 : g20;
#pragma unroll
              for (int i = 0; i < 8; ++i) gv[i] = *(const f32x4*)(g2 + (i >> 1) * 512 + lane * 8 + (i & 1) * 4); }
            float ss = 0.f;
#pragma unroll
            for (int i = 0; i < 4; ++i)
#pragma unroll
                for (int hh = 0; hh < 2; ++hh) {
                    const int c = i * 512 + lane * 8 + hh * 4;
                    f32x4 x = u ? xv1[i * 2 + hh] : xv0[i * 2 + hh]; const f32x4 g = gv[i * 2 + hh];
#pragma unroll
                    for (int k = 0; k < 4; ++k) { x[k] += g[k] * acc[i * 8 + hh * 4 + k]; acc[i * 8 + hh * 4 + k] = x[k]; ss += x[k] * x[k]; }
                    if (l == DEPTH - 1) *(f32x4*)(p.out + (size_t)r * 2048 + c) = x; else *(f32x4*)(xp + c) = x;
                }
            if (l + 1 < DEPTH) {
                ss = wave_sum(ss);
                const float rs = rsqrtf(ss * (1.0f / 2048.0f) + NORM_EPS);
                const float* ms = modn + (size_t)row_s(r) * 12288;
#pragma unroll
                for (int i = 0; i < 4; ++i) {
                    const int c = i * 512 + lane * 8;
#pragma unroll
                    for (int hh = 0; hh < 2; ++hh) {
                        const f32x4 gg = *(const f32x4*)(g1n + c + hh * 4), sh = *(const f32x4*)(ms + c + hh * 4), sc = *(const f32x4*)(ms + 2048 + c + hh * 4);
#pragma unroll
                        for (int k = 0; k < 4; ++k) acc[i * 8 + hh * 4 + k] = acc[i * 8 + hh * 4 + k] * rs * gg[k] * (1.0f + sc[k]) + sh[k];
                    }
                }
#pragma unroll
                for (int i = 0; i < 4; ++i) store8(p.H + (size_t)r * 2048 + i * 512 + lane * 8, acc + i * 8);
            }
        }
    }
}

#define XB_TMO      128
#define XB_XCNT(j)  (256  + 64 * (j))
#define XB_XSUB(j)  (1280 + 64 * (j))
#define XB_XGEN(j)  (2304 + 64 * (j))
#define XB_TOP      3328
#define XB_TOPGEN   3392
#define XCD_BAR_WORDS 3456
#define XB_SPIN_CAP (1u << 22)
__device__ __forceinline__ unsigned xb_ld(unsigned* p)              { return __hip_atomic_load(p, __ATOMIC_RELAXED, __HIP_MEMORY_SCOPE_AGENT); }
__device__ __forceinline__ unsigned xb_add(unsigned* p, unsigned v) { return __hip_atomic_fetch_add(p, v, __ATOMIC_RELAXED, __HIP_MEMORY_SCOPE_AGENT); }
__device__ __forceinline__ unsigned xb_xcc_id() { return (unsigned)__builtin_amdgcn_s_getreg((3 << 11) | 20) & 0xFu; }
#define XB_SPIN(cond, bar) do { unsigned _sp = 0; while (cond) { __builtin_amdgcn_s_sleep(1); \
    if ((++_sp & 255u) == 0u) { if (xb_ld(&(bar)[XB_TMO])) break; if (_sp > XB_SPIN_CAP) { atomicAdd(&(bar)[XB_TMO], 1u); break; } } } } while (0)
struct XcdBarrier { unsigned* bar; unsigned x; volatile LAS unsigned* st; int wid0; };
__device__ __forceinline__ bool xb_leader(int wid0) { return wid0 == 0 && opaque_lane() == 0; }
__device__ __forceinline__ XcdBarrier xcd_barrier_post(unsigned* bar, volatile LAS unsigned* st, int wid0) {
    XcdBarrier b; b.bar = bar; b.x = xb_xcc_id(); b.st = st; b.wid0 = wid0;
    if (xb_leader(wid0)) (void)xb_add(&bar[XB_XCNT(b.x)], 1u);
    return b;
}
__device__ __forceinline__ void xcd_barrier_complete(unsigned* bar, unsigned x, unsigned& nloc, unsigned& nx) {
    const unsigned G = gridDim.x * gridDim.y * gridDim.z;
    unsigned sum, cnt, mine, sp = 0u;
    for (;;) {
        sum = 0u; cnt = 0u; mine = 0u;
#pragma unroll
        for (unsigned j = 0; j < 16; ++j) { const unsigned c = xb_ld(&bar[XB_XCNT(j)]); sum += c; cnt += (c > 0u) ? 1u : 0u; mine = (j == x) ? c : mine; }
        if (sum == G) break;
        __builtin_amdgcn_s_sleep(1);
        if ((++sp & 255u) == 0u) { if (xb_ld(&bar[XB_TMO])) break; if (sp > XB_SPIN_CAP) { atomicAdd(&bar[XB_TMO], 1u); break; } }
    }
    nloc = mine > 0u ? mine : 1u; nx = cnt > 0u ? cnt : 1u;
}
__device__ __forceinline__ void xcd_barrier(const XcdBarrier& b) {
    asm volatile("s_waitcnt vmcnt(0)" ::: "memory");
    __syncthreads();
    if (xb_leader(b.wid0)) {
        unsigned* bar = b.bar;
        __builtin_amdgcn_s_waitcnt(0);
        unsigned nloc = b.st[0], nx = b.st[1];
        if (nloc == 0u) { xcd_barrier_complete(bar, b.x, nloc, nx); b.st[0] = nloc; b.st[1] = nx; }
        const unsigned old = xb_add(&bar[XB_XSUB(b.x)], 1u);
        const unsigned gen = old / nloc;
        if (old + 1u == (gen + 1u) * nloc) {
            __builtin_amdgcn_fence(__ATOMIC_RELEASE, "agent");
            asm volatile("s_waitcnt vmcnt(0)" ::: "memory");
            const unsigned og = xb_add(&bar[XB_TOP], 1u);
            const unsigned tg = og / nx;
            if (og + 1u == (tg + 1u) * nx) xb_add(&bar[XB_TOPGEN], 1u);
            else XB_SPIN(xb_ld(&bar[XB_TOPGEN]) == tg, bar);
            __builtin_amdgcn_fence(__ATOMIC_ACQUIRE, "agent");
            xb_add(&bar[XB_XGEN(b.x)], 1u);
            asm volatile("s_waitcnt vmcnt(0)" ::: "memory");
        } else {
            XB_SPIN(xb_ld(&bar[XB_XGEN(b.x)]) == gen, bar);
            __builtin_amdgcn_fence(__ATOMIC_ACQUIRE, "agent");
            asm volatile("s_waitcnt vmcnt(0)" ::: "memory");
        }
    }
    __syncthreads();
}

enum { PH_ADALN_P = 0, PH_ADALN_R, PH_CONST, PH_CVT_MIX, PH_MODULATE, PH_GEMM_WIN, PH_PREPA, PH_GEMM_LORA, PH_GEMM_FCHAN, PH_GEMM_UQ, PH_GEMM_UKV, PH_PREPB,
       PH_MLA, PH_NA, PH_SCAN, PH_SCAN_A, PH_SCAN_B, PH_SCAN_C, PH_GEMM_WIN_DEFER, PH_RWKV_OUT, PH_GEMM_FSEQ, PH_GEMM_FSEQC, PH_GEMM_MERGE, PH_GEMM_WOUT, PH_CVT_MOE, PH_ROUTER, PH_TOPK, PH_GATHER, PH_GEMM_MOE1, PH_GEMM_MOE2, PH_COMBINE };

template <int PH> __device__ __forceinline__ void run_phase(const int wid0, const Params& p, int l, LAS unsigned char* lds, int blk0 = 0, int nblk = 0) {
    const int G = nblk ? nblk : (int)gridDim.x, c = (int)blockIdx.x - blk0;
    if constexpr (PH == PH_ADALN_P) ph_adaln_partial(wid0, p, lds);
    else if constexpr (PH == PH_ADALN_R) ph_adaln_reduce(wid0, p);
    else if constexpr (PH == PH_CONST) ph_const(wid0, p);
    else if constexpr (PH == PH_CVT_MIX) ph_cvt_mixer(wid0, p, l, lds, 3, (int)blockIdx.x, (int)gridDim.x);
    else if constexpr (PH == PH_MODULATE) ph_modulate(wid0, p, l, p.H);
    else if constexpr (PH == PH_GEMM_WIN || PH == PH_GEMM_WIN_DEFER) {
        pg8::SchedRects S{(const char*)p.H, (const char*)p.WIN_T, 256L * 2048 * 2, 256L * 2048 * 2, G, c, {{0, 0, 0, 0}, {0, 0, 0, 0}, {0, 0, 0, 0}}};
        constexpr bool DEF = (PH == PH_GEMM_WIN_DEFER);
        if (l == 0) {
            if (!DEF) { S.r[0][0] = 0; S.r[0][1] = 69; S.r[0][2] = 0; S.r[0][3] = 51;  S.r[1][0] = 69; S.r[1][1] = 1; S.r[1][2] = 0; S.r[1][3] = 27;  S.r[2][0] = 70; S.r[2][1] = 2; S.r[2][2] = 0; S.r[2][3] = 19; }
            else      { S.r[0][0] = 69; S.r[0][1] = 1; S.r[0][2] = 27; S.r[0][3] = 24;  S.r[1][0] = 70; S.r[1][1] = 2; S.r[1][2] = 19; S.r[1][3] = 32; }
        } else {
            if (!DEF) { S.r[0][0] = 0; S.r[0][1] = 63; S.r[0][2] = 0; S.r[0][3] = 51;  S.r[1][0] = 63; S.r[1][1] = 1; S.r[1][2] = 0; S.r[1][3] = 35;  S.r[2][0] = 64; S.r[2][1] = 8; S.r[2][2] = 0; S.r[2][3] = 10; }
            else      { S.r[0][0] = 63; S.r[0][1] = 1; S.r[0][2] = 35; S.r[0][3] = 16; }
        }
        EpiWin E{p.ZS, p.G};
        pg8::gemm_phase(wid0, lds, 2048, 2048, 2048, S, E);
    } else if constexpr (PH == PH_PREPA) ph_prepA(wid0, p, l);
    else if constexpr (PH == PH_GEMM_LORA) {
        pg8::Sched2D S{(const char*)p.LA, (const char*)p.WLORA_T, 256L * 256 * 2, 256L * 256 * 2, 0, TT / 256, 2560 / 256, G, c, 0};
        EpiLora E{p.in[20] + l * 1024, p.in[22] + l * 1024, p.in[26] + l * 512, p.RK, p.R1, p.R2, p.GRW, p.RBP};
        pg8::gemm_phase(wid0, lds, 256, 256, 256, S, E);
    } else if constexpr (PH == PH_GEMM_FCHAN) {
        pg8::Sched2D S{(const char*)p.WFC, (const char*)(p.ZS + 4128), 256L * 512 * 2, 256L * ZW * 2, 0, 1024 / 256, (l == DEPTH - 1) ? T / 256 : TT / 256, G, (c + 40) % G, 0};
        EpiFourChan E{p.XCS, p.XCSC};
        pg8::gemm_phase(wid0, lds, 512, 512, ZW, S, E);
    } else if constexpr (PH == PH_GEMM_UQ) {
        pg8::Sched2D S{(const char*)p.CQN, (const char*)p.WUQ_T, 256L * 512 * 2, 256L * 512 * 2, 0, (l == DEPTH - 1) ? T / 256 : TT / 256, 768 / 256, G, c, 0};
        EpiBf16 E{p.Q0, 768};
        pg8::gemm_phase(wid0, lds, 512, 512, 512, S, E);
    } else if constexpr (PH == PH_GEMM_UKV) {
        pg8::Sched2D S{(const char*)p.CKVN, (const char*)p.WUKV_T, 256L * 256 * 2, 256L * 256 * 2, 0, TT / 256, 1024 / 256, G, (c + 48) % G, 0};
        EpiBf16 E{p.KV0, 1024};
        pg8::gemm_phase(wid0, lds, 256, 256, 256, S, E);
    } else if constexpr (PH == PH_PREPB) ph_prepB(wid0, p, l);
    else if constexpr (PH == PH_MLA) ph_mla_flash(wid0, p, l, lds);
    else if constexpr (PH == PH_NA) ph_na_flash(wid0, p, l, lds);
    else if constexpr (PH == PH_SCAN_A) ph_scan_a(wid0, p, lds);
    else if constexpr (PH == PH_SCAN_B) ph_scan_b(wid0, p);
    else if constexpr (PH == PH_SCAN_C) ph_scan_c(wid0, p, lds);
    else if constexpr (PH == PH_RWKV_OUT) ph_rwkv_out(wid0, p, l);
    else if constexpr (PH == PH_GEMM_FSEQ) {
        pg8::Sched2D S{(const char*)p.ADFT, (const char*)p.XCS, 256L * 4096 * 2, 256L * 4096 * 2, 0, 2048 / 256, 4096 / 256, G, c, 0};
        EpiFourSeq E{p.Y, 0, 2048, 1.0f / 512.0f};
        pg8::gemm_phase(wid0, lds, 4096, 4096, 4096, S, E);
    } else if constexpr (PH == PH_GEMM_FSEQC) {
        pg8::Sched2D S{(const char*)p.ADFTC, (const char*)p.XCSC, 256L * 512 * 2, 256L * 512 * 2, 0, 1, 4096 / 256, G, (c + 40) % G, 0};
        EpiFourSeq E{p.Y, T, 256, 0.005524271728019903f};
        pg8::gemm_phase(wid0, lds, 512, 512, 512, S, E);
    } else if constexpr (PH == PH_GEMM_MERGE) {
        pg8::gemm_merge(wid0, lds, p.Y, p.WBR_T, p.G, p.ACCB, (l == DEPTH - 1) ? T / 256 : TT / 256, G, c);
    } else if constexpr (PH == PH_GEMM_WOUT) {
        pg8::Sched2D S{(const char*)p.ACCB, (const char*)p.WOUT_T, 256L * 2048 * 2, 256L * 2048 * 2, 0, (l == DEPTH - 1) ? T / 256 : TT / 256, 2048 / 256, G, c, 0};
        EpiWout E{p.XCUR, p.MOD + (size_t)l * 9 * 12288, (l == 0) ? p.in[0] : p.XCUR, (l == 0) ? p.in[2] - (size_t)T * 2048 : p.XCUR};
        pg8::gemm_phase(wid0, lds, 2048, 2048, 2048, S, E);
    } else if constexpr (PH == PH_CVT_MOE) ph_cvt_moe(wid0, p, l, lds, (l == 0 && gridDim.x == 256) ? 4 : 7, (int)blockIdx.x, (int)gridDim.x);
    else if constexpr (PH == PH_ROUTER) ph_moe_router(wid0, p, l, lds);
    else if constexpr (PH == PH_TOPK) ph_topk(wid0, p, l, lds);
    else if constexpr (PH == PH_GATHER) ph_gather(wid0, p, l);
    else if constexpr (PH == PH_GEMM_MOE1) {
        pg8::Sched2D S{(const char*)p.H2, (const char*)p.W13T, 0L, 256L * 2048 * 2, 2048L * 2048 * 2, (l == 0) ? 144 : 128, 2048 / 256, G, c, 1};
        EpiSwiglu E{p.HH};
        pg8::gemm_phase<EpiSwiglu, pg8::Sched2D, true>(wid0, lds, 2048, 2048, 2048, S, E, p.IDXROW);
    } else if constexpr (PH == PH_GEMM_MOE2) {
        pg8::Sched2D S{(const char*)p.HH, (const char*)p.W2T, 256L * 1024 * 2, 256L * 1024 * 2, 2048L * 1024 * 2, (l == 0) ? 144 : 128, 2048 / 256, G, c, 1};
        EpiMoeOut E{p.YE, p.GATEV};
        pg8::gemm_phase(wid0, lds, 1024, 1024, 1024, S, E);
    } else if constexpr (PH == PH_COMBINE) ph_combine(wid0, p, l);
}

template <int PH> __global__ void __launch_bounds__(512, 2) k_phase(Params p, int l) {
    extern __shared__ __attribute__((aligned(16))) unsigned char shm[];
    run_phase<PH>(__builtin_amdgcn_readfirstlane((int)threadIdx.x >> 6), p, l, (LAS unsigned char*)shm);
}


constexpr int LDS_BYTES = 147456;
#define PHASE(PH, L) do { run_phase<PH>(wid0, p, (L), lds); __syncthreads(); } while (0)
#define GBAR() xcd_barrier(xb)
template <int l> __device__ __forceinline__ void layer_body(const int wid0, const Params& p, LAS unsigned char* lds, const XcdBarrier& xb) {
    constexpr int DUP = (l == 0) ? PROBE_DUP : 0;
    if constexpr (DUP == 2) PHASE(PH_CVT_MIX, l);
    if constexpr (l == 0) {
        PHASE(PH_MODULATE, l);
        if constexpr (DUP == 3 || DUP == 11) PHASE(PH_MODULATE, l);
        GBAR();
    }
    PHASE(PH_GEMM_WIN, l);
    if constexpr (DUP == 1) PHASE(PH_GEMM_WIN, l);
    GBAR();
    PHASE(PH_PREPA, l);
    if constexpr (DUP == 3 || DUP == 11) PHASE(PH_PREPA, l);
    GBAR();
    PHASE(PH_GEMM_LORA, l); PHASE(PH_GEMM_FCHAN, l); PHASE(PH_GEMM_UQ, l); PHASE(PH_GEMM_UKV, l);
    if constexpr (DUP == 6 || DUP == 61) { PHASE(PH_GEMM_LORA, l); }
    if constexpr (DUP == 6 || DUP == 62) { PHASE(PH_GEMM_FCHAN, l); }
    if constexpr (DUP == 6 || DUP == 63) { PHASE(PH_GEMM_UQ, l); PHASE(PH_GEMM_UKV, l); }
    GBAR();
    PHASE(PH_PREPB, l);
    if constexpr (DUP == 3 || DUP == 12) PHASE(PH_PREPB, l);
    GBAR();
    PHASE(PH_SCAN_A, l);
    if constexpr (DUP == 5 || DUP == 16) PHASE(PH_SCAN_A, l);
    GBAR();
    PHASE(PH_SCAN_B, l); PHASE(PH_MLA, l); PHASE(PH_NA, l);
    if constexpr (DUP == 5) PHASE(PH_SCAN_B, l);
    if constexpr (DUP == 4) PHASE(PH_MLA, l);
    if constexpr (DUP == 4 || DUP == 41) PHASE(PH_NA, l);
    GBAR();
    PHASE(PH_SCAN_C, l);
    if (gridDim.x == 256) {
        if (blockIdx.x < 128) run_phase<PH_GEMM_FSEQ>(wid0, p, l, lds, 0, 128); else run_phase<PH_GEMM_WIN_DEFER>(wid0, p, l, lds, 128, 128);
        __syncthreads();
    } else { PHASE(PH_GEMM_FSEQ, l); PHASE(PH_GEMM_WIN_DEFER, l); }
    if constexpr (l == 0) PHASE(PH_GEMM_FSEQC, l);
    if constexpr (DUP == 5 || DUP == 18) PHASE(PH_SCAN_C, l);
    if constexpr (DUP == 6 || DUP == 64) { PHASE(PH_GEMM_FSEQ, l); PHASE(PH_GEMM_FSEQC, l); }
    GBAR();
    PHASE(PH_RWKV_OUT, l);
    if constexpr (DUP == 3 || DUP == 13) PHASE(PH_RWKV_OUT, l);
    GBAR();
    constexpr bool FILL = (l == 0);
    PHASE(PH_GEMM_MERGE, l);
    if constexpr (FILL) { if (gridDim.x == 256 && blockIdx.x >= 64) { ph_cvt_moe(wid0, p, l, lds, 1, (int)blockIdx.x - 64, 192); __syncthreads(); } }
    if constexpr (DUP == 7) PHASE(PH_GEMM_MERGE, l);
    GBAR();
    PHASE(PH_GEMM_WOUT, l);
    if constexpr (FILL) { if (gridDim.x == 256 && blockIdx.x >= 64) { ph_cvt_moe(wid0, p, l, lds, 2, (int)blockIdx.x - 64, 192); __syncthreads(); } }
    GBAR();
    PHASE(PH_CVT_MOE, l); PHASE(PH_ROUTER, l);
    if constexpr (DUP == 2) PHASE(PH_CVT_MOE, l);
    if constexpr (DUP == 3 || DUP == 14) PHASE(PH_ROUTER, l);
    GBAR();
    PHASE(PH_TOPK, l);
    if constexpr (DUP == 3 || DUP == 14) PHASE(PH_TOPK, l);
    GBAR();
    PHASE(PH_GEMM_MOE1, l);
    if constexpr (FILL && l + 1 < DEPTH) { if (gridDim.x == 256 && blockIdx.x >= 128) { ph_cvt_mixer(wid0, p, l + 1, lds, 1, (int)blockIdx.x - 128, 128); __syncthreads(); } }
    if constexpr (DUP == 8) PHASE(PH_GEMM_MOE1, l);
    GBAR();
    PHASE(PH_GEMM_MOE2, l);
    if constexpr (FILL && l + 1 < DEPTH) { if (gridDim.x == 256 && blockIdx.x >= 128) { ph_cvt_mixer(wid0, p, l + 1, lds, 2, (int)blockIdx.x - 128, 128); __syncthreads(); } }
    if constexpr (DUP == 8) PHASE(PH_GEMM_MOE2, l);
    GBAR();
    PHASE(PH_COMBINE, l);
    if constexpr (l + 1 < DEPTH) { if (!(FILL && gridDim.x == 256)) PHASE(PH_CVT_MIX, l + 1); }
    GBAR();
}
__global__ void __launch_bounds__(512, 2) k_mega(Params p) {
    extern __shared__ __attribute__((aligned(16))) unsigned char shm[];
    LAS unsigned char* lds = (LAS unsigned char*)shm;
    const int wid0 = __builtin_amdgcn_readfirstlane((int)threadIdx.x >> 6);
    volatile LAS unsigned* xw = (volatile LAS unsigned*)(lds + LDS_BYTES - 16);
    if (xb_leader(wid0)) { xw[0] = 0u; xw[1] = 0u; xw[2] = 0u; xw[3] = 0u; }
    __syncthreads();
    XcdBarrier xb = xcd_barrier_post(p.bar, xw, wid0);
    PHASE(PH_ADALN_P, 0); PHASE(PH_CONST, 0);
    if (gridDim.x == 256) {
        if (blockIdx.x < 192) { ph_cvt_mixer(wid0, p, 0, lds, 3, (int)blockIdx.x, 320); }
        else { ph_cvt_mixer(wid0, p, 0, lds, 3, 192 + 2 * ((int)blockIdx.x - 192), 320); __syncthreads(); ph_cvt_mixer(wid0, p, 0, lds, 3, 193 + 2 * ((int)blockIdx.x - 192), 320); }
        __syncthreads();
    } else { PHASE(PH_CVT_MIX, 0); }
    GBAR();
    PHASE(PH_ADALN_R, 0);
    GBAR();
    layer_body<0>(wid0, p, lds, xb);
    layer_body<1>(wid0, p, lds, xb);
}

static inline size_t al256(size_t x) { return (x + 255) & ~(size_t)255; }

template <int PH> static void launch(const Params& p, int l, hipStream_t st) {
    static bool attr = false;
    if (!attr) { (void)hipFuncSetAttribute((const void*)k_phase<PH>, hipFuncAttributeMaxDynamicSharedMemorySize, LDS_BYTES); attr = true; }
    hipLaunchKernelGGL((k_phase<PH>), dim3(256), dim3(512), LDS_BYTES, st, p, l);
}

extern "C" void kernel_launch(void* const* d_in, const int* in_sizes, int n_in, void* d_out, int out_size, void* d_ws, size_t ws_size, hipStream_t stream) {
    Params p;
    memset(&p, 0, sizeof(p));
    for (int i = 0; i < 36; ++i) p.in[i] = (const float*)d_in[i];
    p.out = (float*)d_out;
    char* ws = (char*)d_ws; size_t off = 0;
    auto take = [&](size_t bytes) { char* r = ws + off; off = al256(off + bytes); return r; };
    p.bar = (unsigned*)take(16384);
    p.MOD = (float*)take((size_t)2 * 9 * 12288 * 4);
    p.MODP = (float*)take((size_t)16 * 2 * 9 * 12288 * 4);
    p.XCUR = (float*)take((size_t)TT * 2048 * 4);
    p.WIN_T = (bf16_t*)take((size_t)ZN * 2048 * 2);
    p.WBR_T = (bf16_t*)take((size_t)4 * 2048 * 512 * 2);
    p.WOUT_T = (bf16_t*)take((size_t)2048 * 2048 * 2);
    p.WUQ_T = (bf16_t*)take((size_t)768 * 512 * 2);
    p.WUKV_T = (bf16_t*)take((size_t)1024 * 256 * 2);
    p.WLORA_T = (bf16_t*)take((size_t)2560 * 256 * 2);
    p.WFC = (bf16_t*)take((size_t)1024 * 512 * 2);
    p.ADFT = (bf16_t*)take((size_t)2048 * 4096 * 2);
    p.ADFTC = (bf16_t*)take((size_t)256 * 512 * 2);
    p.H = (bf16_t*)take((size_t)TT * 2048 * 2);
    p.RBP = (int*)take((size_t)TT * 16);
    const size_t base = off;
    p.Y = (bf16_t*)take((size_t)TT * 2048 * 2);
    p.ZS = (bf16_t*)take((size_t)TT * ZW * 2); p.ACC = (float*)p.ZS;
    p.G = (bf16_t*)take((size_t)TT * GW * 2);
    p.NQ = (bf16_t*)take((size_t)TT * 512 * 2);
    p.NK = (bf16_t*)take((size_t)TT * 512 * 2);
    const size_t scan_base = off;
    p.R1 = (char*)take((size_t)8 * 8 * 2304 * R1B);
    p.R2 = (char*)take((size_t)8 * 8 * 2 * 2304 * R2B);
    p.GRW = (bf16_t*)take((size_t)TT * 512 * 2);
    const size_t scan_end = off;
    p.CQN = (bf16_t*)take((size_t)TT * 512 * 2);
    p.CKVN = (bf16_t*)take((size_t)TT * 256 * 2);
    p.LA = (bf16_t*)take((size_t)TT * 256 * 2);
    p.RK = (bf16_t*)take((size_t)TT * 512 * 2);
    p.Q0 = (bf16_t*)take((size_t)TT * 768 * 2);
    p.KV0 = (bf16_t*)take((size_t)TT * 1024 * 2);
    p.MQ = (bf16_t*)take((size_t)TT * 768 * 2);
    p.MK = (bf16_t*)take((size_t)TT * 768 * 2);
    p.MVT = p.CQN; p.NVT = p.RK; p.ZB = p.KV0;
    p.YS = (float*)p.ZS; p.PMAT = p.YS + (size_t)2 * TT * 512; p.QMAT = p.PMAT + (size_t)128 * 16 * 4096; p.SMAT = p.QMAT + (size_t)128 * 16 * 4096;
    if ((size_t)((char*)(p.SMAT + (size_t)128 * 16 * 4096) - (char*)p.ZS) > (size_t)TT * ZW * 2) fprintf(stderr, "kernel_launch: scan scratch overflows the ZS region\n");
    p.XCS = (bf16_t*)take((size_t)4096 * 2 * 2048 * 2);
    p.XCSC = (bf16_t*)take((size_t)4096 * 2 * 256 * 2);
    const size_t mix_end = off;
    p.ACCB = (bf16_t*)(ws + scan_base);
    size_t moff = scan_base + al256((size_t)TT * 2048 * 2);
    p.W13T = (bf16_t*)(ws + moff); moff = al256(moff + (size_t)16 * 2048 * 2048 * 2);
    p.W2T = (bf16_t*)(ws + moff); moff = al256(moff + (size_t)16 * 2048 * 1024 * 2);
    (void)scan_end;
    if (moff > mix_end) { fprintf(stderr, "kernel_launch: moe weights overflow the mixer region (%zu > %zu)\n", moff, mix_end); }
    size_t aoff = base;
    auto atake = [&](size_t bytes) { char* r = ws + aoff; aoff = al256(aoff + bytes); return r; };
    p.H2 = (bf16_t*)atake((size_t)TT * 2048 * 2);
    p.XE = (bf16_t*)atake((size_t)XE_ROWS * 2048 * 2);
    p.HH = (bf16_t*)atake((size_t)XE_ROWS * 1024 * 2);
    p.YE = (bf16_t*)atake((size_t)XE_ROWS * 2048 * 2);
    p.AFFT = (float*)atake((size_t)128 * 2048 * 4);
    p.AFFC = (float*)atake((size_t)128 * 256 * 4);
    p.IDXROW = (int*)atake((size_t)XE_ROWS * 4);
    p.GATEV = (float*)atake((size_t)XE_ROWS * 4);
    p.SEL = (int*)atake((size_t)TT * 16 * 4);
    if (aoff > scan_base) fprintf(stderr, "kernel_launch: moe activations overflow (%zu > %zu)\n", aoff, scan_base);
    if (mix_end > ws_size) { fprintf(stderr, "kernel_launch: workspace too small: need %zu have %zu\n", mix_end, ws_size); return; }

#ifdef MK_MULTI
    launch<PH_ADALN_P>(p, 0, stream); launch<PH_CONST>(p, 0, stream); launch<PH_ADALN_R>(p, 0, stream);
    for (int l = 0; l < DEPTH; ++l) {
        launch<PH_CVT_MIX>(p, l, stream); launch<PH_MODULATE>(p, l, stream); launch<PH_GEMM_WIN>(p, l, stream); launch<PH_PREPA>(p, l, stream);
        launch<PH_GEMM_LORA>(p, l, stream); launch<PH_GEMM_FCHAN>(p, l, stream); launch<PH_GEMM_UQ>(p, l, stream); launch<PH_GEMM_UKV>(p, l, stream);
        launch<PH_PREPB>(p, l, stream); launch<PH_MLA>(p, l, stream); launch<PH_NA>(p, l, stream); launch<PH_SCAN>(p, l, stream); launch<PH_RWKV_OUT>(p, l, stream);
        launch<PH_GEMM_FSEQ>(p, l, stream); if (l == 0) launch<PH_GEMM_FSEQC>(p, l, stream);
        launch<PH_GEMM_MERGE>(p, l, stream); launch<PH_GEMM_WOUT>(p, l, stream); launch<PH_CVT_MOE>(p, l, stream); launch<PH_ROUTER>(p, l, stream);
        launch<PH_TOPK>(p, l, stream); launch<PH_GATHER>(p, l, stream); launch<PH_GEMM_MOE1>(p, l, stream); launch<PH_GEMM_MOE2>(p, l, stream); launch<PH_COMBINE>(p, l, stream);
    }
#else
    static int grid = 0;
    if (!grid) {
        int dev = 0, cus = 0, per_cu = 0;
        (void)hipGetDevice(&dev);
        (void)hipDeviceGetAttribute(&cus, hipDeviceAttributeMultiprocessorCount, dev);
        (void)hipFuncSetAttribute((const void*)k_mega, hipFuncAttributeMaxDynamicSharedMemorySize, LDS_BYTES);
        (void)hipOccupancyMaxActiveBlocksPerMultiprocessor(&per_cu, (const void*)k_mega, 512, LDS_BYTES);
        if (per_cu < 1) fprintf(stderr, "kernel_launch: occupancy query says %d blocks per CU\n", per_cu);
        grid = cus > 0 ? cus : 256;
    }
    (void)hipMemsetAsync(p.bar, 0, 16384, stream);
    hipLaunchKernelGGL(k_mega, dim3(grid), dim3(512), LDS_BYTES, stream, p);
#endif
}
#ifdef MK_DIAG
template __global__ void k_phase<PH_SCAN_A>(Params, int);
template __global__ void k_phase<PH_SCAN_B>(Params, int);
template __global__ void k_phase<PH_SCAN_C>(Params, int);
template __global__ void k_phase<PH_MLA>(Params, int);
template __global__ void k_phase<PH_NA>(Params, int);
#endif
#ifdef MK_DIAG
template __global__ void k_phase<PH_GEMM_LORA>(Params, int);
template __global__ void k_phase<PH_GEMM_WIN>(Params, int);
template __global__ void k_phase<PH_GEMM_MERGE>(Params, int);
#endif
#ifdef MK_DIAG
template __global__ void k_phase<PH_GEMM_WOUT>(Params, int);
template __global__ void k_phase<PH_GEMM_MOE2>(Params, int);
#endif
```

```cpp
#include <hip/hip_runtime.h>
#include <stdint.h>
#include <stdio.h>
#include <string.h>

#define LAS __attribute__((address_space(3)))
#define PROBE_DUP 0
typedef unsigned short bf16_t;
typedef short bf16x8 __attribute__((ext_vector_type(8)));
typedef float f32x4 __attribute__((ext_vector_type(4)));
typedef float f32x2 __attribute__((ext_vector_type(2)));
typedef unsigned u32x4 __attribute__((ext_vector_type(4)));
typedef unsigned u32x2 __attribute__((ext_vector_type(2)));

constexpr int NB = 8, SEQ = 2048, DM = 2048, CTXL = 256, DEPTH = 2;
constexpr int T = NB * SEQ, TC = NB * CTXL, TT = T + TC;
constexpr int ZW = 4864;
constexpr int GW = 8192;
constexpr int ZN = ZW + GW;
constexpr int NEXP = 16, EFF = 1024;
constexpr int XE_ROWS = 128 * 256 + 16 * 256;
constexpr float NORM_EPS = 1e-6f;
constexpr int R1B = 640, R2B = 512;

struct Params {
    const float* in[36];
    float* out;
    unsigned* bar;
    float* MOD;
    float* MODP;
    float* XCUR;
    bf16_t* WIN_T;
    bf16_t* WBR_T;
    bf16_t* WOUT_T;
    bf16_t* WUQ_T;
    bf16_t* WUKV_T;
    bf16_t* WLORA_T;
    bf16_t* WFC;
    bf16_t* ADFT;
    bf16_t* ADFTC;
    bf16_t* H;
    bf16_t* Y;
    bf16_t* ZS;
    bf16_t* G;
    bf16_t* NQ;
    bf16_t* NK;
    bf16_t* CQN;
    bf16_t* CKVN;
    bf16_t* LA;
    bf16_t* RK;
    int*    RBP;
    char*   R1;
    char*   R2;
    bf16_t* GRW;
    float*  YS;
    float*  PMAT;
    float*  QMAT;
    float*  SMAT;
    bf16_t* Q0;
    bf16_t* KV0;
    bf16_t* ZB;
    bf16_t* MQ;
    bf16_t* MK;
    bf16_t* MVT;
    bf16_t* NVT;
    bf16_t* XCS;
    bf16_t* XCSC;
    float*  ACC;
    bf16_t* ACCB;
    bf16_t* W13T;
    bf16_t* W2T;
    bf16_t* H2;
    float*  AFFT;
    float*  AFFC;
    int*    IDXROW;
    float*  GATEV;
    int*    SEL;
    bf16_t* XE;
    bf16_t* HH;
    bf16_t* YE;
};

__device__ __forceinline__ float bf2f(bf16_t h) { return __uint_as_float(((unsigned)h) << 16); }
typedef float f32x2_t __attribute__((ext_vector_type(2)));
typedef __bf16 bf16x2_t __attribute__((ext_vector_type(2)));
__device__ __forceinline__ unsigned pk2(float lo, float hi) { const f32x2_t v = {lo, hi}; return __builtin_bit_cast(unsigned, __builtin_convertvector(v, bf16x2_t)); }
__device__ __forceinline__ bf16_t f2bf(float f) { return (bf16_t)(pk2(f, f) & 0xffffu); }
__device__ __forceinline__ void unpack8(u32x4 w, float* v) {
    v[0] = __uint_as_float(w.x << 16); v[1] = __uint_as_float(w.x & 0xffff0000u);
    v[2] = __uint_as_float(w.y << 16); v[3] = __uint_as_float(w.y & 0xffff0000u);
    v[4] = __uint_as_float(w.z << 16); v[5] = __uint_as_float(w.z & 0xffff0000u);
    v[6] = __uint_as_float(w.w << 16); v[7] = __uint_as_float(w.w & 0xffff0000u);
}
__device__ __forceinline__ u32x4 pack8(const float* v) { u32x4 w; w.x = pk2(v[0], v[1]); w.y = pk2(v[2], v[3]); w.z = pk2(v[4], v[5]); w.w = pk2(v[6], v[7]); return w; }
__device__ __forceinline__ void load8(const bf16_t* p, float* v) { unpack8(*(const u32x4*)p, v); }
__device__ __forceinline__ void store8(bf16_t* p, const float* v) { *(u32x4*)p = pack8(v); }
__device__ __forceinline__ float wave_sum(float v) {
#pragma unroll
    for (int o = 32; o; o >>= 1) v += __shfl_xor(v, o);
    return v;
}
__device__ __forceinline__ float wave_max(float v) {
#pragma unroll
    for (int o = 32; o; o >>= 1) v = fmaxf(v, __shfl_xor(v, o));
    return v;
}
__device__ __forceinline__ float sum8(float v) { v += __shfl_xor(v, 1); v += __shfl_xor(v, 2); v += __shfl_xor(v, 4); return v; }
__device__ __forceinline__ float sigmoidf_(float x) { return __builtin_amdgcn_rcpf(1.0f + __expf(-x)); }
__device__ __forceinline__ int opaque_lane() { unsigned m = ~0u; asm volatile("" : "+s"(m)); return (int)__builtin_amdgcn_mbcnt_hi(m, __builtin_amdgcn_mbcnt_lo(m, 0u)); }
__device__ __forceinline__ int row_s(int r) { return r < T ? (r >> 11) : 8; }
__device__ __forceinline__ void row_bpos(int r, int& b, int& pf) { if (r < T) { b = r >> 11; pf = 256 + (r & 2047); } else { b = (r - T) >> 8; pf = (r - T) & 255; } }
__device__ __forceinline__ int pos_rev(int pf) { return pf < 256 ? 255 - pf : 2559 - pf; }

__device__ __forceinline__ u32x4 pack8v(f32x4 a, f32x4 b) { u32x4 w; w.x = pk2(a[0], a[1]); w.y = pk2(a[2], a[3]); w.z = pk2(b[0], b[1]); w.w = pk2(b[2], b[3]); return w; }

namespace pg8 {
constexpr int BM = 256, BK = 64, HALF = 128, HTB = HALF * BK * 2, STAGE_BYTES = 8 * HTB, NXCD = 8, WGM = 8;
__host__ __device__ __forceinline__ int lds_byte(int r, int c) { const int st = (r >> 4) * 2 + (c >> 5), rr = r & 15, cc = c & 31, ob = rr * 64 + cc * 2; return st * 1024 + (ob ^ (((ob >> 9) & 1) << 5)); }
__host__ __device__ __forceinline__ void stage_rc(int b, int& R, int& C) { const int st = b / 1024, sb = b % 1024, swz = sb ^ (((sb >> 9) & 1) << 5); R = (st >> 1) * 16 + swz / 64; C = (st & 1) * 32 + (swz % 64) / 2; }
__host__ __device__ __forceinline__ int perm32(int rho) { const int n = rho >> 4, i = rho & 15; return 8 * (i >> 2) + 4 * n + (i & 3); }

struct Unit { int pm, pn, aux, pad; const char* a; const char* b; };

__device__ __forceinline__ bool tile_of(long L, int nM, int nN, int& pm, int& pn) {
    const int nwg = nM * nN; if (L >= nwg || L < 0) return false;
    int wgid = (int)L; { const int q = nwg / NXCD, r = nwg % NXCD, xcd = wgid % NXCD, off = wgid / NXCD; wgid = (xcd < r ? xcd * (q + 1) : r * (q + 1) + (xcd - r) * q) + off; }
    const int nig = WGM * nN, gid = wgid / nig, fm = gid * WGM, gsz = (nM - fm) < WGM ? (nM - fm) : WGM;
    pm = fm + ((wgid % nig) % gsz); pn = (wgid % nig) / gsz; return true;
}

struct Sched2D {
    const char* A; const char* B; long a_tile, b_tile, b_grp; int nM, nN, G, c, moe;
    int nMb = 0, nNb = 0, pm0b = 0;
    __device__ __forceinline__ bool next(int i, Unit& u) const {
        int pm, pn; const long L = (long)i * G + c; const int n1 = nM * nN;
        if (L < n1) { if (!tile_of(L, nM, nN, pm, pn)) return false; }
        else { if (!tile_of(L - n1, nMb, nNb, pm, pn)) return false; pm += pm0b; }
        u.pm = pm; u.pn = pn; u.aux = 0; u.pad = 0;
        u.a = A + (long)pm * a_tile;
        const int e = moe ? (pm < 128 ? (pm >> 3) : (pm - 128)) : 0;
        u.b = B + (long)pn * b_tile + (long)e * b_grp;
        return true;
    }
};
struct SchedMerge {
    const char* A; const char* B; int nM, nN, G, c;
    __device__ __forceinline__ bool next(int i, Unit& u) const {
        int pm, pn; if (!tile_of((long)(i >> 2) * G + c, nM, nN, pm, pn)) return false;
        const int br = i & 3;
        u.pm = pm; u.pn = pn; u.aux = br; u.pad = 0;
        u.a = A + ((long)pm * 256 * 2048 + br * 512) * 2;
        u.b = B + ((long)br * 2048 * 512 + (long)pn * 256 * 512) * 2;
        return true;
    }
};

template <class Epi, class Sched, bool GATHER = false>
__device__ __forceinline__ void gemm_phase(const int wid0, LAS unsigned char* lds, const int K, const int lda, const int ldb, const Sched& S, const Epi& E, const int* gidx = nullptr) {
    int tid = (wid0 << 6) | opaque_lane(); asm volatile("" : "+v"(tid));
    const int wid = __builtin_amdgcn_readfirstlane(tid >> 6), lane = tid & 63, wr = wid >> 2, wc = wid & 3, fr = lane & 15, fq = lane >> 4;
    const int nt = K / BK;
    unsigned voffA[2], voffB[2]; int gR[2], gC[2];
#pragma unroll
    for (int i = 0; i < 2; ++i) { int R, C; stage_rc(tid * 16 + i * 8192, R, C); const int Rb = Epi::PERM ? ((R & ~31) + perm32(R & 31)) : R;
        voffA[i] = (unsigned)(R * lda + C) * 2u; voffB[i] = (unsigned)(Rb * ldb + C) * 2u; gR[i] = R; gC[i] = C; }
    unsigned vA0c[2] = {0u, 0u}, vA1c[2] = {0u, 0u}, vA0n[2] = {0u, 0u}, vA1n[2] = {0u, 0u};
#define PG8_GIDX(dst0, dst1, pm_) do { _Pragma("unroll") for (int _i = 0; _i < 2; ++_i) { dst0[_i] = (unsigned)(gidx[(pm_) * 256 + gR[_i]] * lda + gC[_i]) * 2u; dst1[_i] = (unsigned)(gidx[(pm_) * 256 + 128 + gR[_i]] * lda + gC[_i]) * 2u; } } while (0)
    const size_t kstep = (size_t)(BK * 2);
    const size_t hstepA = (size_t)HALF * lda * 2, hstepB = (size_t)HALF * ldb * 2;
    const unsigned ldsw = (unsigned)wid * 1024u;
    const int aoff = lds_byte(wr * 64 + fr, fq * 8), boff = lds_byte(wc * 32 + fr, fq * 8);
#define PG8_SA(b, h) (((b) * 2 + (h)) * HTB)
#define PG8_SB(b, h) ((4 + (b) * 2 + (h)) * HTB)
#define PG8_STAGE(bufoff, gbase, voff) do { _Pragma("unroll") for (int _i = 0; _i < 2; ++_i) \
        __builtin_amdgcn_global_load_lds((const unsigned*)((const char*)(gbase) + (voff)[_i]), (LAS unsigned*)(lds + (bufoff) + ldsw + _i * 8192), 16, 0, 0); } while (0)
#define PG8_LDA(dst, b, h) do { _Pragma("unroll") for (int m = 0; m < 4; ++m) _Pragma("unroll") for (int k = 0; k < 2; ++k) dst[m][k] = *(const LAS bf16x8*)(lds + PG8_SA(b, h) + aoff + m * 2048 + k * 1024); } while (0)
#define PG8_LDB(dst, b, h) do { _Pragma("unroll") for (int n = 0; n < 2; ++n) _Pragma("unroll") for (int k = 0; k < 2; ++k) dst[n][k] = *(const LAS bf16x8*)(lds + PG8_SB(b, h) + boff + n * 2048 + k * 1024); } while (0)
#define PG8_MMA(ai, bj, At, Bt) do { __builtin_amdgcn_s_setprio(1); _Pragma("unroll") for (int m = 0; m < 4; ++m) _Pragma("unroll") for (int n = 0; n < 2; ++n) _Pragma("unroll") for (int k = 0; k < 2; ++k) \
        acc[ai][bj][m][n] = __builtin_amdgcn_mfma_f32_16x16x32_bf16(Bt[n][k], At[m][k], acc[ai][bj][m][n], 0, 0, 0); __builtin_amdgcn_s_setprio(0); } while (0)
#define PG8_WAIT_V(n) asm volatile("s_waitcnt vmcnt(" #n ")" ::: "memory")
#define PG8_WAIT_L(n) asm volatile("s_waitcnt lgkmcnt(" #n ")" ::: "memory")
#define PG8_BAR __builtin_amdgcn_s_barrier()
#define PG8_SCHED __builtin_amdgcn_sched_barrier(0)
    Unit cur, nxt; int ui = 0;
    if (!S.next(0, cur)) return;
    f32x4 acc[2][2][4][2];
#pragma unroll
    for (int a = 0; a < 2; ++a)
#pragma unroll
        for (int b = 0; b < 2; ++b)
#pragma unroll
            for (int m = 0; m < 4; ++m)
#pragma unroll
                for (int n = 0; n < 2; ++n) acc[a][b][m][n] = (f32x4){0.f, 0.f, 0.f, 0.f};
    bf16x8 At[4][2], B0[2][2], B1[2][2];
    const char* cA = cur.a; const char* cB = cur.b;
    if constexpr (GATHER) { PG8_GIDX(vA0c, vA1c, cur.pm); }
    const size_t hA = GATHER ? (size_t)0 : hstepA;
#define PG8_STAGEA(bufoff, gbase, h_, nx_) do { _Pragma("unroll") for (int _i = 0; _i < 2; ++_i) { \
        const unsigned _o = !GATHER ? voffA[_i] : ((h_) ? ((nx_) ? vA1n[_i] : vA1c[_i]) : ((nx_) ? vA0n[_i] : vA0c[_i])); \
        __builtin_amdgcn_global_load_lds((const unsigned*)((const char*)(gbase) + _o), (LAS unsigned*)(lds + (bufoff) + ldsw + _i * 8192), 16, 0, 0); } } while (0)
    PG8_STAGE(PG8_SB(0, 0), cB, voffB); PG8_STAGEA(PG8_SA(0, 0), cA, 0, false); PG8_STAGE(PG8_SB(0, 1), cB + hstepB, voffB); PG8_STAGEA(PG8_SA(0, 1), cA + hA, 1, false);
    if (wr == 1) PG8_BAR;
    PG8_WAIT_V(4); PG8_BAR;
    PG8_STAGE(PG8_SB(1, 0), cB + kstep, voffB); PG8_STAGEA(PG8_SA(1, 0), cA + kstep, 0, false); PG8_STAGE(PG8_SB(1, 1), cB + hstepB + kstep, voffB);
    PG8_WAIT_V(6); PG8_BAR;
    for (;;) {
        const bool has_next = S.next(ui + 1, nxt);
        const char* nA = has_next ? nxt.a : cA; const char* nB = has_next ? nxt.b : cB;
        if constexpr (GATHER) { if (has_next) { PG8_GIDX(vA0n, vA1n, nxt.pm); } else { vA0n[0] = vA0c[0]; vA0n[1] = vA0c[1]; vA1n[0] = vA1c[0]; vA1n[1] = vA1c[1]; } }
        for (int t = 0; t < nt; t += 2) {
            const bool last = (t == nt - 2);
            const char* a1 = cA + (size_t)(t + 1) * kstep;
            const char* a2 = last ? nA : cA + (size_t)(t + 2) * kstep; const char* b2 = last ? nB : cB + (size_t)(t + 2) * kstep;
            const char* a3 = a2 + kstep; const char* b3 = b2 + kstep;
            PG8_LDB(B0, 0, 0); PG8_SCHED; PG8_LDA(At, 0, 0); PG8_STAGEA(PG8_SA(1, 1), a1 + hA, 1, false);
            PG8_WAIT_L(8); PG8_BAR; PG8_WAIT_L(0); PG8_MMA(0, 0, At, B0); PG8_BAR; PG8_SCHED;
            PG8_LDB(B1, 0, 1); PG8_STAGE(PG8_SB(0, 0), b2, voffB);
            PG8_BAR; PG8_WAIT_L(0); PG8_MMA(0, 1, At, B1); PG8_BAR;
            PG8_LDA(At, 0, 1); PG8_STAGEA(PG8_SA(0, 0), a2, 0, last);
            PG8_BAR; PG8_WAIT_L(0); PG8_MMA(1, 0, At, B0); PG8_BAR; PG8_SCHED;
            PG8_STAGE(PG8_SB(0, 1), b2 + hstepB, voffB);
            PG8_WAIT_V(6); PG8_BAR; PG8_MMA(1, 1, At, B1); PG8_BAR;
            PG8_LDB(B0, 1, 0); PG8_SCHED; PG8_LDA(At, 1, 0); PG8_STAGEA(PG8_SA(0, 1), a2 + hA, 1, last);
            PG8_WAIT_L(8); PG8_BAR; PG8_WAIT_L(0); PG8_MMA(0, 0, At, B0); PG8_BAR; PG8_SCHED;
            PG8_LDB(B1, 1, 1); PG8_STAGE(PG8_SB(1, 0), b3, voffB);
            PG8_BAR; PG8_WAIT_L(0); PG8_MMA(0, 1, At, B1); PG8_BAR;
            PG8_LDA(At, 1, 1); PG8_STAGEA(PG8_SA(1, 0), a3, 0, last);
            PG8_BAR; PG8_WAIT_L(0); PG8_MMA(1, 0, At, B0); PG8_BAR; PG8_SCHED;
            PG8_STAGE(PG8_SB(1, 1), b3 + hstepB, voffB);
            PG8_WAIT_V(6); PG8_BAR; PG8_MMA(1, 1, At, B1); PG8_BAR;
        }
        E(acc, cur, wr, wc, fr, fq);
        if (!has_next) break;
#pragma unroll
        for (int a = 0; a < 2; ++a)
#pragma unroll
            for (int b = 0; b < 2; ++b)
#pragma unroll
                for (int m = 0; m < 4; ++m)
#pragma unroll
                    for (int n = 0; n < 2; ++n) acc[a][b][m][n] = (f32x4){0.f, 0.f, 0.f, 0.f};
        cur = nxt; cA = nA; cB = nB; ++ui;
        if constexpr (GATHER) { vA0c[0] = vA0n[0]; vA0c[1] = vA0n[1]; vA1c[0] = vA1n[0]; vA1c[1] = vA1n[1]; }
    }
    PG8_WAIT_V(0);
    if (wr == 0) PG8_BAR;
    PG8_BAR;
#undef PG8_GIDX
#undef PG8_STAGEA
#undef PG8_SA
#undef PG8_SB
#undef PG8_STAGE
#undef PG8_LDA
#undef PG8_LDB
#undef PG8_MMA
#undef PG8_WAIT_V
#undef PG8_WAIT_L
#undef PG8_BAR
#undef PG8_SCHED
}


struct SchedRects {
    const char* A; const char* B; long a_tile, b_tile; int G, c;
    int r[3][4];
    __device__ __forceinline__ bool next(int i, Unit& u) const {
        long L = (long)i * G + c; int pm = 0, pn = 0; bool ok = false;
#pragma unroll
        for (int k = 0; k < 3; ++k) { const int n = r[k][1] * r[k][3]; if (!ok) { if (L < n) { ok = tile_of(L, r[k][1], r[k][3], pm, pn); pm += r[k][0]; pn += r[k][2]; } else L -= n; } }
        if (!ok) return false;
        u.pm = pm; u.pn = pn; u.aux = 0; u.pad = 0; u.a = A + (long)pm * a_tile; u.b = B + (long)pn * b_tile; return true;
    }
};
__device__ __forceinline__ void gemm_merge(const int wid0, LAS unsigned char* lds, const bf16_t* Y, const bf16_t* WBR, const bf16_t* G, bf16_t* ACCB, int nM, int Gn, int c) {
    int tid = (wid0 << 6) | opaque_lane(); asm volatile("" : "+v"(tid));
    const int wid = __builtin_amdgcn_readfirstlane(tid >> 6), lane = tid & 63, wr = wid >> 2, wc = wid & 3, fr = lane & 15, fq = lane >> 4;
    constexpr int K = 2048, lda = 2048, ldb = 2048, nt = K / BK, nN = 8;
    unsigned voffA[2], voffB[2];
#pragma unroll
    for (int i = 0; i < 2; ++i) { int R, C; stage_rc(tid * 16 + i * 8192, R, C); const int Rb = (R & ~31) + perm32(R & 31);
        voffA[i] = (unsigned)(R * lda + C) * 2u; voffB[i] = (unsigned)(Rb * ldb + C) * 2u; }
    const size_t kstep = (size_t)(BK * 2);
    const size_t hstepA = (size_t)HALF * lda * 2, hstepB = (size_t)HALF * ldb * 2;
    const unsigned ldsw = (unsigned)wid * 1024u;
    const int aoff = lds_byte(wr * 64 + fr, fq * 8), boff = lds_byte(wc * 32 + fr, fq * 8);
#define PG8_SA(b, h) (((b) * 2 + (h)) * HTB)
#define PG8_SB(b, h) ((4 + (b) * 2 + (h)) * HTB)
#define PG8_STAGE(bufoff, gbase, voff) do { _Pragma("unroll") for (int _i = 0; _i < 2; ++_i) \
        __builtin_amdgcn_global_load_lds((const unsigned*)((const char*)(gbase) + (voff)[_i]), (LAS unsigned*)(lds + (bufoff) + ldsw + _i * 8192), 16, 0, 0); } while (0)
#define PG8_LDA(dst, b, h) do { _Pragma("unroll") for (int m = 0; m < 4; ++m) _Pragma("unroll") for (int k = 0; k < 2; ++k) dst[m][k] = *(const LAS bf16x8*)(lds + PG8_SA(b, h) + aoff + m * 2048 + k * 1024); } while (0)
#define PG8_LDB(dst, b, h) do { _Pragma("unroll") for (int n = 0; n < 2; ++n) _Pragma("unroll") for (int k = 0; k < 2; ++k) dst[n][k] = *(const LAS bf16x8*)(lds + PG8_SB(b, h) + boff + n * 2048 + k * 1024); } while (0)
#define PG8_MMA(ai, bj, At, Bt) do { __builtin_amdgcn_s_setprio(1); _Pragma("unroll") for (int m = 0; m < 4; ++m) _Pragma("unroll") for (int n = 0; n < 2; ++n) _Pragma("unroll") for (int k = 0; k < 2; ++k) \
        acc[ai][bj][m][n] = __builtin_amdgcn_mfma_f32_16x16x32_bf16(Bt[n][k], At[m][k], acc[ai][bj][m][n], 0, 0, 0); __builtin_amdgcn_s_setprio(0); } while (0)
#define PG8_WAIT_V(n) asm volatile("s_waitcnt vmcnt(" #n ")" ::: "memory")
#define PG8_WAIT_L(n) asm volatile("s_waitcnt lgkmcnt(" #n ")" ::: "memory")
#define PG8_BAR __builtin_amdgcn_s_barrier()
#define PG8_SCHED __builtin_amdgcn_sched_barrier(0)
    int ui = 0, pm, pn;
    if (!tile_of((long)c, nM, nN, pm, pn)) return;
    f32x4 acc[2][2][4][2];
#pragma unroll
    for (int a = 0; a < 2; ++a)
#pragma unroll
        for (int b = 0; b < 2; ++b)
#pragma unroll
            for (int m = 0; m < 4; ++m)
#pragma unroll
                for (int n = 0; n < 2; ++n) acc[a][b][m][n] = (f32x4){0.f, 0.f, 0.f, 0.f};
    bf16x8 At[4][2], B0[2][2], B1[2][2];
    const char* cA = (const char*)Y + (size_t)pm * 256 * lda * 2; const char* cB = (const char*)WBR + (size_t)pn * 256 * ldb * 2;
    PG8_STAGE(PG8_SB(0, 0), cB, voffB); PG8_STAGE(PG8_SA(0, 0), cA, voffA); PG8_STAGE(PG8_SB(0, 1), cB + hstepB, voffB); PG8_STAGE(PG8_SA(0, 1), cA + hstepA, voffA);
    if (wr == 1) PG8_BAR;
    PG8_WAIT_V(4); PG8_BAR;
    PG8_STAGE(PG8_SB(1, 0), cB + kstep, voffB); PG8_STAGE(PG8_SA(1, 0), cA + kstep, voffA); PG8_STAGE(PG8_SB(1, 1), cB + hstepB + kstep, voffB);
    PG8_WAIT_V(6); PG8_BAR;
    for (;;) {
        int npm, npn; const bool has_next = tile_of((long)(ui + 1) * Gn + c, nM, nN, npm, npn);
        const char* nA = has_next ? (const char*)Y + (size_t)npm * 256 * lda * 2 : cA; const char* nB = has_next ? (const char*)WBR + (size_t)npn * 256 * ldb * 2 : cB;
        const int row0 = pm * 256 + wr * 64 + fr, col0 = pn * 256 + wc * 32 + 8 * fq;
        for (int t = 0; t < nt; t += 2) {
            if (t != 0 && (t & 7) == 0) {
                const int br = (t >> 3) - 1;
#pragma unroll
                for (int ai = 0; ai < 2; ++ai)
#pragma unroll
                    for (int m = 0; m < 4; ++m)
#pragma unroll
                        for (int bj = 0; bj < 2; ++bj) {
                            const bf16_t* gp = G + (size_t)(row0 + ai * 128 + m * 16) * GW + br * 2048 + col0 + bj * 128;
                            float g0[8], g1[8]; load8(gp, g0); load8(gp + 2048, g1);
#pragma unroll
                            for (int k = 0; k < 4; ++k) { acc[ai][bj][m][0][k] *= g0[k] * __builtin_amdgcn_rcpf(fmaxf(g1[k], 1e-30f)); acc[ai][bj][m][1][k] *= g0[4 + k] * __builtin_amdgcn_rcpf(fmaxf(g1[4 + k], 1e-30f)); }
                        }
            }
            const bool last = (t == nt - 2);
            const char* a1 = cA + (size_t)(t + 1) * kstep;
            const char* a2 = last ? nA : cA + (size_t)(t + 2) * kstep; const char* b2 = last ? nB : cB + (size_t)(t + 2) * kstep;
            const char* a3 = a2 + kstep; const char* b3 = b2 + kstep;
            PG8_LDB(B0, 0, 0); PG8_SCHED; PG8_LDA(At, 0, 0); PG8_STAGE(PG8_SA(1, 1), a1 + hstepA, voffA);
            PG8_WAIT_L(8); PG8_BAR; PG8_WAIT_L(0); PG8_MMA(0, 0, At, B0); PG8_BAR; PG8_SCHED;
            PG8_LDB(B1, 0, 1); PG8_STAGE(PG8_SB(0, 0), b2, voffB);
            PG8_BAR; PG8_WAIT_L(0); PG8_MMA(0, 1, At, B1); PG8_BAR;
            PG8_LDA(At, 0, 1); PG8_STAGE(PG8_SA(0, 0), a2, voffA);
            PG8_BAR; PG8_WAIT_L(0); PG8_MMA(1, 0, At, B0); PG8_BAR; PG8_SCHED;
            PG8_STAGE(PG8_SB(0, 1), b2 + hstepB, voffB);
            PG8_WAIT_V(6); PG8_BAR; PG8_MMA(1, 1, At, B1); PG8_BAR;
            PG8_LDB(B0, 1, 0); PG8_SCHED; PG8_LDA(At, 1, 0); PG8_STAGE(PG8_SA(0, 1), a2 + hstepA, voffA);
            PG8_WAIT_L(8); PG8_BAR; PG8_WAIT_L(0); PG8_MMA(0, 0, At, B0); PG8_BAR; PG8_SCHED;
            PG8_LDB(B1, 1, 1); PG8_STAGE(PG8_SB(1, 0), b3, voffB);
            PG8_BAR; PG8_WAIT_L(0); PG8_MMA(0, 1, At, B1); PG8_BAR;
            PG8_LDA(At, 1, 1); PG8_STAGE(PG8_SA(1, 0), a3, voffA);
            PG8_BAR; PG8_WAIT_L(0); PG8_MMA(1, 0, At, B0); PG8_BAR; PG8_SCHED;
            PG8_STAGE(PG8_SB(1, 1), b3 + hstepB, voffB);
            PG8_WAIT_V(6); PG8_BAR; PG8_MMA(1, 1, At, B1); PG8_BAR;
        }
#pragma unroll
        for (int ai = 0; ai < 2; ++ai)
#pragma unroll
            for (int m = 0; m < 4; ++m)
#pragma unroll
                for (int bj = 0; bj < 2; ++bj) {
                    const int row = row0 + ai * 128 + m * 16, col = col0 + bj * 128;
                    float g[8]; load8(G + (size_t)row * GW + 3 * 2048 + col, g);
                    f32x4 o0, o1;
#pragma unroll
                    for (int k = 0; k < 4; ++k) { o0[k] = acc[ai][bj][m][0][k] * g[k]; o1[k] = acc[ai][bj][m][1][k] * g[4 + k]; }
                    *(u32x4*)(ACCB + (size_t)row * 2048 + col) = pack8v(o0, o1);
                    acc[ai][bj][m][0] = (f32x4){0.f, 0.f, 0.f, 0.f}; acc[ai][bj][m][1] = (f32x4){0.f, 0.f, 0.f, 0.f};
                }
        if (!has_next) break;
        pm = npm; pn = npn; cA = nA; cB = nB; ++ui;
    }
    PG8_WAIT_V(0);
    if (wr == 0) PG8_BAR;
    PG8_BAR;
#undef PG8_SA
#undef PG8_SB
#undef PG8_STAGE
#undef PG8_LDA
#undef PG8_LDB
#undef PG8_MMA
#undef PG8_WAIT_V
#undef PG8_WAIT_L
#undef PG8_BAR
#undef PG8_SCHED
}

template <class F> __device__ __forceinline__ void walk8(const f32x4 (&acc)[2][2][4][2], const Unit& u, int wr, int wc, int fr, int fq, F f) {
    const int row0 = u.pm * BM + wr * 64 + fr, col0 = u.pn * BM + wc * 32 + 8 * fq;
#pragma unroll
    for (int ai = 0; ai < 2; ++ai)
#pragma unroll
        for (int m = 0; m < 4; ++m)
#pragma unroll
            for (int bj = 0; bj < 2; ++bj) f(row0 + ai * HALF + m * 16, col0 + bj * HALF, acc[ai][bj][m][0], acc[ai][bj][m][1]);
}
template <class F> __device__ __forceinline__ void walk4(const f32x4 (&acc)[2][2][4][2], const Unit& u, int wr, int wc, int fr, int fq, F f) {
    const int row0 = u.pm * BM + wr * 64 + fr, col0 = u.pn * BM + wc * 32 + 4 * fq;
#pragma unroll
    for (int ai = 0; ai < 2; ++ai)
#pragma unroll
        for (int m = 0; m < 4; ++m)
#pragma unroll
            for (int bj = 0; bj < 2; ++bj)
#pragma unroll
                for (int n = 0; n < 2; ++n) f(row0 + ai * HALF + m * 16, col0 + bj * HALF + n * 16, acc[ai][bj][m][n]);
}
}
using pg8::Unit;
typedef f32x4 AccT[2][2][4][2];


struct EpiWin {
    static constexpr bool PERM = true;
    bf16_t* ZS; bf16_t* G;
    __device__ __forceinline__ void operator()(const AccT& acc, const Unit& u, int wr, int wc, int fr, int fq) const {
        if (u.pn < 19) {
            bf16_t* z = ZS;
            pg8::walk8(acc, u, wr, wc, fr, fq, [&](int row, int col, f32x4 a, f32x4 b) { *(u32x4*)(z + (size_t)row * ZW + col) = pack8v(a, b); });
        } else {
            bf16_t* g = G;
            pg8::walk8(acc, u, wr, wc, fr, fq, [&](int row, int col, f32x4 a, f32x4 b) {
#pragma unroll
                for (int k = 0; k < 4; ++k) { a[k] = sigmoidf_(a[k]); b[k] = sigmoidf_(b[k]); }
                *(u32x4*)(g + (size_t)row * GW + (col - ZW)) = pack8v(a, b); });
        }
    }
};
struct EpiBf16 {
    static constexpr bool PERM = true;
    bf16_t* O; int ldo;
    __device__ __forceinline__ void operator()(const AccT& acc, const Unit& u, int wr, int wc, int fr, int fq) const {
        bf16_t* o = O; const int ld = ldo;
        pg8::walk8(acc, u, wr, wc, fr, fq, [&](int row, int col, f32x4 a, f32x4 b) { *(u32x4*)(o + (size_t)row * ld + col) = pack8v(a, b); });
    }
};
struct EpiLora {
    static constexpr bool PERM = false;
    const float* w0; const float* a0; const float* k_a;
    const bf16_t* RK; const char* R1; char* R2; bf16_t* GRW; const int* RBP;
    __device__ __forceinline__ void operator()(const AccT& acc, const Unit& u, int wr, int wc, int fr, int fq) const {
        const int seg = u.pn >> 1;
        const int row0 = u.pm * 256 + wr * 64 + fr, col0 = u.pn * 256 + wc * 32 + 4 * fq;
        if (seg == 4) {
#pragma unroll
            for (int ai = 0; ai < 2; ++ai)
#pragma unroll
                for (int m = 0; m < 4; ++m)
#pragma unroll
                    for (int bj = 0; bj < 2; ++bj)
#pragma unroll
                        for (int n = 0; n < 2; ++n) { const f32x4 v = acc[ai][bj][m][n]; const int row = row0 + ai * 128 + m * 16, c = (col0 + bj * 128 + n * 16) & 511;
                            u32x2 w; w.x = pk2(v[0], v[1]); w.y = pk2(v[2], v[3]); *(u32x2*)(GRW + (size_t)row * 512 + c) = w; }
            return;
        }
        const int d = seg & 1;
        int rb1[8], rbd[8];
#pragma unroll
        for (int i = 0; i < 8; ++i) { const int row = row0 + (i >> 2) * 128 + (i & 3) * 16; rb1[i] = RBP[row * 4]; rbd[i] = RBP[row * 4 + 1 + d]; }
        if (seg < 2) {
#pragma unroll
            for (int j = 0; j < 4; ++j) {
                const int c = (col0 + (j >> 1) * 128 + (j & 1) * 16) & 511, hd = c >> 6, c64 = c & 63;
                const f32x4 cw = *(const f32x4*)(w0 + d * 512 + c);
#pragma unroll
                for (int i = 0; i < 8; ++i) {
                    const f32x4 v = acc[i >> 2][j >> 1][i & 3][j & 1]; f32x4 r;
#pragma unroll
                    for (int k = 0; k < 4; ++k) { const float w = cw[k] + v[k]; r[k] = __expf(-0.6065306597126334f * sigmoidf_(w)); }
                    *(f32x4*)(R2 + (size_t)(rbd[i] + (hd * 2 + d) * 2304) * R2B + c64 * 4) = r;
                }
            }
        } else {
#pragma unroll
            for (int j = 0; j < 4; ++j) {
                const int c = (col0 + (j >> 1) * 128 + (j & 1) * 16) & 511, hd = c >> 6, c64 = c & 63;
                const f32x4 cw = *(const f32x4*)(a0 + d * 512 + c), ck = *(const f32x4*)(k_a + c);
#pragma unroll
                for (int ih = 0; ih < 2; ++ih) {
                    f32x4 kk[4]; u32x2 kw[4];
#pragma unroll
                    for (int ii = 0; ii < 4; ++ii) { const int i = ih * 4 + ii; const int row = row0 + (i >> 2) * 128 + (i & 3) * 16; kk[ii] = *(const f32x4*)(R1 + (size_t)(rb1[i] + hd * 2304) * R1B + c64 * 4); kw[ii] = *(const u32x2*)(RK + (size_t)row * 512 + c); }
#pragma unroll
                    for (int ii = 0; ii < 4; ++ii) {
                        const int i = ih * 4 + ii;
                        const f32x4 v = acc[i >> 2][j >> 1][i & 3][j & 1];
                        const float kf[4] = { __uint_as_float(kw[ii].x << 16), __uint_as_float(kw[ii].x & 0xffff0000u), __uint_as_float(kw[ii].y << 16), __uint_as_float(kw[ii].y & 0xffff0000u) };
                        f32x4 bb, kd;
#pragma unroll
                        for (int k = 0; k < 4; ++k) { const float a = sigmoidf_(cw[k] + v[k]); kd[k] = kf[k] * (1.0f + (a - 1.0f) * ck[k]); bb[k] = -(kk[ii][k] * a); }
                        char* rec = R2 + (size_t)(rbd[i] + (hd * 2 + d) * 2304) * R2B + c64 * 2;
                        { u32x2 wb; wb.x = pk2(bb[0], bb[1]); wb.y = pk2(bb[2], bb[3]); *(u32x2*)(rec + 256) = wb; u32x2 wk; wk.x = pk2(kd[0], kd[1]); wk.y = pk2(kd[2], kd[3]); *(u32x2*)(rec + 384) = wk; }
                    }
                }
            }
        }
    }
};
struct EpiFourChan {
    static constexpr bool PERM = true;
    bf16_t* XCS; bf16_t* XCSC;
    __device__ __forceinline__ void operator()(const AccT& acc, const Unit& u, int wr, int wc, int fr, int fq) const {
        pg8::walk8(acc, u, wr, wc, fr, fq, [&](int row, int col, f32x4 a, f32x4 b) {
            const int gc = row >> 1, cs = row & 1;
            if (col < T) { const int bb = col >> 11, n = col & 2047; *(u32x4*)(XCS + ((size_t)((bb * 512 + gc) * 2 + cs)) * 2048 + n) = pack8v(a, b); }
            else { const int cc = col - T, bb = cc >> 8, n = cc & 255; *(u32x4*)(XCSC + ((size_t)((bb * 512 + gc) * 2 + cs)) * 256 + n) = pack8v(a, b); }
        });
    }
};
struct EpiFourSeq {
    static constexpr bool PERM = true;
    bf16_t* Y; int rowbase, seqlen; float scale;
    __device__ __forceinline__ void operator()(const AccT& acc, const Unit& u, int wr, int wc, int fr, int fq) const {
        pg8::walk8(acc, u, wr, wc, fr, fq, [&](int row, int col, f32x4 a, f32x4 b) {
            const int bb = col >> 9, ch = col & 511;
            a *= scale; b *= scale;
            *(u32x4*)(Y + (size_t)(rowbase + bb * seqlen + row) * 2048 + ch) = pack8v(a, b);
        });
    }
};
struct EpiMerge {
    static constexpr bool PERM = true;
    const bf16_t* G; float* ACC; bf16_t* ACCB;
    __device__ __forceinline__ void operator()(const AccT& acc, const Unit& u, int wr, int wc, int fr, int fq) const {
        const int br = u.aux;
        pg8::walk8(acc, u, wr, wc, fr, fq, [&](int row, int col, f32x4 a, f32x4 b) {
            float g[8]; load8(G + (size_t)row * GW + br * 2048 + col, g);
            float* ap = ACC + (size_t)row * 2048 + col;
            f32x4 t0 = {0.f, 0.f, 0.f, 0.f}, t1 = {0.f, 0.f, 0.f, 0.f};
            if (br > 0) { t0 = *(const f32x4*)ap; t1 = *(const f32x4*)(ap + 4); }
#pragma unroll
            for (int k = 0; k < 4; ++k) { t0[k] += g[k] * a[k]; t1[k] += g[4 + k] * b[k]; }
            if (br < 3) { *(f32x4*)ap = t0; *(f32x4*)(ap + 4) = t1; }
            else *(u32x4*)(ACCB + (size_t)row * 2048 + col) = pack8v(t0, t1);
        });
    }
};
struct EpiWout {
    static constexpr bool PERM = false;
    float* X; const float* MODL;
    const float* Xlat; const float* Xctx;
    __device__ __forceinline__ void operator()(const AccT& acc, const Unit& u, int wr, int wc, int fr, int fq) const {
        const int row0 = u.pm * 256 + wr * 64 + fr, col0 = u.pn * 256 + wc * 32 + 4 * fq;
        const float* XS = (u.pm < T / 256) ? Xlat : Xctx;
        const float* gp = MODL + (size_t)row_s(u.pm * 256) * 12288 + 2 * 2048 + col0;
        f32x4 g[4];
#pragma unroll
        for (int j = 0; j < 4; ++j) g[j] = *(const f32x4*)(gp + (j >> 1) * 128 + (j & 1) * 16);
#pragma unroll
        for (int h2 = 0; h2 < 2; ++h2) {
            f32x4 xv[4][4];
#pragma unroll
            for (int ii = 0; ii < 4; ++ii) { const int i = h2 * 4 + ii; const float* xp = XS + (size_t)(row0 + (i >> 2) * 128 + (i & 3) * 16) * 2048 + col0;
#pragma unroll
                for (int j = 0; j < 4; ++j) xv[ii][j] = *(const f32x4*)(xp + (j >> 1) * 128 + (j & 1) * 16); }
#pragma unroll
            for (int ii = 0; ii < 4; ++ii) { const int i = h2 * 4 + ii; float* xp = X + (size_t)(row0 + (i >> 2) * 128 + (i & 3) * 16) * 2048 + col0;
#pragma unroll
                for (int j = 0; j < 4; ++j) *(f32x4*)(xp + (j >> 1) * 128 + (j & 1) * 16) = xv[ii][j] + g[j] * acc[i >> 2][j >> 1][i & 3][j & 1]; }
        }
    }
};
struct EpiSwiglu {
    static constexpr bool PERM = true;
    bf16_t* HH;
    __device__ __forceinline__ void operator()(const AccT& acc, const Unit& u, int wr, int wc, int fr, int fq) const {
        const int row0 = u.pm * 256 + wr * 64 + fr, col0 = u.pn * 128 + wc * 32 + 8 * fq;
#pragma unroll
        for (int ai = 0; ai < 2; ++ai)
#pragma unroll
            for (int m = 0; m < 4; ++m) {
                f32x4 o0, o1;
#pragma unroll
                for (int k = 0; k < 4; ++k) {
                    const float a0 = acc[ai][0][m][0][k], u0 = acc[ai][1][m][0][k], a1 = acc[ai][0][m][1][k], u1 = acc[ai][1][m][1][k];
                    o0[k] = a0 * sigmoidf_(a0) * u0; o1[k] = a1 * sigmoidf_(a1) * u1;
                }
                *(u32x4*)(HH + (size_t)(row0 + ai * 128 + m * 16) * EFF + col0) = pack8v(o0, o1);
            }
    }
};
struct EpiMoeOut {
    static constexpr bool PERM = true;
    bf16_t* YE; const float* GATEV;
    __device__ __forceinline__ void operator()(const AccT& acc, const Unit& u, int wr, int wc, int fr, int fq) const {
        const int row0 = u.pm * 256 + wr * 64 + fr, col0 = u.pn * 256 + wc * 32 + 8 * fq;
        float gt[8];
#pragma unroll
        for (int i = 0; i < 8; ++i) gt[i] = GATEV[row0 + (i >> 2) * 128 + (i & 3) * 16];
#pragma unroll
        for (int i = 0; i < 8; ++i)
#pragma unroll
            for (int bj = 0; bj < 2; ++bj) {
                f32x4 a = acc[i >> 2][bj][i & 3][0], b = acc[i >> 2][bj][i & 3][1]; a *= gt[i]; b *= gt[i];
                *(u32x4*)(YE + (size_t)(row0 + (i >> 2) * 128 + (i & 3) * 16) * 2048 + col0 + bj * 128) = pack8v(a, b);
            }
    }
};

__device__ __forceinline__ int opaque_tid(int wid0) { int t = (wid0 << 6) | opaque_lane(); asm volatile("" : "+v"(t)); return t; }
#define PH_PROLOG const int _tid = opaque_tid(wid0)
#define TID (_tid)
#define WID (_tid >> 6)
#define LANE (_tid & 63)
#define GWAVE ((int)(blockIdx.x * 8) + (_tid >> 6))
#define NWAVE ((int)(gridDim.x * 8))

__device__ __forceinline__ void ph_adaln_partial(const int wid0, const Params& p, LAS unsigned char* lds) {
    PH_PROLOG;
    LAS float* sv = (LAS float*)lds;
    const float* c = p.in[1]; const float* cc = p.in[3]; const float* ada_w = p.in[4];
    for (int u = blockIdx.x; u < 192; u += gridDim.x) {
        const int dc = u % 16, jc = (u / 16) % 6, l = u / 96;
        __syncthreads();
        for (int i = TID; i < 9 * 128; i += 512) { const int s = i / 128, d = dc * 128 + (i % 128); const float cv = s < 8 ? c[s * 2048 + d] : cc[d]; sv[i] = cv / (1.0f + __expf(-cv)); }
        __syncthreads();
        const float* w = ada_w + ((size_t)l * 2048 + dc * 128) * 12288 + jc * 2048 + TID * 4;
        f32x4 acc[9];
#pragma unroll
        for (int s = 0; s < 9; ++s) acc[s] = (f32x4){0.f, 0.f, 0.f, 0.f};
        for (int d0 = 0; d0 < 128; d0 += 8) {
            f32x4 w4[8];
#pragma unroll
            for (int j = 0; j < 8; ++j) w4[j] = *(const f32x4*)(w + (size_t)(d0 + j) * 12288);
#pragma unroll
            for (int j = 0; j < 8; ++j)
#pragma unroll
                for (int s = 0; s < 9; ++s) acc[s] += sv[s * 128 + d0 + j] * w4[j];
        }
#pragma unroll
        for (int s = 0; s < 9; ++s) *(f32x4*)(p.MODP + (((size_t)dc * 2 + l) * 9 + s) * 12288 + jc * 2048 + TID * 4) = acc[s];
    }
}
__device__ __forceinline__ void ph_adaln_reduce(const int wid0, const Params& p) {
    PH_PROLOG;
    const float* ada_b = p.in[5];
    for (int i = blockIdx.x * 512 + TID; i < 2 * 9 * 12288; i += gridDim.x * 512) {
        const int j = i % 12288, l = i / (9 * 12288);
        float a = ada_b[l * 12288 + j];
        for (int dc = 0; dc < 16; ++dc) a += p.MODP[(size_t)dc * 2 * 9 * 12288 + i];
        p.MOD[i] = a;
    }
}

struct CvtJob { const float* src; bf16_t* dst; int R, C, dst_ld, map, nb; long src_bs, dst_bs; };
__device__ __forceinline__ int cvt_map(int map, int c) {
    if (map == 1) return c < 4640 ? c : c + 224;
    if (map == 2) return (c >> 7) * 256 + (c & 127);
    if (map == 3) return (c >> 7) * 256 + 128 + (c & 127);
    return c;
}
__device__ __forceinline__ void cvt_run(const int wid0, const CvtJob J, LAS unsigned char* lds, const int vb, const int nb) {
    PH_PROLOG;
    LAS float* tile = (LAS float*)lds;
    const int nct = J.C / 32, nct4 = (nct + 3) >> 2, tpb = (J.R / 64) * nct4, total = J.nb * tpb;
    const int tr = TID >> 3, tc = TID & 7;
    for (int t = vb; t < total; t += nb) {
        const int bi = t / tpb, r2 = t % tpb, rt = r2 / nct4, c4 = r2 % nct4;
        const float* src = J.src + (size_t)bi * J.src_bs + (size_t)(rt * 64 + tr) * J.C + c4 * 128 + tc * 4;
        f32x4 v[4];
#pragma unroll
        for (int q = 0; q < 4; ++q) v[q] = (c4 * 4 + q < nct) ? *(const f32x4*)(src + q * 32) : (f32x4){0.f, 0.f, 0.f, 0.f};
        __syncthreads();
#pragma unroll
        for (int q = 0; q < 4; ++q)
#pragma unroll
            for (int k = 0; k < 4; ++k) tile[(q * 32 + tc * 4 + k) * 65 + tr] = v[q][k];
        __syncthreads();
#pragma unroll
        for (int i = 0; i < 2; ++i) {
            const int pz = TID + 512 * i, c = pz >> 3, r8 = pz & 7;
            if (c4 * 4 + (c >> 5) < nct) {
                float f[8];
#pragma unroll
                for (int k = 0; k < 8; ++k) f[k] = tile[c * 65 + r8 * 8 + k];
                store8(J.dst + (size_t)bi * J.dst_bs + (size_t)cvt_map(J.map, c4 * 128 + c) * J.dst_ld + rt * 64 + r8 * 8, f);
            }
        }
    }
}
__device__ __forceinline__ void ph_cvt_mixer(const int wid0, const Params& p, int l, LAS unsigned char* lds, const int parts, const int vb, const int nb) {
    PH_PROLOG;
    if (parts & 1) {
        cvt_run(wid0, CvtJob{p.in[8] + (size_t)l * 2048 * 12832, p.WIN_T, 2048, 12832, 2048, 1, 1, 0, 0}, lds, vb, nb);
        for (int i = vb * 512 + TID; i < 224 * 2048 / 8; i += nb * 512) *(u32x4*)(p.WIN_T + (size_t)4640 * 2048 + (size_t)i * 8) = (u32x4){0u, 0u, 0u, 0u};
    }
    if (parts & 2) {
        cvt_run(wid0, CvtJob{p.in[30] + (size_t)l * 4 * 512 * 2048, p.WBR_T, 512, 2048, 2048, 0, 4, 512 * 2048, 512}, lds, vb, nb);
        cvt_run(wid0, CvtJob{p.in[31] + (size_t)l * 2048 * 2048, p.WOUT_T, 2048, 2048, 2048, 0, 1, 0, 0}, lds, vb, nb);
        cvt_run(wid0, CvtJob{p.in[14] + (size_t)l * 512 * 768, p.WUQ_T, 512, 768, 512, 0, 1, 0, 0}, lds, vb, nb);
        cvt_run(wid0, CvtJob{p.in[15] + (size_t)l * 256 * 1024, p.WUKV_T, 256, 1024, 256, 0, 1, 0, 0}, lds, vb, nb);
        const float* w2 = p.in[21] + (size_t)l * 2 * 32 * 512; const float* a2 = p.in[23] + (size_t)l * 2 * 32 * 512; const float* g2 = p.in[24] + (size_t)l * 96 * 512;
        for (int i = vb * 512 + TID; i < 2560 * 256; i += nb * 512) {
            const int n = i >> 8, k = i & 255, seg = n >> 9, c = n & 511; float v = 0.f;
            if (seg == 0 && k < 32) v = w2[(0 * 32 + k) * 512 + c];
            else if (seg == 1 && k >= 32 && k < 64) v = w2[(1 * 32 + (k - 32)) * 512 + c];
            else if (seg == 2 && k >= 64 && k < 96) v = a2[(0 * 32 + (k - 64)) * 512 + c];
            else if (seg == 3 && k >= 96 && k < 128) v = a2[(1 * 32 + (k - 96)) * 512 + c];
            else if (seg == 4 && k >= 128 && k < 224) v = g2[(k - 128) * 512 + c];
            p.WLORA_T[i] = f2bf(v);
        }
    }
}
__device__ __forceinline__ void ph_cvt_moe(const int wid0, const Params& p, int l, LAS unsigned char* lds, const int parts, const int vb, const int nb) {
    if (parts & 1) cvt_run(wid0, CvtJob{p.in[33] + (size_t)l * 16 * 2048 * 1024, p.W13T, 2048, 1024, 2048, 2, 16, 2048 * 1024, 2048 * 2048}, lds, vb, nb);
    if (parts & 2) cvt_run(wid0, CvtJob{p.in[34] + (size_t)l * 16 * 2048 * 1024, p.W13T, 2048, 1024, 2048, 3, 16, 2048 * 1024, 2048 * 2048}, lds, vb, nb);
    if (parts & 4) cvt_run(wid0, CvtJob{p.in[35] + (size_t)l * 16 * 1024 * 2048, p.W2T, 1024, 2048, 1024, 0, 16, 1024 * 2048, 2048 * 1024}, lds, vb, nb);
}
__device__ __forceinline__ void ph_const(const int wid0, const Params& p) {
    PH_PROLOG;
    const int gt = blockIdx.x * 512 + TID, gn = gridDim.x * 512;
    for (int i = gt; i < 1024 * 512; i += gn) {
        const int m = i >> 9, k = i & 511, g = m >> 8, cp = (m >> 1) & 127, cs = m & 1, g2 = k >> 7, c = k & 127; float v = 0.f;
        if (g == g2) { const int mm = (c * cp) & 127; const float x = (float)mm * (2.0f / 128.0f); v = cs ? sinpif(x) : cospif(x); }
        p.WFC[i] = f2bf(v);
    }
    for (int i = gt; i < 2048 * 4096; i += gn) {
        const int k = i >> 12, r = i & 4095, cs = r >> 11, n = r & 2047; const int mm = (k * n) & 2047; const float x = (float)mm * (2.0f / 2048.0f);
        p.ADFT[i] = f2bf(cs ? -sinpif(x) : cospif(x));
    }
    for (int i = gt; i < TT; i += gn) { int b, pf; row_bpos(i, b, pf); const int pr = pos_rev(pf); int* q = p.RBP + (size_t)i * 4; q[0] = b * 8 * 2304 + pf; q[1] = b * 16 * 2304 + pf; q[2] = b * 16 * 2304 + pr; q[3] = 0; }
    for (int i = gt; i < 256 * 512; i += gn) {
        const int k = i >> 9, r = i & 511, cs = r >> 8, n = r & 255; const int mm = (k * n) & 255; const float x = (float)mm * (2.0f / 256.0f);
        p.ADFTC[i] = f2bf(cs ? -sinpif(x) : cospif(x));
    }
}

__device__ __forceinline__ void ph_modulate(const int wid0, const Params& p, int l, bf16_t* dst) {
    PH_PROLOG;
    const float* g = p.in[6] + l * 2048;
    const float* modl = p.MOD + (size_t)l * 9 * 12288;
    for (int r = GWAVE; r < TT; r += NWAVE) {
        const float* src = (l == 0) ? (r < T ? p.in[0] + (size_t)r * 2048 : p.in[2] + (size_t)(r - T) * 2048) : p.XCUR + (size_t)r * 2048;
        f32x4 v[8]; float ss = 0.f;
#pragma unroll
        for (int i = 0; i < 8; ++i) { v[i] = *(const f32x4*)(src + i * 256 + LANE * 4); ss += v[i][0] * v[i][0] + v[i][1] * v[i][1] + v[i][2] * v[i][2] + v[i][3] * v[i][3]; }
        ss = wave_sum(ss);
        const float rs = rsqrtf(ss * (1.0f / 2048.0f) + NORM_EPS);
        const float* ms = modl + (size_t)row_s(r) * 12288;
        u32x2 w[8];
#pragma unroll
        for (int i = 0; i < 8; ++i) {
            const int c = i * 256 + LANE * 4;
            const f32x4 gg = *(const f32x4*)(g + c), sh = *(const f32x4*)(ms + c), sc = *(const f32x4*)(ms + 2048 + c);
            f32x4 y = v[i] * rs * gg * (1.0f + sc) + sh;
            w[i].x = pk2(y[0], y[1]); w[i].y = pk2(y[2], y[3]);
        }
#pragma unroll
        for (int i = 0; i < 8; ++i) *(u32x2*)(dst + (size_t)r * 2048 + i * 256 + LANE * 4) = w[i];
    }
}

__device__ __forceinline__ void shiftmix8(const bf16_t* z, bool hp, bool hn, const float* mu, float* o) {
    float a[8], b[8], c[8];
    load8(z, a);
    if (hp) load8(z - ZW, b); else { for (int k = 0; k < 8; ++k) b[k] = 0.f; }
    if (hn) load8(z + ZW, c); else { for (int k = 0; k < 8; ++k) c[k] = 0.f; }
#pragma unroll
    for (int k = 0; k < 8; ++k) o[k] = a[k] + (0.5f * (b[k] + c[k]) - a[k]) * mu[k];
}
__device__ __forceinline__ void smix8(const u32x4 wa, const u32x4 wb, const u32x4 wc, bool hp, bool hn, const float* mu, float* o) {
    float a[8], b[8], c[8];
    unpack8(wa, a); unpack8(wb, b); unpack8(wc, c);
#pragma unroll
    for (int k = 0; k < 8; ++k) { const float bb = hp ? b[k] : 0.f, cc = hn ? c[k] : 0.f; o[k] = a[k] + (0.5f * (bb + cc) - a[k]) * mu[k]; }
}
__device__ __forceinline__ void ldf8(const float* p, float* v) { const f32x4 a = *(const f32x4*)p, b = *(const f32x4*)(p + 4); v[0] = a[0]; v[1] = a[1]; v[2] = a[2]; v[3] = a[3]; v[4] = b[0]; v[5] = b[1]; v[6] = b[2]; v[7] = b[3]; }
__device__ __forceinline__ void ph_prepA(const int wid0, const Params& p, int l) {
    PH_PROLOG;
    const float* qn = p.in[9] + l * 64; const float* kn = p.in[10] + l * 64;
    const float* cqn = p.in[12] + l * 512; const float* ckvn = p.in[13] + l * 256;
    const float* mu_ks = p.in[18] + l * 1152; const float* mu_qs = p.in[19] + l * 608;
    const float* k_k = p.in[25] + l * 512;
    const int lane = LANE;
    float c_qn[8], c_kn[8], c_cqn[8], c_ckvn[8], c_muk[8], c_muv[8], c_mur[8], c_mul[8], c_kk[8];
    ldf8(qn + ((8 * lane) & 63), c_qn); ldf8(kn + ((8 * lane) & 63), c_kn); ldf8(cqn + 8 * lane, c_cqn); ldf8(ckvn + 8 * (lane & 31), c_ckvn);
    ldf8(mu_ks + 8 * lane, c_muk); ldf8(mu_ks + 512 + 8 * lane, c_muv); ldf8(mu_qs + 8 * lane, c_mur); ldf8(k_k + 8 * lane, c_kk);
    const int lj = lane < 16 ? lane : min(lane - 16, 11);
    ldf8(lane < 16 ? mu_ks + 1024 + 8 * lj : mu_qs + 512 + 8 * lj, c_mul);
    const int lcol = lane < 16 ? 2368 + 8 * lj : 4032 + 8 * lj;
    for (int r = GWAVE; r < TT; r += NWAVE) {
        const bf16_t* z = p.ZS + (size_t)r * ZW;
        int pos, len; if (r < T) { pos = r & 2047; len = 2048; } else { pos = (r - T) & 255; len = 256; }
        const bool hp = pos > 0, hn = pos < len - 1;
        const bool qside = !(l == DEPTH - 1 && r >= T);
        const bf16_t* zp = hp ? z - ZW : z; const bf16_t* zn = hn ? z + ZW : z;
        const u32x4 w_nq = *(const u32x4*)(z + 2496 + 8 * lane), w_nk = *(const u32x4*)(z + 8 * lane), w_cq = *(const u32x4*)(z + 3008 + 8 * lane), w_ckv = *(const u32x4*)(z + 1024 + 8 * (lane & 31));
        const u32x4 w_k0 = *(const u32x4*)(z + 1344 + 8 * lane), w_k1 = *(const u32x4*)(zp + 1344 + 8 * lane), w_k2 = *(const u32x4*)(zn + 1344 + 8 * lane);
        const u32x4 w_v0 = *(const u32x4*)(z + 1856 + 8 * lane), w_v1 = *(const u32x4*)(zp + 1856 + 8 * lane), w_v2 = *(const u32x4*)(zn + 1856 + 8 * lane);
        const u32x4 w_r0 = *(const u32x4*)(z + 3520 + 8 * lane), w_r1 = *(const u32x4*)(zp + 3520 + 8 * lane), w_r2 = *(const u32x4*)(zn + 3520 + 8 * lane);
        const u32x4 w_l0 = *(const u32x4*)(z + lcol), w_l1 = *(const u32x4*)(zp + lcol), w_l2 = *(const u32x4*)(zn + lcol);
        float v[8], o[8];
        if (qside) {
            unpack8(w_nq, v);
            float ss = 0.f; for (int k = 0; k < 8; ++k) ss += v[k] * v[k]; ss = sum8(ss); const float rs = rsqrtf(ss * (1.0f / 64.0f) + NORM_EPS) * (0.125f * 1.4426950408889634f);
            for (int k = 0; k < 8; ++k) o[k] = v[k] * rs * c_qn[k]; store8(p.NQ + (size_t)r * 512 + 8 * lane, o);
        }
        { unpack8(w_nk, v);
          float ss = 0.f; for (int k = 0; k < 8; ++k) ss += v[k] * v[k]; ss = sum8(ss); const float rs = rsqrtf(ss * (1.0f / 64.0f) + NORM_EPS);
          for (int k = 0; k < 8; ++k) o[k] = v[k] * rs * c_kn[k]; store8(p.NK + (size_t)r * 512 + 8 * lane, o); }
        if (qside) {
            unpack8(w_cq, v);
            float ss = 0.f; for (int k = 0; k < 8; ++k) ss += v[k] * v[k]; ss = wave_sum(ss); const float rs = rsqrtf(ss * (1.0f / 512.0f) + NORM_EPS);
            for (int k = 0; k < 8; ++k) o[k] = v[k] * rs * c_cqn[k]; store8(p.CQN + (size_t)r * 512 + 8 * lane, o);
        }
        { unpack8(w_ckv, v);
          float ss = 0.f; if (lane < 32) { for (int k = 0; k < 8; ++k) ss += v[k] * v[k]; }
          ss = wave_sum(ss); const float rs = rsqrtf(ss * (1.0f / 256.0f) + NORM_EPS);
          if (lane < 32) { for (int k = 0; k < 8; ++k) o[k] = v[k] * rs * c_ckvn[k]; store8(p.CKVN + (size_t)r * 256 + 8 * lane, o); } }
        smix8(w_k0, w_k1, w_k2, hp, hn, c_muk, o);
        store8(p.RK + (size_t)r * 512 + 8 * lane, o);
        int sb_, pf_; row_bpos(r, sb_, pf_);
        char* rec1 = p.R1 + ((size_t)(sb_ * 8 + (lane >> 3)) * 2304 + pf_) * R1B; const int j0_ = (lane & 7) * 8;
        { float t[8], ss = 0.f; for (int k = 0; k < 8; ++k) { t[k] = o[k] * c_kk[k]; ss += t[k] * t[k]; } ss = sum8(ss);
          const float inv = 1.0f / fmaxf(sqrtf(ss), 1e-12f);
          f32x4 k0 = {t[0] * inv, t[1] * inv, t[2] * inv, t[3] * inv}, k1 = {t[4] * inv, t[5] * inv, t[6] * inv, t[7] * inv};
          *(f32x4*)(rec1 + j0_ * 4) = k0; *(f32x4*)(rec1 + j0_ * 4 + 16) = k1; }
        smix8(w_v0, w_v1, w_v2, hp, hn, c_muv, o);
        store8((bf16_t*)(rec1 + 512) + j0_, o);
        if (qside) smix8(w_r0, w_r1, w_r2, hp, hn, c_mur, o); else { for (int k = 0; k < 8; ++k) o[k] = 0.f; }
        { const f32x4 r0 = {o[0], o[1], o[2], o[3]}, r1 = {o[4], o[5], o[6], o[7]}; *(f32x4*)(rec1 + 256 + j0_ * 4) = r0; *(f32x4*)(rec1 + 256 + j0_ * 4 + 16) = r1; }
        if (lane < 16) {
            smix8(w_l0, w_l1, w_l2, hp, hn, c_mul, o);
            if (lane < 8) for (int k = 0; k < 8; ++k) o[k] = tanhf(o[k]);
            store8(p.LA + (size_t)r * 256 + 8 * lane, o);
        } else if (lane < 28) {
            const int j = lane - 16;
            if (qside) { smix8(w_l0, w_l1, w_l2, hp, hn, c_mul, o); for (int k = 0; k < 8; ++k) o[k] = sigmoidf_(o[k]); } else { for (int k = 0; k < 8; ++k) o[k] = 0.f; }
            store8(p.LA + (size_t)r * 256 + 128 + 8 * j, o);
        } else if (lane < 32) {
            for (int k = 0; k < 8; ++k) o[k] = 0.f;
            store8(p.LA + (size_t)r * 256 + 128 + 8 * (lane - 16), o);
        }
    }
}

__device__ __forceinline__ float rope_lane(float x, int lane, int pos) {
    const int blk = lane >> 5, jj = lane & 31, i = jj & 15;
    const int pp = blk ? (pos & 63) : (pos >> 6);
    const float freq = exp2f(-(float)i * (13.287712379549449f / 16.0f));
    const float ang = (float)pp * freq;
    float s, c; sincosf(ang, &s, &c);
    const float xp = __shfl_xor(x, 16);
    return (jj < 16) ? (x * c - xp * s) : (xp * s + x * c);
}
__device__ __forceinline__ void ph_prepB(const int wid0, const Params& p, int l) {
    PH_PROLOG;
    const float* qg = p.in[16] + l * 192; const float* kg = p.in[17] + l * 192;
    const int lane = LANE;
    const float MLA_SCALE = 0.07216878364870323f * 1.4426950408889634f;
    const float qg0 = qg[lane], qg1 = qg[lane + 64], qg2 = qg[lane + 128], kg0 = kg[lane], kg1 = kg[lane + 64], kg2 = kg[lane + 128];
    const float rfreq = exp2f(-(float)(lane & 15) * (13.287712379549449f / 16.0f));
    for (int r = GWAVE; r < TT; r += NWAVE) {
        const bf16_t* q = p.Q0 + (size_t)r * 768; const bf16_t* kv = p.KV0 + (size_t)r * 1024; const bf16_t* zr = p.ZS + (size_t)r * ZW + 1280 + lane;
        bf16_t qv[4][3], kw[4][2];
#pragma unroll
        for (int h = 0; h < 4; ++h) { qv[h][0] = q[h * 192 + lane]; qv[h][1] = q[h * 192 + lane + 64]; qv[h][2] = q[h * 192 + lane + 128]; kw[h][0] = kv[h * 256 + lane]; kw[h][1] = kv[h * 256 + lane + 64]; }
        const bf16_t k2 = zr[0];
        float rs_ = 0.f, rc_ = 1.f;
        if (r < T) { const int pos = r & 2047, pp = (lane >> 5) ? (pos & 63) : (pos >> 6); __sincosf((float)pp * rfreq, &rs_, &rc_); }
#pragma unroll
        for (int h = 0; h < 4; ++h) {
            {
                float x0 = bf2f(qv[h][0]), x1 = bf2f(qv[h][1]), x2 = bf2f(qv[h][2]);
                const float ss = wave_sum(x0 * x0 + x1 * x1 + x2 * x2), rs = rsqrtf(ss * (1.0f / 192.0f) + NORM_EPS);
                x0 *= rs * qg0; x1 *= rs * qg1; x2 *= rs * qg2;
                if (r < T) { const float xp = __shfl_xor(x2, 16); x2 = ((lane & 31) < 16) ? (x2 * rc_ - xp * rs_) : (xp * rs_ + x2 * rc_); }
                bf16_t* o = p.MQ + ((size_t)r * 4 + h) * 192;
                o[lane] = f2bf(x0 * MLA_SCALE); o[lane + 64] = f2bf(x1 * MLA_SCALE); o[lane + 128] = f2bf(x2 * MLA_SCALE);
            }
            {
                float x0 = bf2f(kw[h][0]), x1 = bf2f(kw[h][1]), x2 = bf2f(k2);
                const float ss = wave_sum(x0 * x0 + x1 * x1 + x2 * x2), rs = rsqrtf(ss * (1.0f / 192.0f) + NORM_EPS);
                x0 *= rs * kg0; x1 *= rs * kg1; x2 *= rs * kg2;
                if (r < T) { const float xp = __shfl_xor(x2, 16); x2 = ((lane & 31) < 16) ? (x2 * rc_ - xp * rs_) : (xp * rs_ + x2 * rc_); }
                bf16_t* o = p.MK + ((size_t)r * 4 + h) * 192;
                o[lane] = f2bf(x0); o[lane + 64] = f2bf(x1); o[lane + 128] = f2bf(x2);
            }
        }
    }
    for (int it = GWAVE; it < 8 * 4 * 36 + 8 * 8 * 36; it += NWAVE) {
        const bool na = it >= 8 * 4 * 36; const int j = na ? it - 8 * 4 * 36 : it;
        const int g = j % 36, bh = j / 36, nh = na ? 8 : 4, b = bh / nh, h = bh % nh;
        const int kk = 64 * g + lane, krow = kk < 2048 ? b * 2048 + kk : T + b * 256 + (kk - 2048);
        const int kap = kk & 15, slot = (kk & ~15) + 8 * ((kap >> 2) & 1) + (kap & 3) + 4 * (kap >> 3);
        if (!na) {
            const bf16_t* src = p.KV0 + (size_t)krow * 1024 + h * 256 + 128; bf16_t* dst = p.MVT + ((size_t)(b * 4 + h) * 128) * 2304 + slot;
            u32x4 wv[16];
#pragma unroll
            for (int i = 0; i < 16; ++i) wv[i] = *(const u32x4*)(src + 8 * i);
#pragma unroll
            for (int i = 0; i < 16; ++i) { const unsigned ww[4] = {wv[i].x, wv[i].y, wv[i].z, wv[i].w};
#pragma unroll
                for (int k = 0; k < 8; ++k) dst[(size_t)(8 * i + k) * 2304] = (bf16_t)((ww[k >> 1] >> ((k & 1) * 16)) & 0xffffu); }
        } else {
            const bf16_t* src = p.ZS + (size_t)krow * ZW + 512 + h * 64; bf16_t* dst = p.NVT + ((size_t)(b * 8 + h) * 64) * 2304 + slot;
            u32x4 wv[8];
#pragma unroll
            for (int i = 0; i < 8; ++i) wv[i] = *(const u32x4*)(src + 8 * i);
#pragma unroll
            for (int i = 0; i < 8; ++i) { const unsigned ww[4] = {wv[i].x, wv[i].y, wv[i].z, wv[i].w};
#pragma unroll
                for (int k = 0; k < 8; ++k) dst[(size_t)(8 * i + k) * 2304] = (bf16_t)((ww[k >> 1] >> ((k & 1) * 16)) & 0xffffu); }
        }
    }
}

typedef float f32x16 __attribute__((ext_vector_type(16)));
__device__ __forceinline__ unsigned cvtpk(float lo, float hi) { return pk2(lo, hi); }
#define MFMA32(a, b, c) __builtin_amdgcn_mfma_f32_32x32x16_bf16((a), (b), (c), 0, 0, 0)
template <int NDB> __device__ __forceinline__ void softmax_step(f32x16& x0, f32x16& x1, float& m, float& lsum, f32x16 (&O)[NDB], bf16x8 (&pf)[4]) {
    constexpr float THR = 11.0f;
    float mx = x0[0];
#pragma unroll
    for (int r = 1; r < 16; ++r) mx = fmaxf(mx, x0[r]);
#pragma unroll
    for (int r = 0; r < 16; ++r) mx = fmaxf(mx, x1[r]);
    { auto rr = __builtin_amdgcn_permlane32_swap(__float_as_uint(mx), __float_as_uint(mx), false, false); mx = fmaxf(__uint_as_float(rr[0]), __uint_as_float(rr[1])); }
    if (!__all(mx - m <= THR)) {
        const float mn = fmaxf(m, mx), alpha = __builtin_amdgcn_exp2f(m - mn);
        lsum *= alpha;
#pragma unroll
        for (int d = 0; d < NDB; ++d) O[d] *= alpha;
        m = mn;
    }
    float ps = 0.f;
#pragma unroll
    for (int r = 0; r < 16; ++r) { x0[r] = __builtin_amdgcn_exp2f(x0[r] - m); ps += x0[r]; }
#pragma unroll
    for (int r = 0; r < 16; ++r) { x1[r] = __builtin_amdgcn_exp2f(x1[r] - m); ps += x1[r]; }
    lsum += ps;
    u32x4 w;
    w.x = cvtpk(x0[0], x0[1]); w.y = cvtpk(x0[2], x0[3]); w.z = cvtpk(x0[4], x0[5]); w.w = cvtpk(x0[6], x0[7]); pf[0] = *reinterpret_cast<bf16x8*>(&w);
    w.x = cvtpk(x0[8], x0[9]); w.y = cvtpk(x0[10], x0[11]); w.z = cvtpk(x0[12], x0[13]); w.w = cvtpk(x0[14], x0[15]); pf[1] = *reinterpret_cast<bf16x8*>(&w);
    w.x = cvtpk(x1[0], x1[1]); w.y = cvtpk(x1[2], x1[3]); w.z = cvtpk(x1[4], x1[5]); w.w = cvtpk(x1[6], x1[7]); pf[2] = *reinterpret_cast<bf16x8*>(&w);
    w.x = cvtpk(x1[8], x1[9]); w.y = cvtpk(x1[10], x1[11]); w.z = cvtpk(x1[12], x1[13]); w.w = cvtpk(x1[14], x1[15]); pf[3] = *reinterpret_cast<bf16x8*>(&w);
}
template <int NDB> __device__ __forceinline__ void attn_store(const f32x16 (&O)[NDB], float lsum, bf16_t* yrow, int hh) {
    { auto rr = __builtin_amdgcn_permlane32_swap(__float_as_uint(lsum), __float_as_uint(lsum), false, false); lsum = __uint_as_float(rr[0]) + __uint_as_float(rr[1]); }
    const float inv = 1.0f / lsum;
#pragma unroll
    for (int d = 0; d < NDB; ++d)
#pragma unroll
        for (int g = 0; g < 4; ++g) {
            u32x2 w; w.x = cvtpk(O[d][4 * g] * inv, O[d][4 * g + 1] * inv); w.y = cvtpk(O[d][4 * g + 2] * inv, O[d][4 * g + 3] * inv);
            *(u32x2*)(yrow + d * 32 + 8 * g + 4 * hh) = w;
        }
}

__device__ __forceinline__ void ph_mla_flash(const int wid0, const Params& p, int l, LAS unsigned char* lds) {
    PH_PROLOG;
    const int tid = TID, wid = __builtin_amdgcn_readfirstlane(tid >> 6), lane = tid & 63, r = lane & 31, hh = lane >> 5;
    constexpr int KP = 400, VP = 144, KBUF = 64 * KP, VBUF = 128 * VP, BUF = KBUF + VBUF;
    const int nunits = 256 + (l == 0 ? 32 : 0);
    const int vblk = (gridDim.x == 256) ? (int)((blockIdx.x & 7) * 32 + (blockIdx.x >> 3)) : (int)blockIdx.x;
    for (int u = vblk; u < nunits; u += gridDim.x) {
        int b, h, qrow0, nkt; bool ctxonly;
        if (u < 256) { b = u >> 5; h = (u >> 3) & 3; qrow0 = b * 2048 + (u & 7) * 256; nkt = 36; ctxonly = false; }
        else { const int j = u - 256; b = j >> 2; h = j & 3; qrow0 = T + b * 256; nkt = 4; ctxonly = true; }
        bf16x8 qf[12];
        { const bf16_t* qp = p.MQ + ((size_t)(qrow0 + wid * 32 + r) * 4 + h) * 192 + 8 * hh;
#pragma unroll
          for (int s = 0; s < 12; ++s) qf[s] = *(const bf16x8*)(qp + 16 * s); }
        f32x16 O[4];
#pragma unroll
        for (int d = 0; d < 4; ++d)
#pragma unroll
            for (int k = 0; k < 16; ++k) O[d][k] = 0.f;
        float m = -1.0e30f, lsum = 0.f;
        u32x4 kreg[3], vreg[2];
        const bf16_t* vtb = p.MVT + ((size_t)(b * 4 + h) * 128) * 2304;
#define MLA_LOAD(t) do { const int _t = (t); \
            const int krow0 = ctxonly ? (T + b * 256 + 64 * _t) : (_t < 32 ? b * 2048 + 64 * _t : T + b * 256 + 64 * (_t - 32)); \
            const int slot0 = ctxonly ? 2048 + 64 * _t : 64 * _t; \
            _Pragma("unroll") for (int i = 0; i < 3; ++i) { const int q = tid + 512 * i, row = q / 24, c = q % 24; kreg[i] = *(const u32x4*)(p.MK + ((size_t)(krow0 + row) * 4 + h) * 192 + c * 8); } \
            _Pragma("unroll") for (int i = 0; i < 2; ++i) { const int q = tid + 512 * i, d = q >> 3, c = q & 7; vreg[i] = *(const u32x4*)(vtb + (size_t)d * 2304 + slot0 + c * 8); } } while (0)
#define MLA_STORE(buf) do { LAS unsigned char* kb_ = lds + (buf) * BUF; \
            _Pragma("unroll") for (int i = 0; i < 3; ++i) { const int q = tid + 512 * i, row = q / 24, c = q % 24; *(LAS u32x4*)(kb_ + row * KP + c * 16) = kreg[i]; } \
            _Pragma("unroll") for (int i = 0; i < 2; ++i) { const int q = tid + 512 * i, d = q >> 3, c = q & 7; *(LAS u32x4*)(kb_ + KBUF + d * VP + c * 16) = vreg[i]; } } while (0)
        __syncthreads();
        MLA_LOAD(0); MLA_STORE(0);
        __syncthreads();
        for (int t = 0; t < nkt; ++t) {
            if (t + 1 < nkt) MLA_LOAD(t + 1);
            const LAS unsigned char* kb = lds + (t & 1) * BUF; const LAS unsigned char* vb = kb + KBUF;
            f32x16 x0, x1;
#pragma unroll
            for (int k = 0; k < 16; ++k) { x0[k] = 0.f; x1[k] = 0.f; }
#pragma unroll
            for (int s = 0; s < 12; s += 3) {
                bf16x8 a0[3], a1[3];
#pragma unroll
                for (int q = 0; q < 3; ++q) { a0[q] = *(const LAS bf16x8*)(kb + r * KP + (16 * (s + q) + 8 * hh) * 2); a1[q] = *(const LAS bf16x8*)(kb + (32 + r) * KP + (16 * (s + q) + 8 * hh) * 2); }
                __builtin_amdgcn_sched_barrier(0);
#pragma unroll
                for (int q = 0; q < 3; ++q) { x0 = MFMA32(a0[q], qf[s + q], x0); x1 = MFMA32(a1[q], qf[s + q], x1); }
                __builtin_amdgcn_sched_barrier(0);
            }
            bf16x8 pf[4];
            softmax_step<4>(x0, x1, m, lsum, O, pf);
#pragma unroll
            for (int d = 0; d < 4; ++d) {
                bf16x8 a[4];
#pragma unroll
                for (int j = 0; j < 4; ++j) a[j] = *(const LAS bf16x8*)(vb + (d * 32 + r) * VP + (j * 16 + 8 * hh) * 2);
                __builtin_amdgcn_sched_barrier(0);
#pragma unroll
                for (int j = 0; j < 4; ++j) O[d] = MFMA32(a[j], pf[j], O[d]);
                __builtin_amdgcn_sched_barrier(0);
            }
            if (t + 1 < nkt) MLA_STORE((t + 1) & 1);
            __syncthreads();
        }
#undef MLA_LOAD
#undef MLA_STORE
        attn_store<4>(O, lsum, p.Y + (size_t)(qrow0 + wid * 32 + r) * 2048 + 1024 + h * 128, hh);
    }
}

__device__ __forceinline__ void ph_na_flash(const int wid0, const Params& p, int l, LAS unsigned char* lds) {
    PH_PROLOG;
    const int tid = TID, lane = tid & 63, r = lane & 31, hh = lane >> 5;
    LAS float* bt = (LAS float*)lds;
    { const float* rpb = p.in[11] + (size_t)l * 8 * 15 * 31; for (int i = tid; i < 8 * 15 * 31; i += 512) bt[i] = rpb[i] * 1.4426950408889634f; }
    __syncthreads();
    const int nitems = 4096 + (l == 0 ? 512 : 0);
    int c0, cend, cstep;
    if (gridDim.x == 256) {
        const int xcd = blockIdx.x & 7, j = blockIdx.x >> 3, nch = nitems >> 3;
        if ((j & 7) == 7) { c0 = 0; cend = 0; cstep = 256; }
        else { c0 = (7 - xcd) * 28 + j - (j >> 3); cend = nch; cstep = 224; }
    } else { c0 = (int)blockIdx.x; cend = nitems >> 3; cstep = (int)gridDim.x; }
    for (int ch = c0; ch < cend; ch += cstep) {
        const int it = ch * 8 + wid0;
        int b, h, gr = 0, w = 0, qrow0; const bool isctx = it >= 4096;
        if (!isctx) { b = it >> 9; h = (it >> 6) & 7; gr = (it >> 1) & 31; w = it & 1; qrow0 = b * 2048 + gr * 64 + w * 32; }
        else { const int j = it - 4096; b = j >> 6; h = (j >> 3) & 7; qrow0 = T + b * 256 + (j & 7) * 32; }
        bf16x8 qf[4];
        { const bf16_t* qp = p.NQ + (size_t)(qrow0 + r) * 512 + h * 64 + 8 * hh;
#pragma unroll
          for (int s = 0; s < 4; ++s) qf[s] = *(const bf16x8*)(qp + 16 * s); }
        const int qc = w * 32 + r, rs = min(max(gr - 4, 0), 24), cs = min(max(qc - 8, 0), 48);
        f32x16 O[2];
#pragma unroll
        for (int d = 0; d < 2; ++d)
#pragma unroll
            for (int k = 0; k < 16; ++k) O[d][k] = 0.f;
        float m = -1.0e30f, lsum = 0.f;
        const bf16_t* vtb = p.NVT + ((size_t)(b * 8 + h) * 64) * 2304;
        const int nsteps = isctx ? 4 : 12;
#define NA_KROW(st_) ((!isctx && (st_) < 8) ? b * 2048 + (rs + (st_)) * 64 : T + b * 256 + 64 * (isctx ? (st_) : (st_) - 8))
#define NA_LOADK(st_) do { const bf16_t* kp_ = p.NK + (size_t)(NA_KROW(st_) + r) * 512 + h * 64 + 8 * hh; \
            _Pragma("unroll") for (int s = 0; s < 4; ++s) { kf[2 * s] = *(const bf16x8*)(kp_ + 16 * s); kf[2 * s + 1] = *(const bf16x8*)(kp_ + 32 * 512 + 16 * s); } } while (0)
        bf16x8 kf[8];
        NA_LOADK(0);
        for (int st = 0; st < nsteps; ++st) {
            const bool local = !isctx && st < 8;
            int slot0, dr = 0;
            if (local) { const int kr = rs + st; slot0 = kr * 64; dr = kr - gr + 7; }
            else { const int c = isctx ? st : st - 8; slot0 = 2048 + 64 * c; }
            f32x16 x0, x1;
#pragma unroll
            for (int k = 0; k < 16; ++k) { x0[k] = 0.f; x1[k] = 0.f; }
            const bf16_t* vp = vtb + (size_t)r * 2304 + slot0 + 8 * hh;
            bf16x8 vf[8];
#pragma unroll
            for (int d = 0; d < 2; ++d)
#pragma unroll
                for (int j = 0; j < 4; ++j) vf[d * 4 + j] = *(const bf16x8*)(vp + (size_t)(d * 32) * 2304 + j * 16);
            __builtin_amdgcn_sched_barrier(0);
#pragma unroll
            for (int s = 0; s < 4; ++s) { x0 = MFMA32(kf[2 * s], qf[s], x0); x1 = MFMA32(kf[2 * s + 1], qf[s], x1); }
            __builtin_amdgcn_sched_barrier(0);
            if (st + 1 < nsteps) NA_LOADK(st + 1);
            __builtin_amdgcn_sched_barrier(0);
            if (local) {
                const LAS float* brow = bt + (h * 15 + dr) * 31;
                const int q15 = 15 - qc;
                {   float bv[16];
#pragma unroll
                    for (int k = 0; k < 16; ++k) { const int kc0 = (k & 3) + 8 * (k >> 2) + 4 * hh; bv[k] = brow[min(max(kc0 + q15, 0), 30)]; }
#pragma unroll
                    for (int k = 0; k < 16; ++k) { const int kc0 = (k & 3) + 8 * (k >> 2) + 4 * hh; x0[k] = ((unsigned)(kc0 - cs) < 16u) ? x0[k] + bv[k] : -3.0e38f; }
                }
                {   float bv[16];
#pragma unroll
                    for (int k = 0; k < 16; ++k) { const int kc1 = (k & 3) + 8 * (k >> 2) + 4 * hh + 32; bv[k] = brow[min(max(kc1 + q15, 0), 30)]; }
#pragma unroll
                    for (int k = 0; k < 16; ++k) { const int kc1 = (k & 3) + 8 * (k >> 2) + 4 * hh + 32; x1[k] = ((unsigned)(kc1 - cs) < 16u) ? x1[k] + bv[k] : -3.0e38f; }
                }
            }
            bf16x8 pf[4];
            softmax_step<2>(x0, x1, m, lsum, O, pf);
#pragma unroll
            for (int d = 0; d < 2; ++d)
#pragma unroll
                for (int j = 0; j < 4; ++j) O[d] = MFMA32(vf[d * 4 + j], pf[j], O[d]);
        }
#undef NA_LOADK
#undef NA_KROW
        attn_store<2>(O, lsum, p.Y + (size_t)(qrow0 + r) * 2048 + 512 + h * 64, hh);
    }
}

#define MFMA_F32(a, b, c) __builtin_amdgcn_mfma_f32_32x32x2f32((a), (b), (c), 0, 0, 0)
constexpr int SCAN_NCH = 16, SCAN_LC = 144;
static_assert(SCAN_LC % 32 == 16, "the fix-up pass assumes a 16-step tail block");
__device__ __forceinline__ float half_sum(float x) { auto rr = __builtin_amdgcn_permlane32_swap(__float_as_uint(x), __float_as_uint(x), false, false); return __uint_as_float(rr[0]) + __uint_as_float(rr[1]); }
#define X2(T_, i_) ((f32x2){(T_)[(i_)], (T_)[(i_) + 1]})
template <bool DOP> __device__ __forceinline__ void scan_dot(const f32x16 (&X)[2][2], const f32x16 (&Z)[2][2], const LAS float* vec, float& s0, float& s1, float& t0, float& t1) {
    f32x2 a0 = {0.f, 0.f}, a1 = {0.f, 0.f}, c0 = {0.f, 0.f}, c1 = {0.f, 0.f};
#pragma unroll
    for (int jb = 0; jb < 2; ++jb)
#pragma unroll
        for (int g = 0; g < 4; ++g) {
            const f32x4 u = *(const LAS f32x4*)(vec + jb * 32 + 8 * g);
            const f32x2 ul = {u[0], u[1]}, uh = {u[2], u[3]};
            a0 += X2(X[0][jb], 4 * g) * ul; a0 += X2(X[0][jb], 4 * g + 2) * uh;
            a1 += X2(X[1][jb], 4 * g) * ul; a1 += X2(X[1][jb], 4 * g + 2) * uh;
            if (DOP) {
                c0 += X2(Z[0][jb], 4 * g) * ul; c0 += X2(Z[0][jb], 4 * g + 2) * uh;
                c1 += X2(Z[1][jb], 4 * g) * ul; c1 += X2(Z[1][jb], 4 * g + 2) * uh;
            }
            if (g & 1) { if (DOP) asm volatile("" : "+v"(a0), "+v"(a1), "+v"(c0), "+v"(c1) :: "memory"); else asm volatile("" : "+v"(a0), "+v"(a1) :: "memory"); }
        }
    s0 = half_sum(a0[0] + a0[1]); s1 = half_sum(a1[0] + a1[1]);
    if (DOP) { t0 = half_sum(c0[0] + c0[1]); t1 = half_sum(c1[0] + c1[1]); }
}
#define MUL2(T_, i_, u_) do { const f32x2 _t = X2(T_, i_) * (u_); (T_)[(i_)] = _t[0]; (T_)[(i_) + 1] = _t[1]; } while (0)
template <bool DOP> __device__ __forceinline__ void scan_decay(f32x16 (&X)[2][2], f32x16 (&Z)[2][2], const LAS float* vec) {
#pragma unroll
    for (int jb = 0; jb < 2; ++jb)
#pragma unroll
        for (int g = 0; g < 4; ++g) {
            const f32x4 u = *(const LAS f32x4*)(vec + jb * 32 + 8 * g);
            const f32x2 ul = {u[0], u[1]}, uh = {u[2], u[3]};
            MUL2(X[0][jb], 4 * g, ul); MUL2(X[0][jb], 4 * g + 2, uh); MUL2(X[1][jb], 4 * g, ul); MUL2(X[1][jb], 4 * g + 2, uh);
            if (DOP) { MUL2(Z[0][jb], 4 * g, ul); MUL2(Z[0][jb], 4 * g + 2, uh); MUL2(Z[1][jb], 4 * g, ul); MUL2(Z[1][jb], 4 * g + 2, uh); }
            if (g & 1) asm volatile("" ::: "memory");
        }
}
constexpr int SCAN_D = 8, SCAN_SLOT = R1B + R2B, SCAN_RING = (SCAN_D + 1) * SCAN_SLOT;
template <bool DOP, bool DOY, bool DOZ = false>
__device__ __forceinline__ void scan_run(const Params& p, int b, int h, int d, int s0, int s1, f32x16 (&Q)[2][2], f32x16 (&P)[2][2], LAS unsigned char* ring, int lane) {
    const int half = lane >> 5, l32 = lane & 31;
    const char* g1 = p.R1 + (size_t)(b * 8 + h) * 2304 * R1B;
    const char* g2 = p.R2 + (size_t)((b * 8 + h) * 2 + d) * 2304 * R2B;
    float* YS = p.YS + (size_t)((b * 8 + h) * 2 + d) * 2304 * 64;
    bf16_t* ZB = p.ZB + (size_t)((b * 8 + h) * 2 + d) * 2304 * 64;
    const unsigned lo16 = (unsigned)lane * 16u, lo4 = (unsigned)lane * 4u;
#define SCAN_ISSUE(sidx, slot) do { const int _s = (sidx); const int _p1 = d ? pos_rev(_s) : _s; LAS unsigned char* _sl = ring + (slot) * SCAN_SLOT; \
        if (lane < 40) __builtin_amdgcn_global_load_lds((const unsigned*)(g1 + (size_t)_p1 * R1B + lo16), (LAS unsigned*)(_sl), 16, 0, 0); \
        if (lane < 32) __builtin_amdgcn_global_load_lds((const unsigned*)(g2 + (size_t)_s * R2B + lo16), (LAS unsigned*)(_sl + R1B), 16, 0, 0); } while (0)
    { LAS unsigned char* zs = ring + SCAN_D * SCAN_SLOT; *(LAS u32x4*)(zs + lo16) = (u32x4){0u, 0u, 0u, 0u}; if (lane < (SCAN_SLOT - 1024) / 16) *(LAS u32x4*)(zs + 1024 + lo16) = (u32x4){0u, 0u, 0u, 0u}; }
#pragma unroll
    for (int k = 0; k < SCAN_D - 1; ++k) SCAN_ISSUE(s0 + k, k);
    for (int sb = s0; sb < s1; sb += 2) {
#pragma unroll
        for (int uu = 0; uu < 2; ++uu) {
            const int s = sb + uu, u = (s - s0) & (SCAN_D - 1);
            SCAN_ISSUE(min(s + SCAN_D - 1, s1 - 1), (u + SCAN_D - 1) & (SCAN_D - 1));
            asm volatile("s_waitcnt vmcnt(14)" ::: "memory");
            const LAS unsigned char* sl = ring + u * SCAN_SLOT;
            const LAS float* Lh = (const LAS float*)sl + 4 * half;
            const LAS unsigned char* sh = (half ? ring + SCAN_D * SCAN_SLOT : sl) + l32 * 2;
            const unsigned kd0 = *(const LAS bf16_t*)(sh + R1B + 384), kd1 = *(const LAS bf16_t*)(sh + R1B + 384 + 64);
            const unsigned nb0 = *(const LAS bf16_t*)(sh + R1B + 256), nb1 = *(const LAS bf16_t*)(sh + R1B + 256 + 64);
            const unsigned vb0 = *(const LAS bf16_t*)(sh + 512), vb1 = *(const LAS bf16_t*)(sh + 512 + 64);
            float sq0, sq1, sp0 = 0.f, sp1 = 0.f;
            scan_dot<DOP>(Q, P, Lh, sq0, sq1, sp0, sp1);
            scan_decay<DOP>(Q, P, (const LAS float*)(sl + R1B) + 4 * half);
            u32x4 fa0 = {kd0 | (nb0 << 16), nb0, 0u, 0u}, fa1 = {kd1 | (nb1 << 16), nb1, 0u, 0u};
            const bf16x8 A0 = *reinterpret_cast<bf16x8*>(&fa0), A1 = *reinterpret_cast<bf16x8*>(&fa1);
#define SCAN_BFRAG(name, vb, sa) u32x4 name##_w = {0u, 0u, 0u, 0u}; { const unsigned _hi = (unsigned)f2bf(sa); const float _lo = (sa) - __uint_as_float(_hi << 16); \
                name##_w.x = (vb) | (_hi << 16); name##_w.y = (unsigned)f2bf(_lo); } const bf16x8 name = *reinterpret_cast<bf16x8*>(&name##_w)
            SCAN_BFRAG(B0q, vb0, sq0); SCAN_BFRAG(B1q, vb1, sq1);
            Q[0][0] = MFMA32(A0, B0q, Q[0][0]); Q[0][1] = MFMA32(A1, B0q, Q[0][1]);
            Q[1][0] = MFMA32(A0, B1q, Q[1][0]); Q[1][1] = MFMA32(A1, B1q, Q[1][1]);
            if (DOP) {
                SCAN_BFRAG(B0p, 0u, sp0); SCAN_BFRAG(B1p, 0u, sp1);
                P[0][0] = MFMA32(A0, B0p, P[0][0]); P[0][1] = MFMA32(A1, B0p, P[0][1]);
                P[1][0] = MFMA32(A0, B1p, P[1][0]); P[1][1] = MFMA32(A1, B1p, P[1][1]);
            }
#undef SCAN_BFRAG
            if (DOY) {
                float y0, y1, u0, u1; scan_dot<false>(Q, Q, Lh + 64, y0, y1, u0, u1);
                *(float*)((char*)(YS + (size_t)s * 64) + lo4) = half ? y1 : y0;
            }
            if (DOZ) {
                float y0, y1, z0, z1; scan_dot<true>(Q, P, Lh + 64, y0, y1, z0, z1);
                *(float*)((char*)(YS + (size_t)s * 64) + lo4) = half ? y1 : y0;
                *(bf16_t*)((char*)(ZB + (size_t)s * 64) + (lo4 >> 1)) = f2bf(half ? z1 : z0);
            }
        }
    }
    asm volatile("s_waitcnt vmcnt(0)" ::: "memory");
#undef SCAN_ISSUE
}
__device__ __forceinline__ void scan_zero(f32x16 (&X)[2][2]) {
#pragma unroll
    for (int a = 0; a < 2; ++a)
#pragma unroll
        for (int c = 0; c < 2; ++c)
#pragma unroll
            for (int k = 0; k < 16; ++k) X[a][c][k] = 0.f;
}
__device__ __forceinline__ void scan_store_acc(float* dst, const f32x16 (&X)[2][2], int lane) {
#pragma unroll
    for (int a = 0; a < 2; ++a)
#pragma unroll
        for (int c = 0; c < 2; ++c)
#pragma unroll
            for (int k = 0; k < 16; ++k) dst[((a * 2 + c) * 16 + k) * 64 + lane] = X[a][c][k];
}
__device__ __forceinline__ void scan_load_acc(const float* src, f32x16 (&X)[2][2], int lane) {
#pragma unroll
    for (int a = 0; a < 2; ++a)
#pragma unroll
        for (int c = 0; c < 2; ++c)
#pragma unroll
            for (int k = 0; k < 16; ++k) X[a][c][k] = src[((a * 2 + c) * 16 + k) * 64 + lane];
}
__device__ __forceinline__ void ph_scan_a(const int wid0, const Params& p, LAS unsigned char* lds) {
    PH_PROLOG;
    const int lane = LANE, wid = WID, half = lane >> 5, l32 = lane & 31;
    LAS unsigned char* L = lds + wid * SCAN_RING;
    for (int it = wid * (int)gridDim.x + (int)blockIdx.x; it < 128 * 16; it += NWAVE) {
        const int c = it >> 7, sid = it & 127, b = sid >> 4, h = (sid >> 1) & 7, d = sid & 1;
        f32x16 Q[2][2], P[2][2];
        scan_zero(Q);
        if (c == 0) {
            scan_run<false, true>(p, b, h, d, 0, SCAN_LC, Q, P, L, lane);
        } else {
#pragma unroll
            for (int a = 0; a < 2; ++a)
#pragma unroll
                for (int cc = 0; cc < 2; ++cc)
#pragma unroll
                    for (int k = 0; k < 16; ++k) P[a][cc][k] = (a == cc && l32 == ((k & 3) + 8 * (k >> 2) + 4 * half)) ? 1.f : 0.f;
            scan_run<true, false, true>(p, b, h, d, c * SCAN_LC, (c + 1) * SCAN_LC, Q, P, L, lane);
            if (c == 15) continue;
            float* pm = p.PMAT + ((size_t)sid * 16 + c) * 4096;
#pragma unroll
            for (int a = 0; a < 2; ++a)
#pragma unroll
                for (int cc = 0; cc < 2; ++cc)
#pragma unroll
                    for (int k = 0; k < 16; ++k)
                        pm[(cc * 32 + (k & 3) + 8 * (k >> 2) + 4 * half) * 64 + a * 32 + l32] = P[a][cc][k];
        }
        scan_store_acc(p.QMAT + ((size_t)sid * 16 + c) * 4096, Q, lane);
    }
}
__device__ __forceinline__ void ph_scan_b(const int wid0, const Params& p) {
    PH_PROLOG;
    const int lane = LANE, wid = WID, half = lane >> 5, l32 = lane & 31;
    const bool packed = gridDim.x == 256;
    if (packed && ((blockIdx.x >> 3) & 7) != 7) return;
    for (int it = packed ? (((int)blockIdx.x >> 6) * 8 + ((int)blockIdx.x & 7)) * 8 + wid : wid * (int)gridDim.x + (int)blockIdx.x; it < 256; it += packed ? 256 : NWAVE) {
        const int sid = it >> 1, ib = it & 1;
        f32x16 X[2];
        { const float* q0 = p.QMAT + ((size_t)sid * 16 + 0) * 4096;
#pragma unroll
          for (int c = 0; c < 2; ++c)
#pragma unroll
              for (int k = 0; k < 16; ++k) X[c][k] = q0[((ib * 2 + c) * 16 + k) * 64 + lane]; }
        for (int c = 1; c < 15; ++c) {
            const float* qc = p.QMAT + ((size_t)sid * 16 + c) * 4096 + lane; const float* pm = p.PMAT + ((size_t)sid * 16 + c) * 4096 + l32 * 64 + 4 * half;
            f32x16 N[2]; f32x4 A0[2][4], A1[2][4];
#pragma unroll
            for (int cc = 0; cc < 2; ++cc)
#pragma unroll
                for (int k = 0; k < 16; ++k) N[cc][k] = qc[((ib * 2 + cc) * 16 + k) * 64];
#pragma unroll
            for (int jb = 0; jb < 2; ++jb)
#pragma unroll
                for (int kq = 0; kq < 4; ++kq) { A0[jb][kq] = *(const f32x4*)(pm + jb * 32 + 8 * kq); A1[jb][kq] = *(const f32x4*)(pm + 32 * 64 + jb * 32 + 8 * kq); }
            float* sm = p.SMAT + ((size_t)sid * 16 + c) * 4096 + lane;
#pragma unroll
            for (int cc = 0; cc < 2; ++cc)
#pragma unroll
                for (int k = 0; k < 16; ++k) sm[((ib * 2 + cc) * 16 + k) * 64] = X[cc][k];
#pragma unroll
            for (int jb = 0; jb < 2; ++jb)
#pragma unroll
                for (int k = 0; k < 16; ++k) { N[0] = MFMA_F32(A0[jb][k >> 2][k & 3], X[jb][k], N[0]); N[1] = MFMA_F32(A1[jb][k >> 2][k & 3], X[jb][k], N[1]); }
            X[0] = N[0]; X[1] = N[1];
        }
        {   float* sm = p.SMAT + ((size_t)sid * 16 + 15) * 4096 + lane;
#pragma unroll
            for (int cc = 0; cc < 2; ++cc)
#pragma unroll
                for (int k = 0; k < 16; ++k) sm[((ib * 2 + cc) * 16 + k) * 64] = X[cc][k]; }
    }
}
__device__ __forceinline__ void ph_scan_c(const int wid0, const Params& p, LAS unsigned char* lds) {
    PH_PROLOG;
    (void)lds;
    const int lane = LANE, wid = WID, half = lane >> 5, l32 = lane & 31;
    for (int it = wid * (int)gridDim.x + (int)blockIdx.x; it < 128 * 15; it += NWAVE) {
        const int c = 1 + (it >> 7), sid = it & 127;
        f32x16 S[2][2];
        scan_load_acc(p.SMAT + ((size_t)sid * 16 + c) * 4096, S, lane);
        float* ys = p.YS + ((size_t)sid * 2304 + c * SCAN_LC) * 64;
        const bf16_t* zs = p.ZB + ((size_t)sid * 2304 + c * SCAN_LC) * 64;
#pragma unroll 1
        for (int tb = 0; tb < (SCAN_LC + 31) / 32; ++tb) {
            const int t = tb * 32 + l32;
            float za[2][16];
#pragma unroll
            for (int jb = 0; jb < 2; ++jb)
#pragma unroll
                for (int g = 0; g < 4; ++g) {
                    u32x2 w = *(const u32x2*)(zs + (size_t)min(t, SCAN_LC - 1) * 64 + jb * 32 + 8 * g + 4 * half);
                    if (t >= SCAN_LC) w = (u32x2){0u, 0u};
                    za[jb][4 * g] = __uint_as_float(w.x << 16); za[jb][4 * g + 1] = __uint_as_float(w.x & 0xffff0000u);
                    za[jb][4 * g + 2] = __uint_as_float(w.y << 16); za[jb][4 * g + 3] = __uint_as_float(w.y & 0xffff0000u);
                }
            f32x16 D[2];
#pragma unroll
            for (int ib = 0; ib < 2; ++ib)
#pragma unroll
                for (int k = 0; k < 16; ++k) { const int tk = tb * 32 + (k & 3) + 8 * (k >> 2) + 4 * half; D[ib][k] = ys[(size_t)min(tk, SCAN_LC - 1) * 64 + ib * 32 + l32]; }
#pragma unroll
            for (int ib = 0; ib < 2; ++ib)
#pragma unroll
                for (int jb = 0; jb < 2; ++jb)
#pragma unroll
                    for (int k = 0; k < 16; ++k) D[ib] = MFMA_F32(za[jb][k], S[ib][jb][k], D[ib]);
#pragma unroll
            for (int ib = 0; ib < 2; ++ib)
#pragma unroll
                for (int k = 0; k < 16; ++k) { const int tk = tb * 32 + (k & 3) + 8 * (k >> 2) + 4 * half; if (k < 8 || tb * 32 + 16 < SCAN_LC) ys[(size_t)tk * 64 + ib * 32 + l32] = D[ib][k]; }
        }
    }
}

__device__ __forceinline__ void ph_rwkv_out(const int wid0, const Params& p, int l) {
    PH_PROLOG;
    const float* r_k = p.in[27] + l * 512; const float* ln_w = p.in[28] + l * 512; const float* ln_b = p.in[29] + l * 512;
    const int lane = LANE, hd = lane >> 3, j0 = (lane & 7) * 8;
    const int nrows = (l == DEPTH - 1) ? T : TT;
    float c_rk[8], c_lw[8], c_lb[8];
    ldf8(r_k + 8 * lane, c_rk); ldf8(ln_w + 8 * lane, c_lw); ldf8(ln_b + 8 * lane, c_lb);
    for (int r0 = GWAVE; r0 < nrows; r0 += 2 * NWAVE) {
        f32x4 ya[2][2], yc[2][2], r4[2][2]; u32x4 wv[2], wkf[2], wkb[2], wg[2];
#pragma unroll
        for (int u = 0; u < 2; ++u) {
            const int r = min(r0 + u * NWAVE, nrows - 1);
            int b, pf; row_bpos(r, b, pf); const int pr = pos_rev(pf);
            const float* yf = p.YS + ((size_t)((b * 8 + hd) * 2 + 0) * 2304 + pf) * 64 + j0; const float* yb = p.YS + ((size_t)((b * 8 + hd) * 2 + 1) * 2304 + pr) * 64 + j0;
            const char* rec1 = p.R1 + ((size_t)(b * 8 + hd) * 2304 + pf) * R1B;
            const char* rf = p.R2 + ((size_t)((b * 8 + hd) * 2 + 0) * 2304 + pf) * R2B + 384; const char* rb = p.R2 + ((size_t)((b * 8 + hd) * 2 + 1) * 2304 + pr) * R2B + 384;
#pragma unroll
            for (int q = 0; q < 2; ++q) { ya[u][q] = *(const f32x4*)(yf + 4 * q); yc[u][q] = *(const f32x4*)(yb + 4 * q); r4[u][q] = *(const f32x4*)(rec1 + 256 + (j0 + 4 * q) * 4); }
            wv[u] = *(const u32x4*)((const bf16_t*)(rec1 + 512) + j0); wkf[u] = *(const u32x4*)((const bf16_t*)rf + j0); wkb[u] = *(const u32x4*)((const bf16_t*)rb + j0);
            wg[u] = *(const u32x4*)(p.GRW + (size_t)r * 512 + 8 * lane);
        }
#pragma unroll
        for (int u = 0; u < 2; ++u) {
            const int r = r0 + u * NWAVE;
            if (r < nrows) {
                float y[8], rr[8], kf[8], kb[8], vv[8], gg[8];
#pragma unroll
                for (int q = 0; q < 2; ++q)
#pragma unroll
                    for (int k = 0; k < 4; ++k) { y[4 * q + k] = ya[u][q][k] + yc[u][q][k]; rr[4 * q + k] = r4[u][q][k]; }
                unpack8(wv[u], vv); unpack8(wkf[u], kf); unpack8(wkb[u], kb); unpack8(wg[u], gg);
                float s = 0.f; for (int k = 0; k < 8; ++k) s += y[k]; s = sum8(s); const float mu = s * (1.0f / 64.0f);
                float q = 0.f; for (int k = 0; k < 8; ++k) { const float dlt = y[k] - mu; q += dlt * dlt; } q = sum8(q);
                const float rstd = rsqrtf(q * (1.0f / 64.0f) + 64e-5f);
                float bc = 0.f; for (int k = 0; k < 8; ++k) bc += rr[k] * (kf[k] + kb[k]) * c_rk[k]; bc = sum8(bc);
                float out[8];
                for (int k = 0; k < 8; ++k) out[k] = ((y[k] - mu) * rstd * c_lw[k] + c_lb[k] + bc * vv[k]) * gg[k];
                store8(p.Y + (size_t)r * 2048 + 1536 + 8 * lane, out);
            }
        }
    }
}

__device__ __forceinline__ void ph_moe_router(const int wid0, const Params& p, int l, LAS unsigned char* lds) {
    PH_PROLOG;
    LAS float* wr = (LAS float*)lds;
    const float* wsrc = p.in[32] + (size_t)l * 2048 * 16;
    for (int i = TID; i < 2048 * 16; i += 512) { const int c = i >> 4, e = i & 15; wr[e * 2048 + c] = wsrc[i]; }
    __syncthreads();
    const float* g = p.in[7] + l * 2048;
    const float* modl = p.MOD + (size_t)l * 9 * 12288;
    const int lane = LANE;
    const int nrows = (l == 0) ? TT : T;
    for (int r0 = GWAVE; r0 < nrows; r0 += 2 * NWAVE) {
        const int r1 = r0 + NWAVE; const bool has1 = r1 < nrows; const int r1c = has1 ? r1 : r0;
        const float* src0 = p.XCUR + (size_t)r0 * 2048; const float* src1 = p.XCUR + (size_t)r1c * 2048;
        f32x4 v0[8], v1[8]; float ss0 = 0.f, ss1 = 0.f;
#pragma unroll
        for (int i = 0; i < 8; ++i) { v0[i] = *(const f32x4*)(src0 + i * 256 + lane * 4); v1[i] = *(const f32x4*)(src1 + i * 256 + lane * 4); }
#pragma unroll
        for (int i = 0; i < 8; ++i) { ss0 += v0[i][0] * v0[i][0] + v0[i][1] * v0[i][1] + v0[i][2] * v0[i][2] + v0[i][3] * v0[i][3]; ss1 += v1[i][0] * v1[i][0] + v1[i][1] * v1[i][1] + v1[i][2] * v1[i][2] + v1[i][3] * v1[i][3]; }
        ss0 = wave_sum(ss0); ss1 = wave_sum(ss1);
        const float rs0 = rsqrtf(ss0 * (1.0f / 2048.0f) + NORM_EPS), rs1 = rsqrtf(ss1 * (1.0f / 2048.0f) + NORM_EPS);
        const float* ms0 = modl + (size_t)row_s(r0) * 12288; const float* ms1 = modl + (size_t)row_s(r1c) * 12288;
#pragma unroll
        for (int i = 0; i < 8; ++i) {
            const int c = i * 256 + lane * 4;
            const f32x4 gg = *(const f32x4*)(g + c);
            const f32x4 sh0 = *(const f32x4*)(ms0 + 3 * 2048 + c), sc0 = *(const f32x4*)(ms0 + 4 * 2048 + c), sh1 = *(const f32x4*)(ms1 + 3 * 2048 + c), sc1 = *(const f32x4*)(ms1 + 4 * 2048 + c);
            v0[i] = v0[i] * rs0 * gg * (1.0f + sc0) + sh0; v1[i] = v1[i] * rs1 * gg * (1.0f + sc1) + sh1;
        }
#pragma unroll
        for (int i = 0; i < 8; ++i) { u32x2 w; w.x = pk2(v0[i][0], v0[i][1]); w.y = pk2(v0[i][2], v0[i][3]); *(u32x2*)(p.H2 + (size_t)r0 * 2048 + i * 256 + lane * 4) = w; }
        if (has1) {
#pragma unroll
            for (int i = 0; i < 8; ++i) { u32x2 w; w.x = pk2(v1[i][0], v1[i][1]); w.y = pk2(v1[i][2], v1[i][3]); *(u32x2*)(p.H2 + (size_t)r1 * 2048 + i * 256 + lane * 4) = w; }
        }
        float a0[16], a1[16];
#pragma unroll
        for (int e = 0; e < 16; ++e) {
            float t0 = 0.f, t1 = 0.f;
#pragma unroll
            for (int i = 0; i < 8; ++i) { const f32x4 w4 = *(const LAS f32x4*)(wr + e * 2048 + i * 256 + lane * 4);
                t0 += v0[i][0] * w4[0] + v0[i][1] * w4[1] + v0[i][2] * w4[2] + v0[i][3] * w4[3]; t1 += v1[i][0] * w4[0] + v1[i][1] * w4[1] + v1[i][2] * w4[2] + v1[i][3] * w4[3]; }
            asm volatile("" : "+v"(t0), "+v"(t1) :: "memory");
            a0[e] = t0; a1[e] = t1;
        }
#pragma unroll
        for (int u = 0; u < 2; ++u) {
            if (u == 1 && !has1) break;
            const int r = u ? r1 : r0;
            float a[16];
#pragma unroll
            for (int e = 0; e < 16; ++e) a[e] = u ? a1[e] : a0[e];
#pragma unroll
            for (int j = 0; j < 8; ++j) { const bool hi = lane & 32; const float keep = hi ? a[j + 8] : a[j], send = hi ? a[j] : a[j + 8]; a[j] = keep + __shfl_xor(send, 32); }
#pragma unroll
            for (int j = 0; j < 4; ++j) { const bool hi = lane & 16; const float keep = hi ? a[j + 4] : a[j], send = hi ? a[j] : a[j + 4]; a[j] = keep + __shfl_xor(send, 16); }
#pragma unroll
            for (int j = 0; j < 2; ++j) { const bool hi = lane & 8; const float keep = hi ? a[j + 2] : a[j], send = hi ? a[j] : a[j + 2]; a[j] = keep + __shfl_xor(send, 8); }
            { const bool hi = lane & 4; const float keep = hi ? a[1] : a[0], send = hi ? a[0] : a[1]; a[0] = keep + __shfl_xor(send, 4); }
            float lg = a[0]; lg += __shfl_xor(lg, 2); lg += __shfl_xor(lg, 1);
            float mx = lg;
            mx = fmaxf(mx, __shfl_xor(mx, 4)); mx = fmaxf(mx, __shfl_xor(mx, 8)); mx = fmaxf(mx, __shfl_xor(mx, 16)); mx = fmaxf(mx, __shfl_xor(mx, 32));
            const float ex = expf(lg - mx);
            float sum = ex;
            sum += __shfl_xor(sum, 4); sum += __shfl_xor(sum, 8); sum += __shfl_xor(sum, 16); sum += __shfl_xor(sum, 32);
            const float mine = ex / sum;
            const int myexp = (lane >> 2) & 15;
            if ((lane & 3) == 0) {
                if (r < T) p.AFFT[((size_t)((r >> 11) * 16 + myexp)) * 2048 + (r & 2047)] = mine;
                else p.AFFC[((size_t)(((r - T) >> 8) * 16 + myexp)) * 256 + ((r - T) & 255)] = mine;
            }
        }
    }
}
__device__ __forceinline__ void ph_topk(const int wid0, const Params& p, int l, LAS unsigned char* lds) {
    PH_PROLOG;
    const int tid = TID, lane = tid & 63, wid = tid >> 6;
    LAS unsigned* keys = (LAS unsigned*)lds;
    LAS int* hist = (LAS int*)(lds + 8192);
    LAS int* hs2 = (LAS int*)(lds + 8192 + 1024);
    LAS int* ctl = (LAS int*)(lds + 8192 + 2048);
    LAS int* wsum = (LAS int*)(lds + 8192 + 2048 + 64);
    LAS int* lidx = (LAS int*)(lds + 8192 + 4096);
    const int nun = (l == 0) ? 256 : 128;
    for (int u = blockIdx.x; u < nun; u += gridDim.x) {
        const bool isctx = u >= 128; const int be = u & 127, b = be >> 4, e = be & 15;
        const int N = isctx ? 256 : 2048, cap = isctx ? 32 : 256;
        const float* src = isctx ? p.AFFC + (size_t)be * 256 : p.AFFT + (size_t)be * 2048;
        __syncthreads();
        for (int i = tid; i < N; i += 512) keys[i] = __float_as_uint(src[i]);
        if (tid == 0) { ctl[0] = 0; ctl[1] = cap; }
        __syncthreads();
        for (int pass = 0; pass < 4; ++pass) {
            const int shift = 24 - 8 * pass;
            if (tid < 256) hist[tid] = 0;
            __syncthreads();
            const unsigned prefix = (unsigned)ctl[0]; const int krem = ctl[1];
            for (int i = tid; i < N; i += 512) { const unsigned k = keys[i]; if (pass == 0 || (k >> (shift + 8)) == (prefix >> (shift + 8))) __hip_atomic_fetch_add(&hist[(k >> shift) & 255u], 1, __ATOMIC_RELAXED, __HIP_MEMORY_SCOPE_WORKGROUP); }
            __syncthreads();
            LAS int* a = hist; LAS int* bb = hs2;
            for (int off = 1; off < 256; off <<= 1) {
                if (tid < 256) bb[tid] = a[tid] + ((tid + off < 256) ? a[tid + off] : 0);
                __syncthreads();
                LAS int* t = a; a = bb; bb = t;
            }
            if (tid < 256) { const int S = a[tid], Sn = (tid < 255) ? a[tid + 1] : 0; if (S >= krem && Sn < krem) { ctl[0] = (int)(prefix | ((unsigned)tid << shift)); ctl[1] = krem - Sn; } }
            __syncthreads();
        }
        const unsigned Tk = (unsigned)ctl[0]; const int need = ctl[1], ngt = cap - need;
        const int per = isctx ? 1 : 4, i0 = tid * per;
        int cg = 0, ce = 0;
        if (i0 < N) for (int k = 0; k < per; ++k) { const unsigned kk = keys[i0 + k]; cg += (kk > Tk); ce += (kk == Tk); }
        int pk = cg | (ce << 16), incl = pk;
#pragma unroll
        for (int o = 1; o < 64; o <<= 1) { const int t = __shfl_up(incl, o); if (lane >= o) incl += t; }
        if (lane == 63) wsum[wid] = incl;
        __syncthreads();
        int base = 0;
        for (int w = 0; w < wid; ++w) base += wsum[w];
        int ex = base + incl - pk, pg = ex & 0xffff, pe = ex >> 16;
        if (i0 < N) for (int k = 0; k < per; ++k) {
            const int i = i0 + k; const unsigned kk = keys[i];
            const int trow = isctx ? (T + b * 256 + i) : (b * 2048 + i);
            int slot = -1;
            if (kk > Tk) { slot = pg; ++pg; } else if (kk == Tk) { if (pe < need) slot = ngt + pe; ++pe; }
            int xrow = -1;
            if (slot >= 0) { xrow = isctx ? ((128 + e) * 256 + b * 32 + slot) : ((e * 8 + b) * 256 + slot); p.IDXROW[xrow] = trow; p.GATEV[xrow] = __uint_as_float(kk); }
            p.SEL[(size_t)trow * 16 + e] = xrow;
        }
    }
}
__device__ __forceinline__ void ph_gather(const int wid0, const Params& p, int l) {
    PH_PROLOG;
    const int nrows = (l == 0) ? XE_ROWS : 128 * 256; const int lane = LANE;
    for (int r = GWAVE; r < nrows; r += NWAVE) {
        const bf16_t* src = p.H2 + (size_t)p.IDXROW[r] * 2048; bf16_t* dst = p.XE + (size_t)r * 2048;
#pragma unroll
        for (int k = 0; k < 4; ++k) *(u32x4*)(dst + (k * 64 + lane) * 8) = *(const u32x4*)(src + (k * 64 + lane) * 8);
    }
}
__device__ __forceinline__ void ph_combine(const int wid0, const Params& p, int l) {
    PH_PROLOG;
    const float* modl = p.MOD + (size_t)l * 9 * 12288; const int lane = LANE;
    const int nrows = (l == 0) ? TT : T;
    const float* g1n = p.in[6] + (l + 1 < DEPTH ? (l + 1) * 2048 : 0);
    const float* modn = p.MOD + (size_t)(l + 1 < DEPTH ? l + 1 : l) * 9 * 12288;
    int selv_n = (lane < 16 && GWAVE < nrows) ? p.SEL[(size_t)GWAVE * 16 + lane] : -1;
    for (int r = GWAVE; r < nrows; r += NWAVE) {
        const int selv = selv_n;
        { const int rn = r + NWAVE; selv_n = (lane < 16 && rn < nrows) ? p.SEL[(size_t)rn * 16 + lane] : -1; }
        const float* g2 = modl + (size_t)row_s(r) * 12288 + 5 * 2048;
        float* xp = p.XCUR + (size_t)r * 2048;
        f32x4 xv[8], gv[8];
#pragma unroll
        for (int i = 0; i < 8; ++i) { const int c = (i >> 1) * 512 + lane * 8 + (i & 1) * 4; xv[i] = *(const f32x4*)(xp + c); gv[i] = *(const f32x4*)(g2 + c); }
        float acc[32];
#pragma unroll
        for (int k = 0; k < 32; ++k) acc[k] = 0.f;
        for (int e = 0; e < 16; ++e) {
            const int xr = __shfl(selv, e);
            if (xr >= 0) {
                const bf16_t* ye = p.YE + (size_t)xr * 2048;
#pragma unroll
                for (int i = 0; i < 4; ++i) { float f[8]; load8(ye + i * 512 + lane * 8, f);
#pragma unroll
                    for (int k = 0; k < 8; ++k) acc[i * 8 + k] += f[k]; }
            }
        }
        float ss = 0.f;
#pragma unroll
        for (int i = 0; i < 4; ++i)
#pragma unroll
            for (int hh = 0; hh < 2; ++hh) {
                const int c = i * 512 + lane * 8 + hh * 4;
                f32x4 x = xv[i * 2 + hh]; const f32x4 g = gv[i * 2 + hh];
#pragma unroll
                for (int k = 0; k < 4; ++k) { x[k] += g[k] * acc[i * 8 + hh * 4 + k]; acc[i * 8 + hh * 4 + k] = x[k]; ss += x[k] * x[k]; }
                if (l == DEPTH - 1) *(f32x4*)(p.out + (size_t)r * 2048 + c) = x; else *(f32x4*)(xp + c) = x;
            }
        if (l + 1 < DEPTH) {
            ss = wave_sum(ss);
            const float rs = rsqrtf(ss * (1.0f / 2048.0f) + NORM_EPS);
            const float* ms = modn + (size_t)row_s(r) * 12288;
#pragma unroll
            for (int i = 0; i < 4; ++i) {
                const int c = i * 512 + lane * 8;
#pragma unroll
                for (int hh = 0; hh < 2; ++hh) {
                    const f32x4 gg = *(const f32x4*)(g1n + c + hh * 4), sh = *(const f32x4*)(ms + c + hh * 4), sc = *(const f32x4*)(ms + 2048 + c + hh * 4);
#pragma unroll
                    for (int k = 0; k < 4; ++k) acc[i * 8 + hh * 4 + k] = acc[i * 8 + hh * 4 + k] * rs * gg[k] * (1.0f + sc[k]) + sh[k];
                }
            }
#pragma unroll
            for (int i = 0; i < 4; ++i) store8(p.H + (size_t)r * 2048 + i * 512 + lane * 8, acc + i * 8);
        }
    }
}

#define XB_TMO      128
#define XB_XCNT(j)  (256  + 64 * (j))
#define XB_XSUB(j)  (1280 + 64 * (j))
#define XB_XGEN(j)  (2304 + 64 * (j))
#define XB_TOP      3328
#define XB_TOPGEN   3392
#define XCD_BAR_WORDS 3456
#define XB_SPIN_CAP (1u << 22)
__device__ __forceinline__ unsigned xb_ld(unsigned* p)              { return __hip_atomic_load(p, __ATOMIC_RELAXED, __HIP_MEMORY_SCOPE_AGENT); }
__device__ __forceinline__ unsigned xb_add(unsigned* p, unsigned v) { return __hip_atomic_fetch_add(p, v, __ATOMIC_RELAXED, __HIP_MEMORY_SCOPE_AGENT); }
__device__ __forceinline__ unsigned xb_xcc_id() { return (unsigned)__builtin_amdgcn_s_getreg((3 << 11) | 20) & 0xFu; }
#define XB_SPIN(cond, bar) do { unsigned _sp = 0; while (cond) { __builtin_amdgcn_s_sleep(1); \
    if ((++_sp & 255u) == 0u) { if (xb_ld(&(bar)[XB_TMO])) break; if (_sp > XB_SPIN_CAP) { atomicAdd(&(bar)[XB_TMO], 1u); break; } } } } while (0)
struct XcdBarrier { unsigned* bar; unsigned x; volatile LAS unsigned* st; int wid0; };
__device__ __forceinline__ bool xb_leader(int wid0) { return wid0 == 0 && opaque_lane() == 0; }
__device__ __forceinline__ XcdBarrier xcd_barrier_post(unsigned* bar, volatile LAS unsigned* st, int wid0) {
    XcdBarrier b; b.bar = bar; b.x = xb_xcc_id(); b.st = st; b.wid0 = wid0;
    if (xb_leader(wid0)) (void)xb_add(&bar[XB_XCNT(b.x)], 1u);
    return b;
}
__device__ __forceinline__ void xcd_barrier_complete(unsigned* bar, unsigned x, unsigned& nloc, unsigned& nx) {
    const unsigned G = gridDim.x * gridDim.y * gridDim.z;
    unsigned sum, cnt, mine, sp = 0u;
    for (;;) {
        sum = 0u; cnt = 0u; mine = 0u;
#pragma unroll
        for (unsigned j = 0; j < 16; ++j) { const unsigned c = xb_ld(&bar[XB_XCNT(j)]); sum += c; cnt += (c > 0u) ? 1u : 0u; mine = (j == x) ? c : mine; }
        if (sum == G) break;
        __builtin_amdgcn_s_sleep(1);
        if ((++sp & 255u) == 0u) { if (xb_ld(&bar[XB_TMO])) break; if (sp > XB_SPIN_CAP) { atomicAdd(&bar[XB_TMO], 1u); break; } }
    }
    nloc = mine > 0u ? mine : 1u; nx = cnt > 0u ? cnt : 1u;
}
__device__ __forceinline__ void xcd_barrier(const XcdBarrier& b) {
    asm volatile("s_waitcnt vmcnt(0)" ::: "memory");
    __syncthreads();
    if (xb_leader(b.wid0)) {
        unsigned* bar = b.bar;
        __builtin_amdgcn_s_waitcnt(0);
        unsigned nloc = b.st[0], nx = b.st[1];
        if (nloc == 0u) { xcd_barrier_complete(bar, b.x, nloc, nx); b.st[0] = nloc; b.st[1] = nx; }
        const unsigned old = xb_add(&bar[XB_XSUB(b.x)], 1u);
        const unsigned gen = old / nloc;
        if (old + 1u == (gen + 1u) * nloc) {
            __builtin_amdgcn_fence(__ATOMIC_RELEASE, "agent");
            asm volatile("s_waitcnt vmcnt(0)" ::: "memory");
            const unsigned og = xb_add(&bar[XB_TOP], 1u);
            const unsigned tg = og / nx;
            if (og + 1u == (tg + 1u) * nx) xb_add(&bar[XB_TOPGEN], 1u);
            else XB_SPIN(xb_ld(&bar[XB_TOPGEN]) == tg, bar);
            __builtin_amdgcn_fence(__ATOMIC_ACQUIRE, "agent");
            xb_add(&bar[XB_XGEN(b.x)], 1u);
            asm volatile("s_waitcnt vmcnt(0)" ::: "memory");
        } else {
            XB_SPIN(xb_ld(&bar[XB_XGEN(b.x)]) == gen, bar);
            __builtin_amdgcn_fence(__ATOMIC_ACQUIRE, "agent");
            asm volatile("s_waitcnt vmcnt(0)" ::: "memory");
        }
    }
    __syncthreads();
}

enum { PH_ADALN_P = 0, PH_ADALN_R, PH_CONST, PH_CVT_MIX, PH_MODULATE, PH_GEMM_WIN, PH_PREPA, PH_GEMM_LORA, PH_GEMM_FCHAN, PH_GEMM_UQ, PH_GEMM_UKV, PH_PREPB,
       PH_MLA, PH_NA, PH_SCAN, PH_SCAN_A, PH_SCAN_B, PH_SCAN_C, PH_GEMM_WIN_DEFER, PH_RWKV_OUT, PH_GEMM_FSEQ, PH_GEMM_FSEQC, PH_GEMM_MERGE, PH_GEMM_WOUT, PH_CVT_MOE, PH_ROUTER, PH_TOPK, PH_GATHER, PH_GEMM_MOE1, PH_GEMM_MOE2, PH_COMBINE };

template <int PH> __device__ __forceinline__ void run_phase(const int wid0, const Params& p, int l, LAS unsigned char* lds, int blk0 = 0, int nblk = 0) {
    const int G = nblk ? nblk : (int)gridDim.x, c = (int)blockIdx.x - blk0;
    if constexpr (PH == PH_ADALN_P) ph_adaln_partial(wid0, p, lds);
    else if constexpr (PH == PH_ADALN_R) ph_adaln_reduce(wid0, p);
    else if constexpr (PH == PH_CONST) ph_const(wid0, p);
    else if constexpr (PH == PH_CVT_MIX) ph_cvt_mixer(wid0, p, l, lds, 3, (int)blockIdx.x, (int)gridDim.x);
    else if constexpr (PH == PH_MODULATE) ph_modulate(wid0, p, l, p.H);
    else if constexpr (PH == PH_GEMM_WIN || PH == PH_GEMM_WIN_DEFER) {
        pg8::SchedRects S{(const char*)p.H, (const char*)p.WIN_T, 256L * 2048 * 2, 256L * 2048 * 2, G, c, {{0, 0, 0, 0}, {0, 0, 0, 0}, {0, 0, 0, 0}}};
        constexpr bool DEF = (PH == PH_GEMM_WIN_DEFER);
        if (l == 0) {
            if (!DEF) { S.r[0][0] = 0; S.r[0][1] = 69; S.r[0][2] = 0; S.r[0][3] = 51;  S.r[1][0] = 69; S.r[1][1] = 1; S.r[1][2] = 0; S.r[1][3] = 27;  S.r[2][0] = 70; S.r[2][1] = 2; S.r[2][2] = 0; S.r[2][3] = 19; }
            else      { S.r[0][0] = 69; S.r[0][1] = 1; S.r[0][2] = 27; S.r[0][3] = 24;  S.r[1][0] = 70; S.r[1][1] = 2; S.r[1][2] = 19; S.r[1][3] = 32; }
        } else {
            if (!DEF) { S.r[0][0] = 0; S.r[0][1] = 63; S.r[0][2] = 0; S.r[0][3] = 51;  S.r[1][0] = 63; S.r[1][1] = 1; S.r[1][2] = 0; S.r[1][3] = 35;  S.r[2][0] = 64; S.r[2][1] = 8; S.r[2][2] = 0; S.r[2][3] = 10; }
            else      { S.r[0][0] = 63; S.r[0][1] = 1; S.r[0][2] = 35; S.r[0][3] = 16; }
        }
        EpiWin E{p.ZS, p.G};
        pg8::gemm_phase(wid0, lds, 2048, 2048, 2048, S, E);
    } else if constexpr (PH == PH_PREPA) ph_prepA(wid0, p, l);
    else if constexpr (PH == PH_GEMM_LORA) {
        pg8::Sched2D S{(const char*)p.LA, (const char*)p.WLORA_T, 256L * 256 * 2, 256L * 256 * 2, 0, TT / 256, 2560 / 256, G, c, 0};
        EpiLora E{p.in[20] + l * 1024, p.in[22] + l * 1024, p.in[26] + l * 512, p.RK, p.R1, p.R2, p.GRW, p.RBP};
        pg8::gemm_phase(wid0, lds, 256, 256, 256, S, E);
    } else if constexpr (PH == PH_GEMM_FCHAN) {
        pg8::Sched2D S{(const char*)p.WFC, (const char*)(p.ZS + 4128), 256L * 512 * 2, 256L * ZW * 2, 0, 1024 / 256, (l == DEPTH - 1) ? T / 256 : TT / 256, G, (c + 40) % G, 0};
        EpiFourChan E{p.XCS, p.XCSC};
        pg8::gemm_phase(wid0, lds, 512, 512, ZW, S, E);
    } else if constexpr (PH == PH_GEMM_UQ) {
        pg8::Sched2D S{(const char*)p.CQN, (const char*)p.WUQ_T, 256L * 512 * 2, 256L * 512 * 2, 0, (l == DEPTH - 1) ? T / 256 : TT / 256, 768 / 256, G, c, 0};
        EpiBf16 E{p.Q0, 768};
        pg8::gemm_phase(wid0, lds, 512, 512, 512, S, E);
    } else if constexpr (PH == PH_GEMM_UKV) {
        pg8::Sched2D S{(const char*)p.CKVN, (const char*)p.WUKV_T, 256L * 256 * 2, 256L * 256 * 2, 0, TT / 256, 1024 / 256, G, (c + 48) % G, 0};
        EpiBf16 E{p.KV0, 1024};
        pg8::gemm_phase(wid0, lds, 256, 256, 256, S, E);
    } else if constexpr (PH == PH_PREPB) ph_prepB(wid0, p, l);
    else if constexpr (PH == PH_MLA) ph_mla_flash(wid0, p, l, lds);
    else if constexpr (PH == PH_NA) ph_na_flash(wid0, p, l, lds);
    else if constexpr (PH == PH_SCAN_A) ph_scan_a(wid0, p, lds);
    else if constexpr (PH == PH_SCAN_B) ph_scan_b(wid0, p);
    else if constexpr (PH == PH_SCAN_C) ph_scan_c(wid0, p, lds);
    else if constexpr (PH == PH_RWKV_OUT) ph_rwkv_out(wid0, p, l);
    else if constexpr (PH == PH_GEMM_FSEQ) {
        pg8::Sched2D S{(const char*)p.ADFT, (const char*)p.XCS, 256L * 4096 * 2, 256L * 4096 * 2, 0, 2048 / 256, 4096 / 256, G, c, 0};
        EpiFourSeq E{p.Y, 0, 2048, 1.0f / 512.0f};
        pg8::gemm_phase(wid0, lds, 4096, 4096, 4096, S, E);
    } else if constexpr (PH == PH_GEMM_FSEQC) {
        pg8::Sched2D S{(const char*)p.ADFTC, (const char*)p.XCSC, 256L * 512 * 2, 256L * 512 * 2, 0, 1, 4096 / 256, G, (c + 40) % G, 0};
        EpiFourSeq E{p.Y, T, 256, 0.005524271728019903f};
        pg8::gemm_phase(wid0, lds, 512, 512, 512, S, E);
    } else if constexpr (PH == PH_GEMM_MERGE) {
        pg8::gemm_merge(wid0, lds, p.Y, p.WBR_T, p.G, p.ACCB, (l == DEPTH - 1) ? T / 256 : TT / 256, G, c);
    } else if constexpr (PH == PH_GEMM_WOUT) {
        pg8::Sched2D S{(const char*)p.ACCB, (const char*)p.WOUT_T, 256L * 2048 * 2, 256L * 2048 * 2, 0, (l == DEPTH - 1) ? T / 256 : TT / 256, 2048 / 256, G, c, 0};
        EpiWout E{p.XCUR, p.MOD + (size_t)l * 9 * 12288, (l == 0) ? p.in[0] : p.XCUR, (l == 0) ? p.in[2] - (size_t)T * 2048 : p.XCUR};
        pg8::gemm_phase(wid0, lds, 2048, 2048, 2048, S, E);
    } else if constexpr (PH == PH_CVT_MOE) ph_cvt_moe(wid0, p, l, lds, (l == 0 && gridDim.x == 256) ? 4 : 7, (int)blockIdx.x, (int)gridDim.x);
    else if constexpr (PH == PH_ROUTER) ph_moe_router(wid0, p, l, lds);
    else if constexpr (PH == PH_TOPK) ph_topk(wid0, p, l, lds);
    else if constexpr (PH == PH_GATHER) ph_gather(wid0, p, l);
    else if constexpr (PH == PH_GEMM_MOE1) {
        pg8::Sched2D S{(const char*)p.H2, (const char*)p.W13T, 0L, 256L * 2048 * 2, 2048L * 2048 * 2, (l == 0) ? 144 : 128, 2048 / 256, G, c, 1};
        EpiSwiglu E{p.HH};
        pg8::gemm_phase<EpiSwiglu, pg8::Sched2D, true>(wid0, lds, 2048, 2048, 2048, S, E, p.IDXROW);
    } else if constexpr (PH == PH_GEMM_MOE2) {
        pg8::Sched2D S{(const char*)p.HH, (const char*)p.W2T, 256L * 1024 * 2, 256L * 1024 * 2, 2048L * 1024 * 2, (l == 0) ? 144 : 128, 2048 / 256, G, c, 1};
        EpiMoeOut E{p.YE, p.GATEV};
        pg8::gemm_phase(wid0, lds, 1024, 1024, 1024, S, E);
    } else if constexpr (PH == PH_COMBINE) ph_combine(wid0, p, l);
}

template <int PH> __global__ void __launch_bounds__(512, 2) k_phase(Params p, int l) {
    extern __shared__ __attribute__((aligned(16))) unsigned char shm[];
    run_phase<PH>(__builtin_amdgcn_readfirstlane((int)threadIdx.x >> 6), p, l, (LAS unsigned char*)shm);
}


constexpr int LDS_BYTES = 147456;
#define PHASE(PH, L) do { run_phase<PH>(wid0, p, (L), lds); __syncthreads(); } while (0)
#define GBAR() xcd_barrier(xb)
template <int l> __device__ __forceinline__ void layer_body(const int wid0, const Params& p, LAS unsigned char* lds, const XcdBarrier& xb) {
    constexpr int DUP = (l == 0) ? PROBE_DUP : 0;
    if constexpr (DUP == 2) PHASE(PH_CVT_MIX, l);
    if constexpr (l == 0) {
        PHASE(PH_MODULATE, l);
        if constexpr (DUP == 3 || DUP == 11) PHASE(PH_MODULATE, l);
        GBAR();
    }
    PHASE(PH_GEMM_WIN, l);
    if constexpr (DUP == 1) PHASE(PH_GEMM_WIN, l);
    GBAR();
    PHASE(PH_PREPA, l);
    if constexpr (DUP == 3 || DUP == 11) PHASE(PH_PREPA, l);
    GBAR();
    PHASE(PH_GEMM_LORA, l); PHASE(PH_GEMM_FCHAN, l); PHASE(PH_GEMM_UQ, l); PHASE(PH_GEMM_UKV, l);
    if constexpr (DUP == 6 || DUP == 61) { PHASE(PH_GEMM_LORA, l); }
    if constexpr (DUP == 6 || DUP == 62) { PHASE(PH_GEMM_FCHAN, l); }
    if constexpr (DUP == 6 || DUP == 63) { PHASE(PH_GEMM_UQ, l); PHASE(PH_GEMM_UKV, l); }
    GBAR();
    PHASE(PH_PREPB, l);
    if constexpr (DUP == 3 || DUP == 12) PHASE(PH_PREPB, l);
    GBAR();
    PHASE(PH_SCAN_A, l);
    if constexpr (DUP == 5 || DUP == 16) PHASE(PH_SCAN_A, l);
    GBAR();
    PHASE(PH_SCAN_B, l); PHASE(PH_MLA, l); PHASE(PH_NA, l);
    if constexpr (DUP == 5) PHASE(PH_SCAN_B, l);
    if constexpr (DUP == 4) PHASE(PH_MLA, l);
    if constexpr (DUP == 4 || DUP == 41) PHASE(PH_NA, l);
    GBAR();
    PHASE(PH_SCAN_C, l);
    if (gridDim.x == 256) {
        if (blockIdx.x < 128) run_phase<PH_GEMM_FSEQ>(wid0, p, l, lds, 0, 128); else run_phase<PH_GEMM_WIN_DEFER>(wid0, p, l, lds, 128, 128);
        __syncthreads();
    } else { PHASE(PH_GEMM_FSEQ, l); PHASE(PH_GEMM_WIN_DEFER, l); }
    if constexpr (l == 0) PHASE(PH_GEMM_FSEQC, l);
    if constexpr (DUP == 5 || DUP == 18) PHASE(PH_SCAN_C, l);
    if constexpr (DUP == 6 || DUP == 64) { PHASE(PH_GEMM_FSEQ, l); PHASE(PH_GEMM_FSEQC, l); }
    GBAR();
    PHASE(PH_RWKV_OUT, l);
    if constexpr (DUP == 3 || DUP == 13) PHASE(PH_RWKV_OUT, l);
    GBAR();
    constexpr bool FILL = (l == 0);
    PHASE(PH_GEMM_MERGE, l);
    if constexpr (FILL) { if (gridDim.x == 256 && blockIdx.x >= 64) { ph_cvt_moe(wid0, p, l, lds, 1, (int)blockIdx.x - 64, 192); __syncthreads(); } }
    if constexpr (DUP == 7) PHASE(PH_GEMM_MERGE, l);
    GBAR();
    PHASE(PH_GEMM_WOUT, l);
    if constexpr (FILL) { if (gridDim.x == 256 && blockIdx.x >= 64) { ph_cvt_moe(wid0, p, l, lds, 2, (int)blockIdx.x - 64, 192); __syncthreads(); } }
    GBAR();
    PHASE(PH_CVT_MOE, l); PHASE(PH_ROUTER, l);
    if constexpr (DUP == 2) PHASE(PH_CVT_MOE, l);
    if constexpr (DUP == 3 || DUP == 14) PHASE(PH_ROUTER, l);
    GBAR();
    PHASE(PH_TOPK, l);
    if constexpr (DUP == 3 || DUP == 14) PHASE(PH_TOPK, l);
    GBAR();
    PHASE(PH_GEMM_MOE1, l);
    if constexpr (FILL && l + 1 < DEPTH) { if (gridDim.x == 256 && blockIdx.x >= 128) { ph_cvt_mixer(wid0, p, l + 1, lds, 1, (int)blockIdx.x - 128, 128); __syncthreads(); } }
    if constexpr (DUP == 8) PHASE(PH_GEMM_MOE1, l);
    GBAR();
    PHASE(PH_GEMM_MOE2, l);
    if constexpr (FILL && l + 1 < DEPTH) { if (gridDim.x == 256 && blockIdx.x >= 128) { ph_cvt_mixer(wid0, p, l + 1, lds, 2, (int)blockIdx.x - 128, 128); __syncthreads(); } }
    if constexpr (DUP == 8) PHASE(PH_GEMM_MOE2, l);
    GBAR();
    PHASE(PH_COMBINE, l);
    if constexpr (l + 1 < DEPTH) { if (!(FILL && gridDim.x == 256)) PHASE(PH_CVT_MIX, l + 1); }
    GBAR();
}
__global__ void __launch_bounds__(512, 2) k_mega(Params p) {
    extern __shared__ __attribute__((aligned(16))) unsigned char shm[];
    LAS unsigned char* lds = (LAS unsigned char*)shm;
    const int wid0 = __builtin_amdgcn_readfirstlane((int)threadIdx.x >> 6);
    volatile LAS unsigned* xw = (volatile LAS unsigned*)(lds + LDS_BYTES - 16);
    if (xb_leader(wid0)) { xw[0] = 0u; xw[1] = 0u; xw[2] = 0u; xw[3] = 0u; }
    __syncthreads();
    XcdBarrier xb = xcd_barrier_post(p.bar, xw, wid0);
    PHASE(PH_ADALN_P, 0); PHASE(PH_CONST, 0);
    if (gridDim.x == 256) {
        if (blockIdx.x < 192) { ph_cvt_mixer(wid0, p, 0, lds, 3, (int)blockIdx.x, 320); }
        else { ph_cvt_mixer(wid0, p, 0, lds, 3, 192 + 2 * ((int)blockIdx.x - 192), 320); __syncthreads(); ph_cvt_mixer(wid0, p, 0, lds, 3, 193 + 2 * ((int)blockIdx.x - 192), 320); }
        __syncthreads();
    } else { PHASE(PH_CVT_MIX, 0); }
    GBAR();
    PHASE(PH_ADALN_R, 0);
    GBAR();
    layer_body<0>(wid0, p, lds, xb);
    layer_body<1>(wid0, p, lds, xb);
}

static inline size_t al256(size_t x) { return (x + 255) & ~(size_t)255; }

template <int PH> static void launch(const Params& p, int l, hipStream_t st) {
    static bool attr = false;
    if (!attr) { (void)hipFuncSetAttribute((const void*)k_phase<PH>, hipFuncAttributeMaxDynamicSharedMemorySize, LDS_BYTES); attr = true; }
    hipLaunchKernelGGL((k_phase<PH>), dim3(256), dim3(512), LDS_BYTES, st, p, l);
}

extern "C" void kernel_launch(void* const* d_in, const int* in_sizes, int n_in, void* d_out, int out_size, void* d_ws, size_t ws_size, hipStream_t stream) {
    Params p;
    memset(&p, 0, sizeof(p));
    for (int i = 0; i < 36; ++i) p.in[i] = (const float*)d_in[i];
    p.out = (float*)d_out;
    char* ws = (char*)d_ws; size_t off = 0;
    auto take = [&](size_t bytes) { char* r = ws + off; off = al256(off + bytes); return r; };
    p.bar = (unsigned*)take(16384);
    p.MOD = (float*)take((size_t)2 * 9 * 12288 * 4);
    p.MODP = (float*)take((size_t)16 * 2 * 9 * 12288 * 4);
    p.XCUR = (float*)take((size_t)TT * 2048 * 4);
    p.WIN_T = (bf16_t*)take((size_t)ZN * 2048 * 2);
    p.WBR_T = (bf16_t*)take((size_t)4 * 2048 * 512 * 2);
    p.WOUT_T = (bf16_t*)take((size_t)2048 * 2048 * 2);
    p.WUQ_T = (bf16_t*)take((size_t)768 * 512 * 2);
    p.WUKV_T = (bf16_t*)take((size_t)1024 * 256 * 2);
    p.WLORA_T = (bf16_t*)take((size_t)2560 * 256 * 2);
    p.WFC = (bf16_t*)take((size_t)1024 * 512 * 2);
    p.ADFT = (bf16_t*)take((size_t)2048 * 4096 * 2);
    p.ADFTC = (bf16_t*)take((size_t)256 * 512 * 2);
    p.H = (bf16_t*)take((size_t)TT * 2048 * 2);
    p.RBP = (int*)take((size_t)TT * 16);
    const size_t base = off;
    p.Y = (bf16_t*)take((size_t)TT * 2048 * 2);
    p.ZS = (bf16_t*)take((size_t)TT * ZW * 2); p.ACC = (float*)p.ZS;
    p.G = (bf16_t*)take((size_t)TT * GW * 2);
    p.NQ = (bf16_t*)take((size_t)TT * 512 * 2);
    p.NK = (bf16_t*)take((size_t)TT * 512 * 2);
    const size_t scan_base = off;
    p.R1 = (char*)take((size_t)8 * 8 * 2304 * R1B);
    p.R2 = (char*)take((size_t)8 * 8 * 2 * 2304 * R2B);
    p.GRW = (bf16_t*)take((size_t)TT * 512 * 2);
    const size_t scan_end = off;
    p.CQN = (bf16_t*)take((size_t)TT * 512 * 2);
    p.CKVN = (bf16_t*)take((size_t)TT * 256 * 2);
    p.LA = (bf16_t*)take((size_t)TT * 256 * 2);
    p.RK = (bf16_t*)take((size_t)TT * 512 * 2);
    p.Q0 = (bf16_t*)take((size_t)TT * 768 * 2);
    p.KV0 = (bf16_t*)take((size_t)TT * 1024 * 2);
    p.MQ = (bf16_t*)take((size_t)TT * 768 * 2);
    p.MK = (bf16_t*)take((size_t)TT * 768 * 2);
    p.MVT = p.CQN; p.NVT = p.RK; p.ZB = p.KV0;
    p.YS = (float*)p.ZS; p.PMAT = p.YS + (size_t)2 * TT * 512; p.QMAT = p.PMAT + (size_t)128 * 16 * 4096; p.SMAT = p.QMAT + (size_t)128 * 16 * 4096;
    if ((size_t)((char*)(p.SMAT + (size_t)128 * 16 * 4096) - (char*)p.ZS) > (size_t)TT * ZW * 2) fprintf(stderr, "kernel_launch: scan scratch overflows the ZS region\n");
    p.XCS = (bf16_t*)take((size_t)4096 * 2 * 2048 * 2);
    p.XCSC = (bf16_t*)take((size_t)4096 * 2 * 256 * 2);
    const size_t mix_end = off;
    p.ACCB = (bf16_t*)(ws + scan_base);
    size_t moff = scan_base + al256((size_t)TT * 2048 * 2);
    p.W13T = (bf16_t*)(ws + moff); moff = al256(moff + (size_t)16 * 2048 * 2048 * 2);
    p.W2T = (bf16_t*)(ws + moff); moff = al256(moff + (size_t)16 * 2048 * 1024 * 2);
    (void)scan_end;
    if (moff > mix_end) { fprintf(stderr, "kernel_launch: moe weights overflow the mixer region (%zu > %zu)\n", moff, mix_end); }
    size_t aoff = base;
    auto atake = [&](size_t bytes) { char* r = ws + aoff; aoff = al256(aoff + bytes); return r; };
    p.H2 = (bf16_t*)atake((size_t)TT * 2048 * 2);
    p.XE = (bf16_t*)atake((size_t)XE_ROWS * 2048 * 2);
    p.HH = (bf16_t*)atake((size_t)XE_ROWS * 1024 * 2);
    p.YE = (bf16_t*)atake((size_t)XE_ROWS * 2048 * 2);
    p.AFFT = (float*)atake((size_t)128 * 2048 * 4);
    p.AFFC = (float*)atake((size_t)128 * 256 * 4);
    p.IDXROW = (int*)atake((size_t)XE_ROWS * 4);
    p.GATEV = (float*)atake((size_t)XE_ROWS * 4);
    p.SEL = (int*)atake((size_t)TT * 16 * 4);
    if (aoff > scan_base) fprintf(stderr, "kernel_launch: moe activations overflow (%zu > %zu)\n", aoff, scan_base);
    if (mix_end > ws_size) { fprintf(stderr, "kernel_launch: workspace too small: need %zu have %zu\n", mix_end, ws_size); return; }

#ifdef MK_MULTI
    launch<PH_ADALN_P>(p, 0, stream); launch<PH_CONST>(p, 0, stream); launch<PH_ADALN_R>(p, 0, stream);
    for (int l = 0; l < DEPTH; ++l) {
        launch<PH_CVT_MIX>(p, l, stream); launch<PH_MODULATE>(p, l, stream); launch<PH_GEMM_WIN>(p, l, stream); launch<PH_PREPA>(p, l, stream);
        launch<PH_GEMM_LORA>(p, l, stream); launch<PH_GEMM_FCHAN>(p, l, stream); launch<PH_GEMM_UQ>(p, l, stream); launch<PH_GEMM_UKV>(p, l, stream);
        launch<PH_PREPB>(p, l, stream); launch<PH_MLA>(p, l, stream); launch<PH_NA>(p, l, stream); launch<PH_SCAN>(p, l, stream); launch<PH_RWKV_OUT>(p, l, stream);
        launch<PH_GEMM_FSEQ>(p, l, stream); if (l == 0) launch<PH_GEMM_FSEQC>(p, l, stream);
        launch<PH_GEMM_MERGE>(p, l, stream); launch<PH_GEMM_WOUT>(p, l, stream); launch<PH_CVT_MOE>(p, l, stream); launch<PH_ROUTER>(p, l, stream);
        launch<PH_TOPK>(p, l, stream); launch<PH_GATHER>(p, l, stream); launch<PH_GEMM_MOE1>(p, l, stream); launch<PH_GEMM_MOE2>(p, l, stream); launch<PH_COMBINE>(p, l, stream);
    }
#else
    static int grid = 0;
    if (!grid) {
        int dev = 0, cus = 0, per_cu = 0;
        (void)hipGetDevice(&dev);
        (void)hipDeviceGetAttribute(&cus, hipDeviceAttributeMultiprocessorCount, dev);
        (void)hipFuncSetAttribute((const void*)k_mega, hipFuncAttributeMaxDynamicSharedMemorySize, LDS_BYTES);
        (void)hipOccupancyMaxActiveBlocksPerMultiprocessor(&per_cu, (const void*)k_mega, 512, LDS_BYTES);
        if (per_cu < 1) fprintf(stderr, "kernel_launch: occupancy query says %d blocks per CU\n", per_cu);
        grid = cus > 0 ? cus : 256;
    }
    (void)hipMemsetAsync(p.bar, 0, 16384, stream);
    hipLaunchKernelGGL(k_mega, dim3(grid), dim3(512), LDS_BYTES, stream, p);
#endif
}
#ifdef MK_DIAG
template __global__ void k_phase<PH_SCAN_A>(Params, int);
template __global__ void k_phase<PH_SCAN_B>(Params, int);
template __global__ void k_phase<PH_SCAN_C>(Params, int);
template __global__ void k_phase<PH_MLA>(Params, int);
template __global__ void k_phase<PH_NA>(Params, int);
#endif
#ifdef MK_DIAG
template __global__ void k_phase<PH_GEMM_LORA>(Params, int);
template __global__ void k_phase<PH_GEMM_WIN>(Params, int);
template __global__ void k_phase<PH_GEMM_MERGE>(Params, int);
#endif
#ifdef MK_DIAG
template __global__ void k_phase<PH_GEMM_WOUT>(Params, int);
template __global__ void k_phase<PH_GEMM_MOE2>(Params, int);
#endif
```

```cpp
#include <hip/hip_runtime.h>
#include <stdint.h>
#include <stdio.h>
#include <string.h>

#define LAS __attribute__((address_space(3)))
#define PROBE_DUP 0
typedef unsigned short bf16_t;
typedef short bf16x8 __attribute__((ext_vector_type(8)));
typedef float f32x4 __attribute__((ext_vector_type(4)));
typedef float f32x2 __attribute__((ext_vector_type(2)));
typedef unsigned u32x4 __attribute__((ext_vector_type(4)));
typedef unsigned u32x2 __attribute__((ext_vector_type(2)));

constexpr int NB = 8, SEQ = 2048, DM = 2048, CTXL = 256, DEPTH = 2;
constexpr int T = NB * SEQ, TC = NB * CTXL, TT = T + TC;
constexpr int ZW = 4864;
constexpr int GW = 8192;
constexpr int ZN = ZW + GW;
constexpr int NEXP = 16, EFF = 1024;
constexpr int XE_ROWS = 128 * 256 + 16 * 256;
constexpr float NORM_EPS = 1e-6f;
constexpr int R1B = 640, R2B = 512;

struct Params {
    const float* in[36];
    float* out;
    unsigned* bar;
    float* MOD;
    float* MODP;
    float* XCUR;
    bf16_t* WIN_T;
    bf16_t* WBR_T;
    bf16_t* WOUT_T;
    bf16_t* WUQ_T;
    bf16_t* WUKV_T;
    bf16_t* WLORA_T;
    bf16_t* WFC;
    bf16_t* ADFT;
    bf16_t* ADFTC;
    bf16_t* H;
    bf16_t* Y;
    bf16_t* ZS;
    bf16_t* G;
    bf16_t* NQ;
    bf16_t* NK;
    bf16_t* CQN;
    bf16_t* CKVN;
    bf16_t* LA;
    bf16_t* RK;
    int*    RBP;
    char*   R1;
    char*   R2;
    bf16_t* GRW;
    float*  YS;
    float*  PMAT;
    float*  QMAT;
    float*  SMAT;
    bf16_t* Q0;
    bf16_t* KV0;
    bf16_t* ZB;
    bf16_t* MQ;
    bf16_t* MK;
    bf16_t* MVT;
    bf16_t* NVT;
    bf16_t* XCS;
    bf16_t* XCSC;
    float*  ACC;
    bf16_t* ACCB;
    bf16_t* W13T;
    bf16_t* W2T;
    bf16_t* H2;
    float*  AFFT;
    float*  AFFC;
    int*    IDXROW;
    float*  GATEV;
    int*    SEL;
    bf16_t* XE;
    bf16_t* HH;
    bf16_t* YE;
};

__device__ __forceinline__ float bf2f(bf16_t h) { return __uint_as_float(((unsigned)h) << 16); }
typedef float f32x2_t __attribute__((ext_vector_type(2)));
typedef __bf16 bf16x2_t __attribute__((ext_vector_type(2)));
__device__ __forceinline__ unsigned pk2(float lo, float hi) { const f32x2_t v = {lo, hi}; return __builtin_bit_cast(unsigned, __builtin_convertvector(v, bf16x2_t)); }
__device__ __forceinline__ bf16_t f2bf(float f) { return (bf16_t)(pk2(f, f) & 0xffffu); }
__device__ __forceinline__ void unpack8(u32x4 w, float* v) {
    v[0] = __uint_as_float(w.x << 16); v[1] = __uint_as_float(w.x & 0xffff0000u);
    v[2] = __uint_as_float(w.y << 16); v[3] = __uint_as_float(w.y & 0xffff0000u);
    v[4] = __uint_as_float(w.z << 16); v[5] = __uint_as_float(w.z & 0xffff0000u);
    v[6] = __uint_as_float(w.w << 16); v[7] = __uint_as_float(w.w & 0xffff0000u);
}
__device__ __forceinline__ u32x4 pack8(const float* v) { u32x4 w; w.x = pk2(v[0], v[1]); w.y = pk2(v[2], v[3]); w.z = pk2(v[4], v[5]); w.w = pk2(v[6], v[7]); return w; }
__device__ __forceinline__ void load8(const bf16_t* p, float* v) { unpack8(*(const u32x4*)p, v); }
__device__ __forceinline__ void store8(bf16_t* p, const float* v) { *(u32x4*)p = pack8(v); }
__device__ __forceinline__ float wave_sum(float v) {
#pragma unroll
    for (int o = 32; o; o >>= 1) v += __shfl_xor(v, o);
    return v;
}
__device__ __forceinline__ float wave_max(float v) {
#pragma unroll
    for (int o = 32; o; o >>= 1) v = fmaxf(v, __shfl_xor(v, o));
    return v;
}
__device__ __forceinline__ float sum8(float v) { v += __shfl_xor(v, 1); v += __shfl_xor(v, 2); v += __shfl_xor(v, 4); return v; }
__device__ __forceinline__ float sigmoidf_(float x) { return __builtin_amdgcn_rcpf(1.0f + __expf(-x)); }
__device__ __forceinline__ int opaque_lane() { unsigned m = ~0u; asm volatile("" : "+s"(m)); return (int)__builtin_amdgcn_mbcnt_hi(m, __builtin_amdgcn_mbcnt_lo(m, 0u)); }
__device__ __forceinline__ int row_s(int r) { return r < T ? (r >> 11) : 8; }
__device__ __forceinline__ void row_bpos(int r, int& b, int& pf) { if (r < T) { b = r >> 11; pf = 256 + (r & 2047); } else { b = (r - T) >> 8; pf = (r - T) & 255; } }
__device__ __forceinline__ int pos_rev(int pf) { return pf < 256 ? 255 - pf : 2559 - pf; }

__device__ __forceinline__ u32x4 pack8v(f32x4 a, f32x4 b) { u32x4 w; w.x = pk2(a[0], a[1]); w.y = pk2(a[2], a[3]); w.z = pk2(b[0], b[1]); w.w = pk2(b[2], b[3]); return w; }

namespace pg8 {
constexpr int BM = 256, BK = 64, HALF = 128, HTB = HALF * BK * 2, STAGE_BYTES = 8 * HTB, NXCD = 8, WGM = 8;
__host__ __device__ __forceinline__ int lds_byte(int r, int c) { const int st = (r >> 4) * 2 + (c >> 5), rr = r & 15, cc = c & 31, ob = rr * 64 + cc * 2; return st * 1024 + (ob ^ (((ob >> 9) & 1) << 5)); }
__host__ __device__ __forceinline__ void stage_rc(int b, int& R, int& C) { const int st = b / 1024, sb = b % 1024, swz = sb ^ (((sb >> 9) & 1) << 5); R = (st >> 1) * 16 + swz / 64; C = (st & 1) * 32 + (swz % 64) / 2; }
__host__ __device__ __forceinline__ int perm32(int rho) { const int n = rho >> 4, i = rho & 15; return 8 * (i >> 2) + 4 * n + (i & 3); }

struct Unit { int pm, pn, aux, pad; const char* a; const char* b; };

__device__ __forceinline__ bool tile_of(long L, int nM, int nN, int& pm, int& pn) {
    const int nwg = nM * nN; if (L >= nwg || L < 0) return false;
    int wgid = (int)L; { const int q = nwg / NXCD, r = nwg % NXCD, xcd = wgid % NXCD, off = wgid / NXCD; wgid = (xcd < r ? xcd * (q + 1) : r * (q + 1) + (xcd - r) * q) + off; }
    const int nig = WGM * nN, gid = wgid / nig, fm = gid * WGM, gsz = (nM - fm) < WGM ? (nM - fm) : WGM;
    pm = fm + ((wgid % nig) % gsz); pn = (wgid % nig) / gsz; return true;
}

struct Sched2D {
    const char* A; const char* B; long a_tile, b_tile, b_grp; int nM, nN, G, c, moe;
    int nMb = 0, nNb = 0, pm0b = 0;
    __device__ __forceinline__ bool next(int i, Unit& u) const {
        int pm, pn; const long L = (long)i * G + c; const int n1 = nM * nN;
        if (L < n1) { if (!tile_of(L, nM, nN, pm, pn)) return false; }
        else { if (!tile_of(L - n1, nMb, nNb, pm, pn)) return false; pm += pm0b; }
        u.pm = pm; u.pn = pn; u.aux = 0; u.pad = 0;
        u.a = A + (long)pm * a_tile;
        const int e = moe ? (pm < 128 ? (pm >> 3) : (pm - 128)) : 0;
        u.b = B + (long)pn * b_tile + (long)e * b_grp;
        return true;
    }
};
struct SchedMerge {
    const char* A; const char* B; int nM, nN, G, c;
    __device__ __forceinline__ bool next(int i, Unit& u) const {
        int pm, pn; if (!tile_of((long)(i >> 2) * G + c, nM, nN, pm, pn)) return false;
        const int br = i & 3;
        u.pm = pm; u.pn = pn; u.aux = br; u.pad = 0;
        u.a = A + ((long)pm * 256 * 2048 + br * 512) * 2;
        u.b = B + ((long)br * 2048 * 512 + (long)pn * 256 * 512) * 2;
        return true;
    }
};

template <class Epi, class Sched, bool GATHER = false>
__device__ __forceinline__ void gemm_phase(const int wid0, LAS unsigned char* lds, const int K, const int lda, const int ldb, const Sched& S, const Epi& E, const int* gidx = nullptr) {
    int tid = (wid0 << 6) | opaque_lane(); asm volatile("" : "+v"(tid));
    const int wid = __builtin_amdgcn_readfirstlane(tid >> 6), lane = tid & 63, wr = wid >> 2, wc = wid & 3, fr = lane & 15, fq = lane >> 4;
    const int nt = K / BK;
    unsigned voffA[2], voffB[2]; int gR[2], gC[2];
#pragma unroll
    for (int i = 0; i < 2; ++i) { int R, C; stage_rc(tid * 16 + i * 8192, R, C); const int Rb = Epi::PERM ? ((R & ~31) + perm32(R & 31)) : R;
        voffA[i] = (unsigned)(R * lda + C) * 2u; voffB[i] = (unsigned)(Rb * ldb + C) * 2u; gR[i] = R; gC[i] = C; }
    unsigned vA0c[2] = {0u, 0u}, vA1c[2] = {0u, 0u}, vA0n[2] = {0u, 0u}, vA1n[2] = {0u, 0u};
#define PG8_GIDX(dst0, dst1, pm_) do { _Pragma("unroll") for (int _i = 0; _i < 2; ++_i) { dst0[_i] = (unsigned)(gidx[(pm_) * 256 + gR[_i]] * lda + gC[_i]) * 2u; dst1[_i] = (unsigned)(gidx[(pm_) * 256 + 128 + gR[_i]] * lda + gC[_i]) * 2u; } } while (0)
    const size_t kstep = (size_t)(BK * 2);
    const size_t hstepA = (size_t)HALF * lda * 2, hstepB = (size_t)HALF * ldb * 2;
    const unsigned ldsw = (unsigned)wid * 1024u;
    const int aoff = lds_byte(wr * 64 + fr, fq * 8), boff = lds_byte(wc * 32 + fr, fq * 8);
#define PG8_SA(b, h) (((b) * 2 + (h)) * HTB)
#define PG8_SB(b, h) ((4 + (b) * 2 + (h)) * HTB)
#define PG8_STAGE(bufoff, gbase, voff) do { _Pragma("unroll") for (int _i = 0; _i < 2; ++_i) \
        __builtin_amdgcn_global_load_lds((const unsigned*)((const char*)(gbase) + (voff)[_i]), (LAS unsigned*)(lds + (bufoff) + ldsw + _i * 8192), 16, 0, 0); } while (0)
#define PG8_LDA(dst, b, h) do { _Pragma("unroll") for (int m = 0; m < 4; ++m) _Pragma("unroll") for (int k = 0; k < 2; ++k) dst[m][k] = *(const LAS bf16x8*)(lds + PG8_SA(b, h) + aoff + m * 2048 + k * 1024); } while (0)
#define PG8_LDB(dst, b, h) do { _Pragma("unroll") for (int n = 0; n < 2; ++n) _Pragma("unroll") for (int k = 0; k < 2; ++k) dst[n][k] = *(const LAS bf16x8*)(lds + PG8_SB(b, h) + boff + n * 2048 + k * 1024); } while (0)
#define PG8_MMA(ai, bj, At, Bt) do { __builtin_amdgcn_s_setprio(1); _Pragma("unroll") for (int m = 0; m < 4; ++m) _Pragma("unroll") for (int n = 0; n < 2; ++n) _Pragma("unroll") for (int k = 0; k < 2; ++k) \
        acc[ai][bj][m][n] = __builtin_amdgcn_mfma_f32_16x16x32_bf16(Bt[n][k], At[m][k], acc[ai][bj][m][n], 0, 0, 0); __builtin_amdgcn_s_setprio(0); } while (0)
#define PG8_WAIT_V(n) asm volatile("s_waitcnt vmcnt(" #n ")" ::: "memory")
#define PG8_WAIT_L(n) asm volatile("s_waitcnt lgkmcnt(" #n ")" ::: "memory")
#define PG8_BAR __builtin_amdgcn_s_barrier()
#define PG8_SCHED __builtin_amdgcn_sched_barrier(0)
    Unit cur, nxt; int ui = 0;
    if (!S.next(0, cur)) return;
    f32x4 acc[2][2][4][2];
#pragma unroll
    for (int a = 0; a < 2; ++a)
#pragma unroll
        for (int b = 0; b < 2; ++b)
#pragma unroll
            for (int m = 0; m < 4; ++m)
#pragma unroll
                for (int n = 0; n < 2; ++n) acc[a][b][m][n] = (f32x4){0.f, 0.f, 0.f, 0.f};
    bf16x8 At[4][2], B0[2][2], B1[2][2];
    const char* cA = cur.a; const char* cB = cur.b;
    if constexpr (GATHER) { PG8_GIDX(vA0c, vA1c, cur.pm); }
    const size_t hA = GATHER ? (size_t)0 : hstepA;
#define PG8_STAGEA(bufoff, gbase, h_, nx_) do { _Pragma("unroll") for (int _i = 0; _i < 2; ++_i) { \
        const unsigned _o = !GATHER ? voffA[_i] : ((h_) ? ((nx_) ? vA1n[_i] : vA1c[_i]) : ((nx_) ? vA0n[_i] : vA0c[_i])); \
        __builtin_amdgcn_global_load_lds((const unsigned*)((const char*)(gbase) + _o), (LAS unsigned*)(lds + (bufoff) + ldsw + _i * 8192), 16, 0, 0); } } while (0)
    PG8_STAGE(PG8_SB(0, 0), cB, voffB); PG8_STAGEA(PG8_SA(0, 0), cA, 0, false); PG8_STAGE(PG8_SB(0, 1), cB + hstepB, voffB); PG8_STAGEA(PG8_SA(0, 1), cA + hA, 1, false);
    if (wr == 1) PG8_BAR;
    PG8_WAIT_V(4); PG8_BAR;
    PG8_STAGE(PG8_SB(1, 0), cB + kstep, voffB); PG8_STAGEA(PG8_SA(1, 0), cA + kstep, 0, false); PG8_STAGE(PG8_SB(1, 1), cB + hstepB + kstep, voffB);
    PG8_WAIT_V(6); PG8_BAR;
    for (;;) {
        const bool has_next = S.next(ui + 1, nxt);
        const char* nA = has_next ? nxt.a : cA; const char* nB = has_next ? nxt.b : cB;
        if constexpr (GATHER) { if (has_next) { PG8_GIDX(vA0n, vA1n, nxt.pm); } else { vA0n[0] = vA0c[0]; vA0n[1] = vA0c[1]; vA1n[0] = vA1c[0]; vA1n[1] = vA1c[1]; } }
        for (int t = 0; t < nt; t += 2) {
            const bool last = (t == nt - 2);
            const char* a1 = cA + (size_t)(t + 1) * kstep;
            const char* a2 = last ? nA : cA + (size_t)(t + 2) * kstep; const char* b2 = last ? nB : cB + (size_t)(t + 2) * kstep;
            const char* a3 = a2 + kstep; const char* b3 = b2 + kstep;
            PG8_LDB(B0, 0, 0); PG8_SCHED; PG8_LDA(At, 0, 0); PG8_STAGEA(PG8_SA(1, 1), a1 + hA, 1, false);
            PG8_WAIT_L(8); PG8_BAR; PG8_WAIT_L(0); PG8_MMA(0, 0, At, B0); PG8_BAR; PG8_SCHED;
            PG8_LDB(B1, 0, 1); PG8_STAGE(PG8_SB(0, 0), b2, voffB);
            PG8_BAR; PG8_WAIT_L(0); PG8_MMA(0, 1, At, B1); PG8_BAR;
            PG8_LDA(At, 0, 1); PG8_STAGEA(PG8_SA(0, 0), a2, 0, last);
            PG8_BAR; PG8_WAIT_L(0); PG8_MMA(1, 0, At, B0); PG8_BAR; PG8_SCHED;
            PG8_STAGE(PG8_SB(0, 1), b2 + hstepB, voffB);
            PG8_WAIT_V(6); PG8_BAR; PG8_MMA(1, 1, At, B1); PG8_BAR;
            PG8_LDB(B0, 1, 0); PG8_SCHED; PG8_LDA(At, 1, 0); PG8_STAGEA(PG8_SA(0, 1), a2 + hA, 1, last);
            PG8_WAIT_L(8); PG8_BAR; PG8_WAIT_L(0); PG8_MMA(0, 0, At, B0); PG8_BAR; PG8_SCHED;
            PG8_LDB(B1, 1, 1); PG8_STAGE(PG8_SB(1, 0), b3, voffB);
            PG8_BAR; PG8_WAIT_L(0); PG8_MMA(0, 1, At, B1); PG8_BAR;
            PG8_LDA(At, 1, 1); PG8_STAGEA(PG8_SA(1, 0), a3, 0, last);
            PG8_BAR; PG8_WAIT_L(0); PG8_MMA(1, 0, At, B0); PG8_BAR; PG8_SCHED;
            PG8_STAGE(PG8_SB(1, 1), b3 + hstepB, voffB);
            PG8_WAIT_V(6); PG8_BAR; PG8_MMA(1, 1, At, B1); PG8_BAR;
        }
        E(acc, cur, wr, wc, fr, fq);
        if (!has_next) break;
#pragma unroll
        for (int a = 0; a < 2; ++a)
#pragma unroll
            for (int b = 0; b < 2; ++b)
#pragma unroll
                for (int m = 0; m < 4; ++m)
#pragma unroll
                    for (int n = 0; n < 2; ++n) acc[a][b][m][n] = (f32x4){0.f, 0.f, 0.f, 0.f};
        cur = nxt; cA = nA; cB = nB; ++ui;
        if constexpr (GATHER) { vA0c[0] = vA0n[0]; vA0c[1] = vA0n[1]; vA1c[0] = vA1n[0]; vA1c[1] = vA1n[1]; }
    }
    PG8_WAIT_V(0);
    if (wr == 0) PG8_BAR;
    PG8_BAR;
#undef PG8_GIDX
#undef PG8_STAGEA
#undef PG8_SA
#undef PG8_SB
#undef PG8_STAGE
#undef PG8_LDA
#undef PG8_LDB
#undef PG8_MMA
#undef PG8_WAIT_V
#undef PG8_WAIT_L
#undef PG8_BAR
#undef PG8_SCHED
}


struct SchedRects {
    const char* A; const char* B; long a_tile, b_tile; int G, c;
    int r[3][4];
    __device__ __forceinline__ bool next(int i, Unit& u) const {
        long L = (long)i * G + c; int pm = 0, pn = 0; bool ok = false;
#pragma unroll
        for (int k = 0; k < 3; ++k) { const int n = r[k][1] * r[k][3]; if (!ok) { if (L < n) { ok = tile_of(L, r[k][1], r[k][3], pm, pn); pm += r[k][0]; pn += r[k][2]; } else L -= n; } }
        if (!ok) return false;
        u.pm = pm; u.pn = pn; u.aux = 0; u.pad = 0; u.a = A + (long)pm * a_tile; u.b = B + (long)pn * b_tile; return true;
    }
};
__device__ __forceinline__ void gemm_merge(const int wid0, LAS unsigned char* lds, const bf16_t* Y, const bf16_t* WBR, const bf16_t* G, bf16_t* ACCB, int nM, int Gn, int c) {
    int tid = (wid0 << 6) | opaque_lane(); asm volatile("" : "+v"(tid));
    const int wid = __builtin_amdgcn_readfirstlane(tid >> 6), lane = tid & 63, wr = wid >> 2, wc = wid & 3, fr = lane & 15, fq = lane >> 4;
    constexpr int K = 2048, lda = 2048, ldb = 2048, nt = K / BK, nN = 8;
    unsigned voffA[2], voffB[2];
#pragma unroll
    for (int i = 0; i < 2; ++i) { int R, C; stage_rc(tid * 16 + i * 8192, R, C); const int Rb = (R & ~31) + perm32(R & 31);
        voffA[i] = (unsigned)(R * lda + C) * 2u; voffB[i] = (unsigned)(Rb * ldb + C) * 2u; }
    const size_t kstep = (size_t)(BK * 2);
    const size_t hstepA = (size_t)HALF * lda * 2, hstepB = (size_t)HALF * ldb * 2;
    const unsigned ldsw = (unsigned)wid * 1024u;
    const int aoff = lds_byte(wr * 64 + fr, fq * 8), boff = lds_byte(wc * 32 + fr, fq * 8);
#define PG8_SA(b, h) (((b) * 2 + (h)) * HTB)
#define PG8_SB(b, h) ((4 + (b) * 2 + (h)) * HTB)
#define PG8_STAGE(bufoff, gbase, voff) do { _Pragma("unroll") for (int _i = 0; _i < 2; ++_i) \
        __builtin_amdgcn_global_load_lds((const unsigned*)((const char*)(gbase) + (voff)[_i]), (LAS unsigned*)(lds + (bufoff) + ldsw + _i * 8192), 16, 0, 0); } while (0)
#define PG8_LDA(dst, b, h) do { _Pragma("unroll") for (int m = 0; m < 4; ++m) _Pragma("unroll") for (int k = 0; k < 2; ++k) dst[m][k] = *(const LAS bf16x8*)(lds + PG8_SA(b, h) + aoff + m * 2048 + k * 1024); } while (0)
#define PG8_LDB(dst, b, h) do { _Pragma("unroll") for (int n = 0; n < 2; ++n) _Pragma("unroll") for (int k = 0; k < 2; ++k) dst[n][k] = *(const LAS bf16x8*)(lds + PG8_SB(b, h) + boff + n * 2048 + k * 1024); } while (0)
#define PG8_MMA(ai, bj, At, Bt) do { __builtin_amdgcn_s_setprio(1); _Pragma("unroll") for (int m = 0; m < 4; ++m) _Pragma("unroll") for (int n = 0; n < 2; ++n) _Pragma("unroll") for (int k = 0; k < 2; ++k) \
        acc[ai][bj][m][n] = __builtin_amdgcn_mfma_f32_16x16x32_bf16(Bt[n][k], At[m][k], acc[ai][bj][m][n], 0, 0, 0); __builtin_amdgcn_s_setprio(0); } while (0)
#define PG8_WAIT_V(n) asm volatile("s_waitcnt vmcnt(" #n ")" ::: "memory")
#define PG8_WAIT_L(n) asm volatile("s_waitcnt lgkmcnt(" #n ")" ::: "memory")
#define PG8_BAR __builtin_amdgcn_s_barrier()
#define PG8_SCHED __builtin_amdgcn_sched_barrier(0)
    int ui = 0, pm, pn;
    if (!tile_of((long)c, nM, nN, pm, pn)) return;
    f32x4 acc[2][2][4][2];
#pragma unroll
    for (int a = 0; a < 2; ++a)
#pragma unroll
        for (int b = 0; b < 2; ++b)
#pragma unroll
            for (int m = 0; m < 4; ++m)
#pragma unroll
                for (int n = 0; n < 2; ++n) acc[a][b][m][n] = (f32x4){0.f, 0.f, 0.f, 0.f};
    bf16x8 At[4][2], B0[2][2], B1[2][2];
    const char* cA = (const char*)Y + (size_t)pm * 256 * lda * 2; const char* cB = (const char*)WBR + (size_t)pn * 256 * ldb * 2;
    PG8_STAGE(PG8_SB(0, 0), cB, voffB); PG8_STAGE(PG8_SA(0, 0), cA, voffA); PG8_STAGE(PG8_SB(0, 1), cB + hstepB, voffB); PG8_STAGE(PG8_SA(0, 1), cA + hstepA, voffA);
    if (wr == 1) PG8_BAR;
    PG8_WAIT_V(4); PG8_BAR;
    PG8_STAGE(PG8_SB(1, 0), cB + kstep, voffB); PG8_STAGE(PG8_SA(1, 0), cA + kstep, voffA); PG8_STAGE(PG8_SB(1, 1), cB + hstepB + kstep, voffB);
    PG8_WAIT_V(6); PG8_BAR;
    for (;;) {
        int npm, npn; const bool has_next = tile_of((long)(ui + 1) * Gn + c, nM, nN, npm, npn);
        const char* nA = has_next ? (const char*)Y + (size_t)npm * 256 * lda * 2 : cA; const char* nB = has_next ? (const char*)WBR + (size_t)npn * 256 * ldb * 2 : cB;
        const int row0 = pm * 256 + wr * 64 + fr, col0 = pn * 256 + wc * 32 + 8 * fq;
        for (int t = 0; t < nt; t += 2) {
            if (t != 0 && (t & 7) == 0) {
                const int br = (t >> 3) - 1;
#pragma unroll
                for (int ai = 0; ai < 2; ++ai)
#pragma unroll
                    for (int m = 0; m < 4; ++m)
#pragma unroll
                        for (int bj = 0; bj < 2; ++bj) {
                            const bf16_t* gp = G + (size_t)(row0 + ai * 128 + m * 16) * GW + br * 2048 + col0 + bj * 128;
                            float g0[8], g1[8]; load8(gp, g0); load8(gp + 2048, g1);
#pragma unroll
                            for (int k = 0; k < 4; ++k) { acc[ai][bj][m][0][k] *= g0[k] * __builtin_amdgcn_rcpf(fmaxf(g1[k], 1e-30f)); acc[ai][bj][m][1][k] *= g0[4 + k] * __builtin_amdgcn_rcpf(fmaxf(g1[4 + k], 1e-30f)); }
                        }
            }
            const bool last = (t == nt - 2);
            const char* a1 = cA + (size_t)(t + 1) * kstep;
            const char* a2 = last ? nA : cA + (size_t)(t + 2) * kstep; const char* b2 = last ? nB : cB + (size_t)(t + 2) * kstep;
            const char* a3 = a2 + kstep; const char* b3 = b2 + kstep;
            PG8_LDB(B0, 0, 0); PG8_SCHED; PG8_LDA(At, 0, 0); PG8_STAGE(PG8_SA(1, 1), a1 + hstepA, voffA);
            PG8_WAIT_L(8); PG8_BAR; PG8_WAIT_L(0); PG8_MMA(0, 0, At, B0); PG8_BAR; PG8_SCHED;
            PG8_LDB(B1, 0, 1); PG8_STAGE(PG8_SB(0, 0), b2, voffB);
            PG8_BAR; PG8_WAIT_L(0); PG8_MMA(0, 1, At, B1); PG8_BAR;
            PG8_LDA(At, 0, 1); PG8_STAGE(PG8_SA(0, 0), a2, voffA);
            PG8_BAR; PG8_WAIT_L(0); PG8_MMA(1, 0, At, B0); PG8_BAR; PG8_SCHED;
            PG8_STAGE(PG8_SB(0, 1), b2 + hstepB, voffB);
            PG8_WAIT_V(6); PG8_BAR; PG8_MMA(1, 1, At, B1); PG8_BAR;
            PG8_LDB(B0, 1, 0); PG8_SCHED; PG8_LDA(At, 1, 0); PG8_STAGE(PG8_SA(0, 1), a2 + hstepA, voffA);
            PG8_WAIT_L(8); PG8_BAR; PG8_WAIT_L(0); PG8_MMA(0, 0, At, B0); PG8_BAR; PG8_SCHED;
            PG8_LDB(B1, 1, 1); PG8_STAGE(PG8_SB(1, 0), b3, voffB);
            PG8_BAR; PG8_WAIT_L(0); PG8_MMA(0, 1, At, B1); PG8_BAR;
            PG8_LDA(At, 1, 1); PG8_STAGE(PG8_SA(1, 0), a3, voffA);
            PG8_BAR; PG8_WAIT_L(0); PG8_MMA(1, 0, At, B0); PG8_BAR; PG8_SCHED;
            PG8_STAGE(PG8_SB(1, 1), b3 + hstepB, voffB);
            PG8_WAIT_V(6); PG8_BAR; PG8_MMA(1, 1, At, B1); PG8_BAR;
        }
#pragma unroll
        for (int ai = 0; ai < 2; ++ai)
#pragma unroll
            for (int m = 0; m < 4; ++m)
#pragma unroll
                for (int bj = 0; bj < 2; ++bj) {
                    const int row = row0 + ai * 128 + m * 16, col = col0 + bj * 128;
                    float g[8]; load8(G + (size_t)row * GW + 3 * 2048 + col, g);
                    f32x4 o0, o1;
#pragma unroll
                    for (int k = 0; k < 4; ++k) { o0[k] = acc[ai][bj][m][0][k] * g[k]; o1[k] = acc[ai][bj][m][1][k] * g[4 + k]; }
                    *(u32x4*)(ACCB + (size_t)row * 2048 + col) = pack8v(o0, o1);
                    acc[ai][bj][m][0] = (f32x4){0.f, 0.f, 0.f, 0.f}; acc[ai][bj][m][1] = (f32x4){0.f, 0.f, 0.f, 0.f};
                }
        if (!has_next) break;
        pm = npm; pn = npn; cA = nA; cB = nB; ++ui;
    }
    PG8_WAIT_V(0);
    if (wr == 0) PG8_BAR;
    PG8_BAR;
#undef PG8_SA
#undef PG8_SB
#undef PG8_STAGE
#undef PG8_LDA
#undef PG8_LDB
#undef PG8_MMA
#undef PG8_WAIT_V
#undef PG8_WAIT_L
#undef PG8_BAR
#undef PG8_SCHED
}

template <class F> __device__ __forceinline__ void walk8(const f32x4 (&acc)[2][2][4][2], const Unit& u, int wr, int wc, int fr, int fq, F f) {
    const int row0 = u.pm * BM + wr * 64 + fr, col0 = u.pn * BM + wc * 32 + 8 * fq;
#pragma unroll
    for (int ai = 0; ai < 2; ++ai)
#pragma unroll
        for (int m = 0; m < 4; ++m)
#pragma unroll
            for (int bj = 0; bj < 2; ++bj) f(row0 + ai * HALF + m * 16, col0 + bj * HALF, acc[ai][bj][m][0], acc[ai][bj][m][1]);
}
template <class F> __device__ __forceinline__ void walk4(const f32x4 (&acc)[2][2][4][2], const Unit& u, int wr, int wc, int fr, int fq, F f) {
    const int row0 = u.pm * BM + wr * 64 + fr, col0 = u.pn * BM + wc * 32 + 4 * fq;
#pragma unroll
    for (int ai = 0; ai < 2; ++ai)
#pragma unroll
        for (int m = 0; m < 4; ++m)
#pragma unroll
            for (int bj = 0; bj < 2; ++bj)
#pragma unroll
                for (int n = 0; n < 2; ++n) f(row0 + ai * HALF + m * 16, col0 + bj * HALF + n * 16, acc[ai][bj][m][n]);
}
}
using pg8::Unit;
typedef f32x4 AccT[2][2][4][2];


struct EpiWin {
    static constexpr bool PERM = true;
    bf16_t* ZS; bf16_t* G;
    __device__ __forceinline__ void operator()(const AccT& acc, const Unit& u, int wr, int wc, int fr, int fq) const {
        if (u.pn < 19) {
            bf16_t* z = ZS;
            pg8::walk8(acc, u, wr, wc, fr, fq, [&](int row, int col, f32x4 a, f32x4 b) { *(u32x4*)(z + (size_t)row * ZW + col) = pack8v(a, b); });
        } else {
            bf16_t* g = G;
            pg8::walk8(acc, u, wr, wc, fr, fq, [&](int row, int col, f32x4 a, f32x4 b) {
#pragma unroll
                for (int k = 0; k < 4; ++k) { a[k] = sigmoidf_(a[k]); b[k] = sigmoidf_(b[k]); }
                *(u32x4*)(g + (size_t)row * GW + (col - ZW)) = pack8v(a, b); });
        }
    }
};
struct EpiBf16 {
    static constexpr bool PERM = true;
    bf16_t* O; int ldo;
    __device__ __forceinline__ void operator()(const AccT& acc, const Unit& u, int wr, int wc, int fr, int fq) const {
        bf16_t* o = O; const int ld = ldo;
        pg8::walk8(acc, u, wr, wc, fr, fq, [&](int row, int col, f32x4 a, f32x4 b) { *(u32x4*)(o + (size_t)row * ld + col) = pack8v(a, b); });
    }
};
struct EpiLora {
    static constexpr bool PERM = false;
    const float* w0; const float* a0; const float* k_a;
    const bf16_t* RK; const char* R1; char* R2; bf16_t* GRW; const int* RBP;
    __device__ __forceinline__ void operator()(const AccT& acc, const Unit& u, int wr, int wc, int fr, int fq) const {
        const int seg = u.pn >> 1;
        const int row0 = u.pm * 256 + wr * 64 + fr, col0 = u.pn * 256 + wc * 32 + 4 * fq;
        if (seg == 4) {
#pragma unroll
            for (int ai = 0; ai < 2; ++ai)
#pragma unroll
                for (int m = 0; m < 4; ++m)
#pragma unroll
                    for (int bj = 0; bj < 2; ++bj)
#pragma unroll
                        for (int n = 0; n < 2; ++n) { const f32x4 v = acc[ai][bj][m][n]; const int row = row0 + ai * 128 + m * 16, c = (col0 + bj * 128 + n * 16) & 511;
                            u32x2 w; w.x = pk2(v[0], v[1]); w.y = pk2(v[2], v[3]); *(u32x2*)(GRW + (size_t)row * 512 + c) = w; }
            return;
        }
        const int d = seg & 1;
        int rb1[8], rbd[8];
#pragma unroll
        for (int i = 0; i < 8; ++i) { const int row = row0 + (i >> 2) * 128 + (i & 3) * 16; rb1[i] = RBP[row * 4]; rbd[i] = RBP[row * 4 + 1 + d]; }
        if (seg < 2) {
#pragma unroll
            for (int j = 0; j < 4; ++j) {
                const int c = (col0 + (j >> 1) * 128 + (j & 1) * 16) & 511, hd = c >> 6, c64 = c & 63;
                const f32x4 cw = *(const f32x4*)(w0 + d * 512 + c);
#pragma unroll
                for (int i = 0; i < 8; ++i) {
                    const f32x4 v = acc[i >> 2][j >> 1][i & 3][j & 1]; f32x4 r;
#pragma unroll
                    for (int k = 0; k < 4; ++k) { const float w = cw[k] + v[k]; r[k] = __expf(-0.6065306597126334f * sigmoidf_(w)); }
                    *(f32x4*)(R2 + (size_t)(rbd[i] + (hd * 2 + d) * 2304) * R2B + c64 * 4) = r;
                }
            }
        } else {
#pragma unroll
            for (int j = 0; j < 4; ++j) {
                const int c = (col0 + (j >> 1) * 128 + (j & 1) * 16) & 511, hd = c >> 6, c64 = c & 63;
                const f32x4 cw = *(const f32x4*)(a0 + d * 512 + c), ck = *(const f32x4*)(k_a + c);
#pragma unroll
                for (int ih = 0; ih < 2; ++ih) {
                    f32x4 kk[4]; u32x2 kw[4];
#pragma unroll
                    for (int ii = 0; ii < 4; ++ii) { const int i = ih * 4 + ii; const int row = row0 + (i >> 2) * 128 + (i & 3) * 16; kk[ii] = *(const f32x4*)(R1 + (size_t)(rb1[i] + hd * 2304) * R1B + c64 * 4); kw[ii] = *(const u32x2*)(RK + (size_t)row * 512 + c); }
#pragma unroll
                    for (int ii = 0; ii < 4; ++ii) {
                        const int i = ih * 4 + ii;
                        const f32x4 v = acc[i >> 2][j >> 1][i & 3][j & 1];
                        const float kf[4] = { __uint_as_float(kw[ii].x << 16), __uint_as_float(kw[ii].x & 0xffff0000u), __uint_as_float(kw[ii].y << 16), __uint_as_float(kw[ii].y & 0xffff0000u) };
                        f32x4 bb, kd;
#pragma unroll
                        for (int k = 0; k < 4; ++k) { const float a = sigmoidf_(cw[k] + v[k]); kd[k] = kf[k] * (1.0f + (a - 1.0f) * ck[k]); bb[k] = -(kk[ii][k] * a); }
                        char* rec = R2 + (size_t)(rbd[i] + (hd * 2 + d) * 2304) * R2B + c64 * 2;
                        { u32x2 wb; wb.x = pk2(bb[0], bb[1]); wb.y = pk2(bb[2], bb[3]); *(u32x2*)(rec + 256) = wb; u32x2 wk; wk.x = pk2(kd[0], kd[1]); wk.y = pk2(kd[2], kd[3]); *(u32x2*)(rec + 384) = wk; }
                    }
                }
            }
        }
    }
};
struct EpiFourChan {
    static constexpr bool PERM = true;
    bf16_t* XCS; bf16_t* XCSC;
    __device__ __forceinline__ void operator()(const AccT& acc, const Unit& u, int wr, int wc, int fr, int fq) const {
        pg8::walk8(acc, u, wr, wc, fr, fq, [&](int row, int col, f32x4 a, f32x4 b) {
            const int gc = row >> 1, cs = row & 1;
            if (col < T) { const int bb = col >> 11, n = col & 2047; *(u32x4*)(XCS + ((size_t)((bb * 512 + gc) * 2 + cs)) * 2048 + n) = pack8v(a, b); }
            else { const int cc = col - T, bb = cc >> 8, n = cc & 255; *(u32x4*)(XCSC + ((size_t)((bb * 512 + gc) * 2 + cs)) * 256 + n) = pack8v(a, b); }
        });
    }
};
struct EpiFourSeq {
    static constexpr bool PERM = true;
    bf16_t* Y; int rowbase, seqlen; float scale;
    __device__ __forceinline__ void operator()(const AccT& acc, const Unit& u, int wr, int wc, int fr, int fq) const {
        pg8::walk8(acc, u, wr, wc, fr, fq, [&](int row, int col, f32x4 a, f32x4 b) {
            const int bb = col >> 9, ch = col & 511;
            a *= scale; b *= scale;
            *(u32x4*)(Y + (size_t)(rowbase + bb * seqlen + row) * 2048 + ch) = pack8v(a, b);
        });
    }
};
struct EpiMerge {
    static constexpr bool PERM = true;
    const bf16_t* G; float* ACC; bf16_t* ACCB;
    __device__ __forceinline__ void operator()(const AccT& acc, const Unit& u, int wr, int wc, int fr, int fq) const {
        const int br = u.aux;
        pg8::walk8(acc, u, wr, wc, fr, fq, [&](int row, int col, f32x4 a, f32x4 b) {
            float g[8]; load8(G + (size_t)row * GW + br * 2048 + col, g);
            float* ap = ACC + (size_t)row * 2048 + col;
            f32x4 t0 = {0.f, 0.f, 0.f, 0.f}, t1 = {0.f, 0.f, 0.f, 0.f};
            if (br > 0) { t0 = *(const f32x4*)ap; t1 = *(const f32x4*)(ap + 4); }
#pragma unroll
            for (int k = 0; k < 4; ++k) { t0[k] += g[k] * a[k]; t1[k] += g[4 + k] * b[k]; }
            if (br < 3) { *(f32x4*)ap = t0; *(f32x4*)(ap + 4) = t1; }
            else *(u32x4*)(ACCB + (size_t)row * 2048 + col) = pack8v(t0, t1);
        });
    }
};
struct EpiWout {
    static constexpr bool PERM = false;
    float* X; const float* MODL;
    const float* Xlat; const float* Xctx;
    __device__ __forceinline__ void operator()(const AccT& acc, const Unit& u, int wr, int wc, int fr, int fq) const {
        const int row0 = u.pm * 256 + wr * 64 + fr, col0 = u.pn * 256 + wc * 32 + 4 * fq;
        const float* XS = (u.pm < T / 256) ? Xlat : Xctx;
        const float* gp = MODL + (size_t)row_s(u.pm * 256) * 12288 + 2 * 2048 + col0;
        f32x4 g[4];
#pragma unroll
        for (int j = 0; j < 4; ++j) g[j] = *(const f32x4*)(gp + (j >> 1) * 128 + (j & 1) * 16);
#pragma unroll
        for (int h2 = 0; h2 < 2; ++h2) {
            f32x4 xv[4][4];
#pragma unroll
            for (int ii = 0; ii < 4; ++ii) { const int i = h2 * 4 + ii; const float* xp = XS + (size_t)(row0 + (i >> 2) * 128 + (i & 3) * 16) * 2048 + col0;
#pragma unroll
                for (int j = 0; j < 4; ++j) xv[ii][j] = *(const f32x4*)(xp + (j >> 1) * 128 + (j & 1) * 16); }
#pragma unroll
            for (int ii = 0; ii < 4; ++ii) { const int i = h2 * 4 + ii; float* xp = X + (size_t)(row0 + (i >> 2) * 128 + (i & 3) * 16) * 2048 + col0;
#pragma unroll
                for (int j = 0; j < 4; ++j) *(f32x4*)(xp + (j >> 1) * 128 + (j & 1) * 16) = xv[ii][j] + g[j] * acc[i >> 2][j >> 1][i & 3][j & 1]; }
        }
    }
};
struct EpiSwiglu {
    static constexpr bool PERM = true;
    bf16_t* HH;
    __device__ __forceinline__ void operator()(const AccT& acc, const Unit& u, int wr, int wc, int fr, int fq) const {
        const int row0 = u.pm * 256 + wr * 64 + fr, col0 = u.pn * 128 + wc * 32 + 8 * fq;
#pragma unroll
        for (int ai = 0; ai < 2; ++ai)
#pragma unroll
            for (int m = 0; m < 4; ++m) {
                f32x4 o0, o1;
#pragma unroll
                for (int k = 0; k < 4; ++k) {
                    const float a0 = acc[ai][0][m][0][k], u0 = acc[ai][1][m][0][k], a1 = acc[ai][0][m][1][k], u1 = acc[ai][1][m][1][k];
                    o0[k] = a0 * sigmoidf_(a0) * u0; o1[k] = a1 * sigmoidf_(a1) * u1;
                }
                *(u32x4*)(HH + (size_t)(row0 + ai * 128 + m * 16) * EFF + col0) = pack8v(o0, o1);
            }
    }
};
struct EpiMoeOut {
    static constexpr bool PERM = true;
    bf16_t* YE; const float* GATEV;
    __device__ __forceinline__ void operator()(const AccT& acc, const Unit& u, int wr, int wc, int fr, int fq) const {
        const int row0 = u.pm * 256 + wr * 64 + fr, col0 = u.pn * 256 + wc * 32 + 8 * fq;
        float gt[8];
#pragma unroll
        for (int i = 0; i < 8; ++i) gt[i] = GATEV[row0 + (i >> 2) * 128 + (i & 3) * 16];
#pragma unroll
        for (int i = 0; i < 8; ++i)
#pragma unroll
            for (int bj = 0; bj < 2; ++bj) {
                f32x4 a = acc[i >> 2][bj][i & 3][0], b = acc[i >> 2][bj][i & 3][1]; a *= gt[i]; b *= gt[i];
                *(u32x4*)(YE + (size_t)(row0 + (i >> 2) * 128 + (i & 3) * 16) * 2048 + col0 + bj * 128) = pack8v(a, b);
            }
    }
};

__device__ __forceinline__ int opaque_tid(int wid0) { int t = (wid0 << 6) | opaque_lane(); asm volatile("" : "+v"(t)); return t; }
#define PH_PROLOG const int _tid = opaque_tid(wid0)
#define TID (_tid)
#define WID (_tid >> 6)
#define LANE (_tid & 63)
#define GWAVE ((int)(blockIdx.x * 8) + (_tid >> 6))
#define NWAVE ((int)(gridDim.x * 8))

__device__ __forceinline__ void ph_adaln_partial(const int wid0, const Params& p, LAS unsigned char* lds) {
    PH_PROLOG;
    LAS float* sv = (LAS float*)lds;
    const float* c = p.in[1]; const float* cc = p.in[3]; const float* ada_w = p.in[4];
    for (int u = blockIdx.x; u < 192; u += gridDim.x) {
        const int dc = u % 16, jc = (u / 16) % 6, l = u / 96;
        __syncthreads();
        for (int i = TID; i < 9 * 128; i += 512) { const int s = i / 128, d = dc * 128 + (i % 128); const float cv = s < 8 ? c[s * 2048 + d] : cc[d]; sv[i] = cv / (1.0f + __expf(-cv)); }
        __syncthreads();
        const float* w = ada_w + ((size_t)l * 2048 + dc * 128) * 12288 + jc * 2048 + TID * 4;
        f32x4 acc[9];
#pragma unroll
        for (int s = 0; s < 9; ++s) acc[s] = (f32x4){0.f, 0.f, 0.f, 0.f};
        for (int d0 = 0; d0 < 128; d0 += 8) {
            f32x4 w4[8];
#pragma unroll
            for (int j = 0; j < 8; ++j) w4[j] = *(const f32x4*)(w + (size_t)(d0 + j) * 12288);
#pragma unroll
            for (int j = 0; j < 8; ++j)
#pragma unroll
                for (int s = 0; s < 9; ++s) acc[s] += sv[s * 128 + d0 + j] * w4[j];
        }
#pragma unroll
        for (int s = 0; s < 9; ++s) *(f32x4*)(p.MODP + (((size_t)dc * 2 + l) * 9 + s) * 12288 + jc * 2048 + TID * 4) = acc[s];
    }
}
__device__ __forceinline__ void ph_adaln_reduce(const int wid0, const Params& p) {
    PH_PROLOG;
    const float* ada_b = p.in[5];
    for (int i = blockIdx.x * 512 + TID; i < 2 * 9 * 12288; i += gridDim.x * 512) {
        const int j = i % 12288, l = i / (9 * 12288);
        float a = ada_b[l * 12288 + j];
        for (int dc = 0; dc < 16; ++dc) a += p.MODP[(size_t)dc * 2 * 9 * 12288 + i];
        p.MOD[i] = a;
    }
}

struct CvtJob { const float* src; bf16_t* dst; int R, C, dst_ld, map, nb; long src_bs, dst_bs; };
__device__ __forceinline__ int cvt_map(int map, int c) {
    if (map == 1) return c < 4640 ? c : c + 224;
    if (map == 2) return (c >> 7) * 256 + (c & 127);
    if (map == 3) return (c >> 7) * 256 + 128 + (c & 127);
    return c;
}
__device__ __forceinline__ void cvt_run(const int wid0, const CvtJob J, LAS unsigned char* lds, const int vb, const int nb) {
    PH_PROLOG;
    LAS float* tile = (LAS float*)lds;
    const int nct = J.C / 32, nct4 = (nct + 3) >> 2, tpb = (J.R / 64) * nct4, total = J.nb * tpb;
    const int tr = TID >> 3, tc = TID & 7;
    for (int t = vb; t < total; t += nb) {
        const int bi = t / tpb, r2 = t % tpb, rt = r2 / nct4, c4 = r2 % nct4;
        const float* src = J.src + (size_t)bi * J.src_bs + (size_t)(rt * 64 + tr) * J.C + c4 * 128 + tc * 4;
        f32x4 v[4];
#pragma unroll
        for (int q = 0; q < 4; ++q) v[q] = (c4 * 4 + q < nct) ? *(const f32x4*)(src + q * 32) : (f32x4){0.f, 0.f, 0.f, 0.f};
        __syncthreads();
#pragma unroll
        for (int q = 0; q < 4; ++q)
#pragma unroll
            for (int k = 0; k < 4; ++k) tile[(q * 32 + tc * 4 + k) * 65 + tr] = v[q][k];
        __syncthreads();
#pragma unroll
        for (int i = 0; i < 2; ++i) {
            const int pz = TID + 512 * i, c = pz >> 3, r8 = pz & 7;
            if (c4 * 4 + (c >> 5) < nct) {
                float f[8];
#pragma unroll
                for (int k = 0; k < 8; ++k) f[k] = tile[c * 65 + r8 * 8 + k];
                store8(J.dst + (size_t)bi * J.dst_bs + (size_t)cvt_map(J.map, c4 * 128 + c) * J.dst_ld + rt * 64 + r8 * 8, f);
            }
        }
    }
}
__device__ __forceinline__ void ph_cvt_mixer(const int wid0, const Params& p, int l, LAS unsigned char* lds, const int parts, const int vb, const int nb) {
    PH_PROLOG;
    if (parts & 1) {
        cvt_run(wid0, CvtJob{p.in[8] + (size_t)l * 2048 * 12832, p.WIN_T, 2048, 12832, 2048, 1, 1, 0, 0}, lds, vb, nb);
        for (int i = vb * 512 + TID; i < 224 * 2048 / 8; i += nb * 512) *(u32x4*)(p.WIN_T + (size_t)4640 * 2048 + (size_t)i * 8) = (u32x4){0u, 0u, 0u, 0u};
    }
    if (parts & 2) {
        cvt_run(wid0, CvtJob{p.in[30] + (size_t)l * 4 * 512 * 2048, p.WBR_T, 512, 2048, 2048, 0, 4, 512 * 2048, 512}, lds, vb, nb);
        cvt_run(wid0, CvtJob{p.in[31] + (size_t)l * 2048 * 2048, p.WOUT_T, 2048, 2048, 2048, 0, 1, 0, 0}, lds, vb, nb);
        cvt_run(wid0, CvtJob{p.in[14] + (size_t)l * 512 * 768, p.WUQ_T, 512, 768, 512, 0, 1, 0, 0}, lds, vb, nb);
        cvt_run(wid0, CvtJob{p.in[15] + (size_t)l * 256 * 1024, p.WUKV_T, 256, 1024, 256, 0, 1, 0, 0}, lds, vb, nb);
        const float* w2 = p.in[21] + (size_t)l * 2 * 32 * 512; const float* a2 = p.in[23] + (size_t)l * 2 * 32 * 512; const float* g2 = p.in[24] + (size_t)l * 96 * 512;
        for (int i = vb * 512 + TID; i < 2560 * 256; i += nb * 512) {
            const int n = i >> 8, k = i & 255, seg = n >> 9, c = n & 511; float v = 0.f;
            if (seg == 0 && k < 32) v = w2[(0 * 32 + k) * 512 + c];
            else if (seg == 1 && k >= 32 && k < 64) v = w2[(1 * 32 + (k - 32)) * 512 + c];
            else if (seg == 2 && k >= 64 && k < 96) v = a2[(0 * 32 + (k - 64)) * 512 + c];
            else if (seg == 3 && k >= 96 && k < 128) v = a2[(1 * 32 + (k - 96)) * 512 + c];
            else if (seg == 4 && k >= 128 && k < 224) v = g2[(k - 128) * 512 + c];
            p.WLORA_T[i] = f2bf(v);
        }
    }
}
__device__ __forceinline__ void ph_cvt_moe(const int wid0, const Params& p, int l, LAS unsigned char* lds, const int parts, const int vb, const int nb) {
    if (parts & 1) cvt_run(wid0, CvtJob{p.in[33] + (size_t)l * 16 * 2048 * 1024, p.W13T, 2048, 1024, 2048, 2, 16, 2048 * 1024, 2048 * 2048}, lds, vb, nb);
    if (parts & 2) cvt_run(wid0, CvtJob{p.in[34] + (size_t)l * 16 * 2048 * 1024, p.W13T, 2048, 1024, 2048, 3, 16, 2048 * 1024, 2048 * 2048}, lds, vb, nb);
    if (parts & 4) cvt_run(wid0, CvtJob{p.in[35] + (size_t)l * 16 * 1024 * 2048, p.W2T, 1024, 2048, 1024, 0, 16, 1024 * 2048, 2048 * 1024}, lds, vb, nb);
}
__device__ __forceinline__ void ph_const(const int wid0, const Params& p) {
    PH_PROLOG;
    const int gt = blockIdx.x * 512 + TID, gn = gridDim.x * 512;
    for (int i = gt; i < 1024 * 512; i += gn) {
        const int m = i >> 9, k = i & 511, g = m >> 8, cp = (m >> 1) & 127, cs = m & 1, g2 = k >> 7, c = k & 127; float v = 0.f;
        if (g == g2) { const int mm = (c * cp) & 127; const float x = (float)mm * (2.0f / 128.0f); v = cs ? sinpif(x) : cospif(x); }
        p.WFC[i] = f2bf(v);
    }
    for (int i = gt; i < 2048 * 4096; i += gn) {
        const int k = i >> 12, r = i & 4095, cs = r >> 11, n = r & 2047; const int mm = (k * n) & 2047; const float x = (float)mm * (2.0f / 2048.0f);
        p.ADFT[i] = f2bf(cs ? -sinpif(x) : cospif(x));
    }
    for (int i = gt; i < TT; i += gn) { int b, pf; row_bpos(i, b, pf); const int pr = pos_rev(pf); int* q = p.RBP + (size_t)i * 4; q[0] = b * 8 * 2304 + pf; q[1] = b * 16 * 2304 + pf; q[2] = b * 16 * 2304 + pr; q[3] = 0; }
    for (int i = gt; i < 256 * 512; i += gn) {
        const int k = i >> 9, r = i & 511, cs = r >> 8, n = r & 255; const int mm = (k * n) & 255; const float x = (float)mm * (2.0f / 256.0f);
        p.ADFTC[i] = f2bf(cs ? -sinpif(x) : cospif(x));
    }
}

__device__ __forceinline__ void ph_modulate(const int wid0, const Params& p, int l, bf16_t* dst) {
    PH_PROLOG;
    const float* g = p.in[6] + l * 2048;
    const float* modl = p.MOD + (size_t)l * 9 * 12288;
    for (int r = GWAVE; r < TT; r += NWAVE) {
        const float* src = (l == 0) ? (r < T ? p.in[0] + (size_t)r * 2048 : p.in[2] + (size_t)(r - T) * 2048) : p.XCUR + (size_t)r * 2048;
        f32x4 v[8]; float ss = 0.f;
#pragma unroll
        for (int i = 0; i < 8; ++i) { v[i] = *(const f32x4*)(src + i * 256 + LANE * 4); ss += v[i][0] * v[i][0] + v[i][1] * v[i][1] + v[i][2] * v[i][2] + v[i][3] * v[i][3]; }
        ss = wave_sum(ss);
        const float rs = rsqrtf(ss * (1.0f / 2048.0f) + NORM_EPS);
        const float* ms = modl + (size_t)row_s(r) * 12288;
        u32x2 w[8];
#pragma unroll
        for (int i = 0; i < 8; ++i) {
            const int c = i * 256 + LANE * 4;
            const f32x4 gg = *(const f32x4*)(g + c), sh = *(const f32x4*)(ms + c), sc = *(const f32x4*)(ms + 2048 + c);
            f32x4 y = v[i] * rs * gg * (1.0f + sc) + sh;
            w[i].x = pk2(y[0], y[1]); w[i].y = pk2(y[2], y[3]);
        }
#pragma unroll
        for (int i = 0; i < 8; ++i) *(u32x2*)(dst + (size_t)r * 2048 + i * 256 + LANE * 4) = w[i];
    }
}

__device__ __forceinline__ void shiftmix8(const bf16_t* z, bool hp, bool hn, const float* mu, float* o) {
    float a[8], b[8], c[8];
    load8(z, a);
    if (hp) load8(z - ZW, b); else { for (int k = 0; k < 8; ++k) b[k] = 0.f; }
    if (hn) load8(z + ZW, c); else { for (int k = 0; k < 8; ++k) c[k] = 0.f; }
#pragma unroll
    for (int k = 0; k < 8; ++k) o[k] = a[k] + (0.5f * (b[k] + c[k]) - a[k]) * mu[k];
}
__device__ __forceinline__ void smix8(const u32x4 wa, const u32x4 wb, const u32x4 wc, bool hp, bool hn, const float* mu, float* o) {
    float a[8], b[8], c[8];
    unpack8(wa, a); unpack8(wb, b); unpack8(wc, c);
#pragma unroll
    for (int k = 0; k < 8; ++k) { const float bb = hp ? b[k] : 0.f, cc = hn ? c[k] : 0.f; o[k] = a[k] + (0.5f * (bb + cc) - a[k]) * mu[k]; }
}
__device__ __forceinline__ void ldf8(const float* p, float* v) { const f32x4 a = *(const f32x4*)p, b = *(const f32x4*)(p + 4); v[0] = a[0]; v[1] = a[1]; v[2] = a[2]; v[3] = a[3]; v[4] = b[0]; v[5] = b[1]; v[6] = b[2]; v[7] = b[3]; }
__device__ __forceinline__ void ph_prepA(const int wid0, const Params& p, int l) {
    PH_PROLOG;
    const float* qn = p.in[9] + l * 64; const float* kn = p.in[10] + l * 64;
    const float* cqn = p.in[12] + l * 512; const float* ckvn = p.in[13] + l * 256;
    const float* mu_ks = p.in[18] + l * 1152; const float* mu_qs = p.in[19] + l * 608;
    const float* k_k = p.in[25] + l * 512;
    const int lane = LANE;
    float c_qn[8], c_kn[8], c_cqn[8], c_ckvn[8], c_muk[8], c_muv[8], c_mur[8], c_mul[8], c_kk[8];
    ldf8(qn + ((8 * lane) & 63), c_qn); ldf8(kn + ((8 * lane) & 63), c_kn); ldf8(cqn + 8 * lane, c_cqn); ldf8(ckvn + 8 * (lane & 31), c_ckvn);
    ldf8(mu_ks + 8 * lane, c_muk); ldf8(mu_ks + 512 + 8 * lane, c_muv); ldf8(mu_qs + 8 * lane, c_mur); ldf8(k_k + 8 * lane, c_kk);
    const int lj = lane < 16 ? lane : min(lane - 16, 11);
    ldf8(lane < 16 ? mu_ks + 1024 + 8 * lj : mu_qs + 512 + 8 * lj, c_mul);
    const int lcol = lane < 16 ? 2368 + 8 * lj : 4032 + 8 * lj;
    for (int r = GWAVE; r < TT; r += NWAVE) {
        const bf16_t* z = p.ZS + (size_t)r * ZW;
        int pos, len; if (r < T) { pos = r & 2047; len = 2048; } else { pos = (r - T) & 255; len = 256; }
        const bool hp = pos > 0, hn = pos < len - 1;
        const bool qside = !(l == DEPTH - 1 && r >= T);
        const bf16_t* zp = hp ? z - ZW : z; const bf16_t* zn = hn ? z + ZW : z;
        const u32x4 w_nq = *(const u32x4*)(z + 2496 + 8 * lane), w_nk = *(const u32x4*)(z + 8 * lane), w_cq = *(const u32x4*)(z + 3008 + 8 * lane), w_ckv = *(const u32x4*)(z + 1024 + 8 * (lane & 31));
        const u32x4 w_k0 = *(const u32x4*)(z + 1344 + 8 * lane), w_k1 = *(const u32x4*)(zp + 1344 + 8 * lane), w_k2 = *(const u32x4*)(zn + 1344 + 8 * lane);
        const u32x4 w_v0 = *(const u32x4*)(z + 1856 + 8 * lane), w_v1 = *(const u32x4*)(zp + 1856 + 8 * lane), w_v2 = *(const u32x4*)(zn + 1856 + 8 * lane);
        const u32x4 w_r0 = *(const u32x4*)(z + 3520 + 8 * lane), w_r1 = *(const u32x4*)(zp + 3520 + 8 * lane), w_r2 = *(const u32x4*)(zn + 3520 + 8 * lane);
        const u32x4 w_l0 = *(const u32x4*)(z + lcol), w_l1 = *(const u32x4*)(zp + lcol), w_l2 = *(const u32x4*)(zn + lcol);
        float v[8], o[8];
        if (qside) {
            unpack8(w_nq, v);
            float ss = 0.f; for (int k = 0; k < 8; ++k) ss += v[k] * v[k]; ss = sum8(ss); const float rs = rsqrtf(ss * (1.0f / 64.0f) + NORM_EPS) * (0.125f * 1.4426950408889634f);
            for (int k = 0; k < 8; ++k) o[k] = v[k] * rs * c_qn[k]; store8(p.NQ + (size_t)r * 512 + 8 * lane, o);
        }
        { unpack8(w_nk, v);
          float ss = 0.f; for (int k = 0; k < 8; ++k) ss += v[k] * v[k]; ss = sum8(ss); const float rs = rsqrtf(ss * (1.0f / 64.0f) + NORM_EPS);
          for (int k = 0; k < 8; ++k) o[k] = v[k] * rs * c_kn[k]; store8(p.NK + (size_t)r * 512 + 8 * lane, o); }
        if (qside) {
            unpack8(w_cq, v);
            float ss = 0.f; for (int k = 0; k < 8; ++k) ss += v[k] * v[k]; ss = wave_sum(ss); const float rs = rsqrtf(ss * (1.0f / 512.0f) + NORM_EPS);
            for (int k = 0; k < 8; ++k) o[k] = v[k] * rs * c_cqn[k]; store8(p.CQN + (size_t)r * 512 + 8 * lane, o);
        }
        { unpack8(w_ckv, v);
          float ss = 0.f; if (lane < 32) { for (int k = 0; k < 8; ++k) ss += v[k] * v[k]; }
          ss = wave_sum(ss); const float rs = rsqrtf(ss * (1.0f / 256.0f) + NORM_EPS);
          if (lane < 32) { for (int k = 0; k < 8; ++k) o[k] = v[k] * rs * c_ckvn[k]; store8(p.CKVN + (size_t)r * 256 + 8 * lane, o); } }
        smix8(w_k0, w_k1, w_k2, hp, hn, c_muk, o);
        store8(p.RK + (size_t)r * 512 + 8 * lane, o);
        int sb_, pf_; row_bpos(r, sb_, pf_);
        char* rec1 = p.R1 + ((size_t)(sb_ * 8 + (lane >> 3)) * 2304 + pf_) * R1B; const int j0_ = (lane & 7) * 8;
        { float t[8], ss = 0.f; for (int k = 0; k < 8; ++k) { t[k] = o[k] * c_kk[k]; ss += t[k] * t[k]; } ss = sum8(ss);
          const float inv = 1.0f / fmaxf(sqrtf(ss), 1e-12f);
          f32x4 k0 = {t[0] * inv, t[1] * inv, t[2] * inv, t[3] * inv}, k1 = {t[4] * inv, t[5] * inv, t[6] * inv, t[7] * inv};
          *(f32x4*)(rec1 + j0_ * 4) = k0; *(f32x4*)(rec1 + j0_ * 4 + 16) = k1; }
        smix8(w_v0, w_v1, w_v2, hp, hn, c_muv, o);
        store8((bf16_t*)(rec1 + 512) + j0_, o);
        if (qside) smix8(w_r0, w_r1, w_r2, hp, hn, c_mur, o); else { for (int k = 0; k < 8; ++k) o[k] = 0.f; }
        { const f32x4 r0 = {o[0], o[1], o[2], o[3]}, r1 = {o[4], o[5], o[6], o[7]}; *(f32x4*)(rec1 + 256 + j0_ * 4) = r0; *(f32x4*)(rec1 + 256 + j0_ * 4 + 16) = r1; }
        if (lane < 16) {
            smix8(w_l0, w_l1, w_l2, hp, hn, c_mul, o);
            if (lane < 8) for (int k = 0; k < 8; ++k) o[k] = 1.0f - 2.0f * __builtin_amdgcn_rcpf(1.0f + __expf(2.0f * o[k]));
            store8(p.LA + (size_t)r * 256 + 8 * lane, o);
        } else if (lane < 28) {
            const int j = lane - 16;
            if (qside) { smix8(w_l0, w_l1, w_l2, hp, hn, c_mul, o); for (int k = 0; k < 8; ++k) o[k] = sigmoidf_(o[k]); } else { for (int k = 0; k < 8; ++k) o[k] = 0.f; }
            store8(p.LA + (size_t)r * 256 + 128 + 8 * j, o);
        } else if (lane < 32) {
            for (int k = 0; k < 8; ++k) o[k] = 0.f;
            store8(p.LA + (size_t)r * 256 + 128 + 8 * (lane - 16), o);
        }
    }
}

__device__ __forceinline__ float rope_lane(float x, int lane, int pos) {
    const int blk = lane >> 5, jj = lane & 31, i = jj & 15;
    const int pp = blk ? (pos & 63) : (pos >> 6);
    const float freq = exp2f(-(float)i * (13.287712379549449f / 16.0f));
    const float ang = (float)pp * freq;
    float s, c; sincosf(ang, &s, &c);
    const float xp = __shfl_xor(x, 16);
    return (jj < 16) ? (x * c - xp * s) : (xp * s + x * c);
}
__device__ __forceinline__ void ph_prepB(const int wid0, const Params& p, int l) {
    PH_PROLOG;
    const float* qg = p.in[16] + l * 192; const float* kg = p.in[17] + l * 192;
    const int lane = LANE;
    const float MLA_SCALE = 0.07216878364870323f * 1.4426950408889634f;
    const float qg0 = qg[lane], qg1 = qg[lane + 64], qg2 = qg[lane + 128], kg0 = kg[lane], kg1 = kg[lane + 64], kg2 = kg[lane + 128];
    const float rfreq = exp2f(-(float)(lane & 15) * (13.287712379549449f / 16.0f));
    for (int r = GWAVE; r < TT; r += NWAVE) {
        const bf16_t* q = p.Q0 + (size_t)r * 768; const bf16_t* kv = p.KV0 + (size_t)r * 1024; const bf16_t* zr = p.ZS + (size_t)r * ZW + 1280 + lane;
        bf16_t qv[4][3], kw[4][2];
#pragma unroll
        for (int h = 0; h < 4; ++h) { qv[h][0] = q[h * 192 + lane]; qv[h][1] = q[h * 192 + lane + 64]; qv[h][2] = q[h * 192 + lane + 128]; kw[h][0] = kv[h * 256 + lane]; kw[h][1] = kv[h * 256 + lane + 64]; }
        const bf16_t k2 = zr[0];
        float rs_ = 0.f, rc_ = 1.f;
        if (r < T) { const int pos = r & 2047, pp = (lane >> 5) ? (pos & 63) : (pos >> 6); __sincosf((float)pp * rfreq, &rs_, &rc_); }
#pragma unroll
        for (int h = 0; h < 4; ++h) {
            {
                float x0 = bf2f(qv[h][0]), x1 = bf2f(qv[h][1]), x2 = bf2f(qv[h][2]);
                const float ss = wave_sum(x0 * x0 + x1 * x1 + x2 * x2), rs = rsqrtf(ss * (1.0f / 192.0f) + NORM_EPS);
                x0 *= rs * qg0; x1 *= rs * qg1; x2 *= rs * qg2;
                if (r < T) { const float xp = __shfl_xor(x2, 16); x2 = ((lane & 31) < 16) ? (x2 * rc_ - xp * rs_) : (xp * rs_ + x2 * rc_); }
                bf16_t* o = p.MQ + ((size_t)r * 4 + h) * 192;
                o[lane] = f2bf(x0 * MLA_SCALE); o[lane + 64] = f2bf(x1 * MLA_SCALE); o[lane + 128] = f2bf(x2 * MLA_SCALE);
            }
            {
                float x0 = bf2f(kw[h][0]), x1 = bf2f(kw[h][1]), x2 = bf2f(k2);
                const float ss = wave_sum(x0 * x0 + x1 * x1 + x2 * x2), rs = rsqrtf(ss * (1.0f / 192.0f) + NORM_EPS);
                x0 *= rs * kg0; x1 *= rs * kg1; x2 *= rs * kg2;
                if (r < T) { const float xp = __shfl_xor(x2, 16); x2 = ((lane & 31) < 16) ? (x2 * rc_ - xp * rs_) : (xp * rs_ + x2 * rc_); }
                bf16_t* o = p.MK + ((size_t)r * 4 + h) * 192;
                o[lane] = f2bf(x0); o[lane + 64] = f2bf(x1); o[lane + 128] = f2bf(x2);
            }
        }
    }
    for (int it = GWAVE; it < 8 * 4 * 36 + 8 * 8 * 36; it += NWAVE) {
        const bool na = it >= 8 * 4 * 36; const int j = na ? it - 8 * 4 * 36 : it;
        const int g = j % 36, bh = j / 36, nh = na ? 8 : 4, b = bh / nh, h = bh % nh;
        const int kk = 64 * g + lane, krow = kk < 2048 ? b * 2048 + kk : T + b * 256 + (kk - 2048);
        const int kap = kk & 15, slot = (kk & ~15) + 8 * ((kap >> 2) & 1) + (kap & 3) + 4 * (kap >> 3);
        if (!na) {
            const bf16_t* src = p.KV0 + (size_t)krow * 1024 + h * 256 + 128; bf16_t* dst = p.MVT + ((size_t)(b * 4 + h) * 128) * 2304 + slot;
            u32x4 wv[16];
#pragma unroll
            for (int i = 0; i < 16; ++i) wv[i] = *(const u32x4*)(src + 8 * i);
#pragma unroll
            for (int i = 0; i < 16; ++i) { const unsigned ww[4] = {wv[i].x, wv[i].y, wv[i].z, wv[i].w};
#pragma unroll
                for (int k = 0; k < 8; ++k) dst[(size_t)(8 * i + k) * 2304] = (bf16_t)((ww[k >> 1] >> ((k & 1) * 16)) & 0xffffu); }
        } else {
            const bf16_t* src = p.ZS + (size_t)krow * ZW + 512 + h * 64; bf16_t* dst = p.NVT + ((size_t)(b * 8 + h) * 64) * 2304 + slot;
            u32x4 wv[8];
#pragma unroll
            for (int i = 0; i < 8; ++i) wv[i] = *(const u32x4*)(src + 8 * i);
#pragma unroll
            for (int i = 0; i < 8; ++i) { const unsigned ww[4] = {wv[i].x, wv[i].y, wv[i].z, wv[i].w};
#pragma unroll
                for (int k = 0; k < 8; ++k) dst[(size_t)(8 * i + k) * 2304] = (bf16_t)((ww[k >> 1] >> ((k & 1) * 16)) & 0xffffu); }
        }
    }
}

typedef float f32x16 __attribute__((ext_vector_type(16)));
__device__ __forceinline__ unsigned cvtpk(float lo, float hi) { return pk2(lo, hi); }
#define MFMA32(a, b, c) __builtin_amdgcn_mfma_f32_32x32x16_bf16((a), (b), (c), 0, 0, 0)
template <int NDB> __device__ __forceinline__ void softmax_step(f32x16& x0, f32x16& x1, float& m, float& lsum, f32x16 (&O)[NDB], bf16x8 (&pf)[4]) {
    constexpr float THR = 11.0f;
    float mx = x0[0];
#pragma unroll
    for (int r = 1; r < 16; ++r) mx = fmaxf(mx, x0[r]);
#pragma unroll
    for (int r = 0; r < 16; ++r) mx = fmaxf(mx, x1[r]);
    { auto rr = __builtin_amdgcn_permlane32_swap(__float_as_uint(mx), __float_as_uint(mx), false, false); mx = fmaxf(__uint_as_float(rr[0]), __uint_as_float(rr[1])); }
    if (!__all(mx - m <= THR)) {
        const float mn = fmaxf(m, mx), alpha = __builtin_amdgcn_exp2f(m - mn);
        lsum *= alpha;
#pragma unroll
        for (int d = 0; d < NDB; ++d) O[d] *= alpha;
        m = mn;
    }
    float ps = 0.f;
#pragma unroll
    for (int r = 0; r < 16; ++r) { x0[r] = __builtin_amdgcn_exp2f(x0[r] - m); ps += x0[r]; }
#pragma unroll
    for (int r = 0; r < 16; ++r) { x1[r] = __builtin_amdgcn_exp2f(x1[r] - m); ps += x1[r]; }
    lsum += ps;
    u32x4 w;
    w.x = cvtpk(x0[0], x0[1]); w.y = cvtpk(x0[2], x0[3]); w.z = cvtpk(x0[4], x0[5]); w.w = cvtpk(x0[6], x0[7]); pf[0] = *reinterpret_cast<bf16x8*>(&w);
    w.x = cvtpk(x0[8], x0[9]); w.y = cvtpk(x0[10], x0[11]); w.z = cvtpk(x0[12], x0[13]); w.w = cvtpk(x0[14], x0[15]); pf[1] = *reinterpret_cast<bf16x8*>(&w);
    w.x = cvtpk(x1[0], x1[1]); w.y = cvtpk(x1[2], x1[3]); w.z = cvtpk(x1[4], x1[5]); w.w = cvtpk(x1[6], x1[7]); pf[2] = *reinterpret_cast<bf16x8*>(&w);
    w.x = cvtpk(x1[8], x1[9]); w.y = cvtpk(x1[10], x1[11]); w.z = cvtpk(x1[12], x1[13]); w.w = cvtpk(x1[14], x1[15]); pf[3] = *reinterpret_cast<bf16x8*>(&w);
}
template <int NDB> __device__ __forceinline__ void attn_store(const f32x16 (&O)[NDB], float lsum, bf16_t* yrow, int hh) {
    { auto rr = __builtin_amdgcn_permlane32_swap(__float_as_uint(lsum), __float_as_uint(lsum), false, false); lsum = __uint_as_float(rr[0]) + __uint_as_float(rr[1]); }
    const float inv = 1.0f / lsum;
#pragma unroll
    for (int d = 0; d < NDB; ++d)
#pragma unroll
        for (int g = 0; g < 4; ++g) {
            u32x2 w; w.x = cvtpk(O[d][4 * g] * inv, O[d][4 * g + 1] * inv); w.y = cvtpk(O[d][4 * g + 2] * inv, O[d][4 * g + 3] * inv);
            *(u32x2*)(yrow + d * 32 + 8 * g + 4 * hh) = w;
        }
}

__device__ __forceinline__ void ph_mla_flash(const int wid0, const Params& p, int l, LAS unsigned char* lds) {
    PH_PROLOG;
    const int tid = TID, wid = __builtin_amdgcn_readfirstlane(tid >> 6), lane = tid & 63, r = lane & 31, hh = lane >> 5;
    constexpr int KP = 400, VP = 144, KBUF = 64 * KP, VBUF = 128 * VP, BUF = KBUF + VBUF;
    const int nunits = 256 + (l == 0 ? 32 : 0);
    const int vblk = (gridDim.x == 256) ? (int)((blockIdx.x & 7) * 32 + (blockIdx.x >> 3)) : (int)blockIdx.x;
    for (int u = vblk; u < nunits; u += gridDim.x) {
        int b, h, qrow0, nkt; bool ctxonly;
        if (u < 256) { b = u >> 5; h = (u >> 3) & 3; qrow0 = b * 2048 + (u & 7) * 256; nkt = 36; ctxonly = false; }
        else { const int j = u - 256; b = j >> 2; h = j & 3; qrow0 = T + b * 256; nkt = 4; ctxonly = true; }
        bf16x8 qf[12];
        { const bf16_t* qp = p.MQ + ((size_t)(qrow0 + wid * 32 + r) * 4 + h) * 192 + 8 * hh;
#pragma unroll
          for (int s = 0; s < 12; ++s) qf[s] = *(const bf16x8*)(qp + 16 * s); }
        f32x16 O[4];
#pragma unroll
        for (int d = 0; d < 4; ++d)
#pragma unroll
            for (int k = 0; k < 16; ++k) O[d][k] = 0.f;
        float m = -1.0e30f, lsum = 0.f;
        u32x4 kreg[3], vreg[2];
        const bf16_t* vtb = p.MVT + ((size_t)(b * 4 + h) * 128) * 2304;
#define MLA_LOAD(t) do { const int _t = (t); \
            const int krow0 = ctxonly ? (T + b * 256 + 64 * _t) : (_t < 32 ? b * 2048 + 64 * _t : T + b * 256 + 64 * (_t - 32)); \
            const int slot0 = ctxonly ? 2048 + 64 * _t : 64 * _t; \
            _Pragma("unroll") for (int i = 0; i < 3; ++i) { const int q = tid + 512 * i, row = q / 24, c = q % 24; kreg[i] = *(const u32x4*)(p.MK + ((size_t)(krow0 + row) * 4 + h) * 192 + c * 8); } \
            _Pragma("unroll") for (int i = 0; i < 2; ++i) { const int q = tid + 512 * i, d = q >> 3, c = q & 7; vreg[i] = *(const u32x4*)(vtb + (size_t)d * 2304 + slot0 + c * 8); } } while (0)
#define MLA_STORE(buf) do { LAS unsigned char* kb_ = lds + (buf) * BUF; \
            _Pragma("unroll") for (int i = 0; i < 3; ++i) { const int q = tid + 512 * i, row = q / 24, c = q % 24; *(LAS u32x4*)(kb_ + row * KP + c * 16) = kreg[i]; } \
            _Pragma("unroll") for (int i = 0; i < 2; ++i) { const int q = tid + 512 * i, d = q >> 3, c = q & 7; *(LAS u32x4*)(kb_ + KBUF + d * VP + c * 16) = vreg[i]; } } while (0)
        __syncthreads();
        MLA_LOAD(0); MLA_STORE(0);
        __syncthreads();
        for (int t = 0; t < nkt; ++t) {
            if (t + 1 < nkt) MLA_LOAD(t + 1);
            const LAS unsigned char* kb = lds + (t & 1) * BUF; const LAS unsigned char* vb = kb + KBUF;
            f32x16 x0, x1;
#pragma unroll
            for (int k = 0; k < 16; ++k) { x0[k] = 0.f; x1[k] = 0.f; }
#pragma unroll
            for (int s = 0; s < 12; s += 3) {
                bf16x8 a0[3], a1[3];
#pragma unroll
                for (int q = 0; q < 3; ++q) { a0[q] = *(const LAS bf16x8*)(kb + r * KP + (16 * (s + q) + 8 * hh) * 2); a1[q] = *(const LAS bf16x8*)(kb + (32 + r) * KP + (16 * (s + q) + 8 * hh) * 2); }
                __builtin_amdgcn_sched_barrier(0);
#pragma unroll
                for (int q = 0; q < 3; ++q) { x0 = MFMA32(a0[q], qf[s + q], x0); x1 = MFMA32(a1[q], qf[s + q], x1); }
                __builtin_amdgcn_sched_barrier(0);
            }
            bf16x8 pf[4];
            softmax_step<4>(x0, x1, m, lsum, O, pf);
#pragma unroll
            for (int d = 0; d < 4; ++d) {
                bf16x8 a[4];
#pragma unroll
                for (int j = 0; j < 4; ++j) a[j] = *(const LAS bf16x8*)(vb + (d * 32 + r) * VP + (j * 16 + 8 * hh) * 2);
                __builtin_amdgcn_sched_barrier(0);
#pragma unroll
                for (int j = 0; j < 4; ++j) O[d] = MFMA32(a[j], pf[j], O[d]);
                __builtin_amdgcn_sched_barrier(0);
            }
            if (t + 1 < nkt) MLA_STORE((t + 1) & 1);
            __syncthreads();
        }
#undef MLA_LOAD
#undef MLA_STORE
        attn_store<4>(O, lsum, p.Y + (size_t)(qrow0 + wid * 32 + r) * 2048 + 1024 + h * 128, hh);
    }
}

__device__ __forceinline__ void ph_na_flash(const int wid0, const Params& p, int l, LAS unsigned char* lds) {
    PH_PROLOG;
    const int tid = TID, lane = tid & 63, r = lane & 31, hh = lane >> 5;
    LAS float* bt = (LAS float*)lds;
    { const float* rpb = p.in[11] + (size_t)l * 8 * 15 * 31; for (int i = tid; i < 8 * 15 * 31; i += 512) bt[i] = rpb[i] * 1.4426950408889634f; }
    __syncthreads();
    const int nitems = 4096 + (l == 0 ? 512 : 0);
    int c0, cend, cstep;
    if (gridDim.x == 256) {
        const int xcd = blockIdx.x & 7, j = blockIdx.x >> 3, nch = nitems >> 3;
        if ((j & 7) == 7) { c0 = 0; cend = 0; cstep = 256; }
        else { c0 = (7 - xcd) * 28 + j - (j >> 3); cend = nch; cstep = 224; }
    } else { c0 = (int)blockIdx.x; cend = nitems >> 3; cstep = (int)gridDim.x; }
    for (int ch = c0; ch < cend; ch += cstep) {
        const int it = ch * 8 + wid0;
        int b, h, gr = 0, w = 0, qrow0; const bool isctx = it >= 4096;
        if (!isctx) { b = it >> 9; h = (it >> 6) & 7; gr = (it >> 1) & 31; w = it & 1; qrow0 = b * 2048 + gr * 64 + w * 32; }
        else { const int j = it - 4096; b = j >> 6; h = (j >> 3) & 7; qrow0 = T + b * 256 + (j & 7) * 32; }
        bf16x8 qf[4];
        { const bf16_t* qp = p.NQ + (size_t)(qrow0 + r) * 512 + h * 64 + 8 * hh;
#pragma unroll
          for (int s = 0; s < 4; ++s) qf[s] = *(const bf16x8*)(qp + 16 * s); }
        const int qc = w * 32 + r, rs = min(max(gr - 4, 0), 24), cs = min(max(qc - 8, 0), 48);
        f32x16 O[2];
#pragma unroll
        for (int d = 0; d < 2; ++d)
#pragma unroll
            for (int k = 0; k < 16; ++k) O[d][k] = 0.f;
        float m = -1.0e30f, lsum = 0.f;
        const bf16_t* vtb = p.NVT + ((size_t)(b * 8 + h) * 64) * 2304;
        const int nsteps = isctx ? 4 : 12;
#define NA_KROW(st_) ((!isctx && (st_) < 8) ? b * 2048 + (rs + (st_)) * 64 : T + b * 256 + 64 * (isctx ? (st_) : (st_) - 8))
#define NA_LOADK(st_) do { const bf16_t* kp_ = p.NK + (size_t)(NA_KROW(st_) + r) * 512 + h * 64 + 8 * hh; \
            _Pragma("unroll") for (int s = 0; s < 4; ++s) { kf[2 * s] = *(const bf16x8*)(kp_ + 16 * s); kf[2 * s + 1] = *(const bf16x8*)(kp_ + 32 * 512 + 16 * s); } } while (0)
        bf16x8 kf[8];
        NA_LOADK(0);
        for (int st = 0; st < nsteps; ++st) {
            const bool local = !isctx && st < 8;
            int slot0, dr = 0;
            if (local) { const int kr = rs + st; slot0 = kr * 64; dr = kr - gr + 7; }
            else { const int c = isctx ? st : st - 8; slot0 = 2048 + 64 * c; }
            f32x16 x0, x1;
#pragma unroll
            for (int k = 0; k < 16; ++k) { x0[k] = 0.f; x1[k] = 0.f; }
            const bf16_t* vp = vtb + (size_t)r * 2304 + slot0 + 8 * hh;
            bf16x8 vf[8];
#pragma unroll
            for (int d = 0; d < 2; ++d)
#pragma unroll
                for (int j = 0; j < 4; ++j) vf[d * 4 + j] = *(const bf16x8*)(vp + (size_t)(d * 32) * 2304 + j * 16);
            __builtin_amdgcn_sched_barrier(0);
#pragma unroll
            for (int s = 0; s < 4; ++s) { x0 = MFMA32(kf[2 * s], qf[s], x0); x1 = MFMA32(kf[2 * s + 1], qf[s], x1); }
            __builtin_amdgcn_sched_barrier(0);
            if (st + 1 < nsteps) NA_LOADK(st + 1);
            __builtin_amdgcn_sched_barrier(0);
            if (local) {
                const LAS float* brow = bt + (h * 15 + dr) * 31;
                const int q15 = 15 - qc;
                {   float bv[16];
#pragma unroll
                    for (int k = 0; k < 16; ++k) { const int kc0 = (k & 3) + 8 * (k >> 2) + 4 * hh; bv[k] = brow[min(max(kc0 + q15, 0), 30)]; }
#pragma unroll
                    for (int k = 0; k < 16; ++k) { const int kc0 = (k & 3) + 8 * (k >> 2) + 4 * hh; x0[k] = ((unsigned)(kc0 - cs) < 16u) ? x0[k] + bv[k] : -3.0e38f; }
                }
                {   float bv[16];
#pragma unroll
                    for (int k = 0; k < 16; ++k) { const int kc1 = (k & 3) + 8 * (k >> 2) + 4 * hh + 32; bv[k] = brow[min(max(kc1 + q15, 0), 30)]; }
#pragma unroll
                    for (int k = 0; k < 16; ++k) { const int kc1 = (k & 3) + 8 * (k >> 2) + 4 * hh + 32; x1[k] = ((unsigned)(kc1 - cs) < 16u) ? x1[k] + bv[k] : -3.0e38f; }
                }
            }
            bf16x8 pf[4];
            softmax_step<2>(x0, x1, m, lsum, O, pf);
#pragma unroll
            for (int d = 0; d < 2; ++d)
#pragma unroll
                for (int j = 0; j < 4; ++j) O[d] = MFMA32(vf[d * 4 + j], pf[j], O[d]);
        }
#undef NA_LOADK
#undef NA_KROW
        attn_store<2>(O, lsum, p.Y + (size_t)(qrow0 + r) * 2048 + 512 + h * 64, hh);
    }
}

#define MFMA_F32(a, b, c) __builtin_amdgcn_mfma_f32_32x32x2f32((a), (b), (c), 0, 0, 0)
constexpr int SCAN_NCH = 16, SCAN_LC = 144;
static_assert(SCAN_LC % 32 == 16, "the fix-up pass assumes a 16-step tail block");
__device__ __forceinline__ float half_sum(float x) { auto rr = __builtin_amdgcn_permlane32_swap(__float_as_uint(x), __float_as_uint(x), false, false); return __uint_as_float(rr[0]) + __uint_as_float(rr[1]); }
#define X2(T_, i_) ((f32x2){(T_)[(i_)], (T_)[(i_) + 1]})
template <bool DOP> __device__ __forceinline__ void scan_dot(const f32x16 (&X)[2][2], const f32x16 (&Z)[2][2], const LAS float* vec, float& s0, float& s1, float& t0, float& t1) {
    f32x2 a0 = {0.f, 0.f}, a1 = {0.f, 0.f}, c0 = {0.f, 0.f}, c1 = {0.f, 0.f};
#pragma unroll
    for (int jb = 0; jb < 2; ++jb)
#pragma unroll
        for (int g = 0; g < 4; ++g) {
            const f32x4 u = *(const LAS f32x4*)(vec + jb * 32 + 8 * g);
            const f32x2 ul = {u[0], u[1]}, uh = {u[2], u[3]};
            a0 += X2(X[0][jb], 4 * g) * ul; a0 += X2(X[0][jb], 4 * g + 2) * uh;
            a1 += X2(X[1][jb], 4 * g) * ul; a1 += X2(X[1][jb], 4 * g + 2) * uh;
            if (DOP) {
                c0 += X2(Z[0][jb], 4 * g) * ul; c0 += X2(Z[0][jb], 4 * g + 2) * uh;
                c1 += X2(Z[1][jb], 4 * g) * ul; c1 += X2(Z[1][jb], 4 * g + 2) * uh;
            }
            if (g & 1) { if (DOP) asm volatile("" : "+v"(a0), "+v"(a1), "+v"(c0), "+v"(c1) :: "memory"); else asm volatile("" : "+v"(a0), "+v"(a1) :: "memory"); }
        }
    s0 = half_sum(a0[0] + a0[1]); s1 = half_sum(a1[0] + a1[1]);
    if (DOP) { t0 = half_sum(c0[0] + c0[1]); t1 = half_sum(c1[0] + c1[1]); }
}
#define MUL2(T_, i_, u_) do { const f32x2 _t = X2(T_, i_) * (u_); (T_)[(i_)] = _t[0]; (T_)[(i_) + 1] = _t[1]; } while (0)
template <bool DOP> __device__ __forceinline__ void scan_decay(f32x16 (&X)[2][2], f32x16 (&Z)[2][2], const LAS float* vec) {
#pragma unroll
    for (int jb = 0; jb < 2; ++jb)
#pragma unroll
        for (int g = 0; g < 4; ++g) {
            const f32x4 u = *(const LAS f32x4*)(vec + jb * 32 + 8 * g);
            const f32x2 ul = {u[0], u[1]}, uh = {u[2], u[3]};
            MUL2(X[0][jb], 4 * g, ul); MUL2(X[0][jb], 4 * g + 2, uh); MUL2(X[1][jb], 4 * g, ul); MUL2(X[1][jb], 4 * g + 2, uh);
            if (DOP) { MUL2(Z[0][jb], 4 * g, ul); MUL2(Z[0][jb], 4 * g + 2, uh); MUL2(Z[1][jb], 4 * g, ul); MUL2(Z[1][jb], 4 * g + 2, uh); }
            if (g & 1) asm volatile("" ::: "memory");
        }
}
constexpr int SCAN_D = 8, SCAN_SLOT = R1B + R2B, SCAN_RING = (SCAN_D + 1) * SCAN_SLOT;
template <bool DOP, bool DOY, bool DOZ = false>
__device__ __forceinline__ void scan_run(const Params& p, int b, int h, int d, int s0, int s1, f32x16 (&Q)[2][2], f32x16 (&P)[2][2], LAS unsigned char* ring, int lane) {
    const int half = lane >> 5, l32 = lane & 31;
    const char* g1 = p.R1 + (size_t)(b * 8 + h) * 2304 * R1B;
    const char* g2 = p.R2 + (size_t)((b * 8 + h) * 2 + d) * 2304 * R2B;
    float* YS = p.YS + (size_t)((b * 8 + h) * 2 + d) * 2304 * 64;
    bf16_t* ZB = p.ZB + (size_t)((b * 8 + h) * 2 + d) * 2304 * 64;
    const unsigned lo16 = (unsigned)lane * 16u, lo4 = (unsigned)lane * 4u;
#define SCAN_ISSUE(sidx, slot) do { const int _s = (sidx); const int _p1 = d ? pos_rev(_s) : _s; LAS unsigned char* _sl = ring + (slot) * SCAN_SLOT; \
        if (lane < 40) __builtin_amdgcn_global_load_lds((const unsigned*)(g1 + (size_t)_p1 * R1B + lo16), (LAS unsigned*)(_sl), 16, 0, 0); \
        if (lane < 32) __builtin_amdgcn_global_load_lds((const unsigned*)(g2 + (size_t)_s * R2B + lo16), (LAS unsigned*)(_sl + R1B), 16, 0, 0); } while (0)
    { LAS unsigned char* zs = ring + SCAN_D * SCAN_SLOT; *(LAS u32x4*)(zs + lo16) = (u32x4){0u, 0u, 0u, 0u}; if (lane < (SCAN_SLOT - 1024) / 16) *(LAS u32x4*)(zs + 1024 + lo16) = (u32x4){0u, 0u, 0u, 0u}; }
#pragma unroll
    for (int k = 0; k < SCAN_D - 1; ++k) SCAN_ISSUE(s0 + k, k);
    for (int sb = s0; sb < s1; sb += 2) {
#pragma unroll
        for (int uu = 0; uu < 2; ++uu) {
            const int s = sb + uu, u = (s - s0) & (SCAN_D - 1);
            SCAN_ISSUE(min(s + SCAN_D - 1, s1 - 1), (u + SCAN_D - 1) & (SCAN_D - 1));
            asm volatile("s_waitcnt vmcnt(14)" ::: "memory");
            const LAS unsigned char* sl = ring + u * SCAN_SLOT;
            const LAS float* Lh = (const LAS float*)sl + 4 * half;
            const LAS unsigned char* sh = (half ? ring + SCAN_D * SCAN_SLOT : sl) + l32 * 2;
            const unsigned kd0 = *(const LAS bf16_t*)(sh + R1B + 384), kd1 = *(const LAS bf16_t*)(sh + R1B + 384 + 64);
            const unsigned nb0 = *(const LAS bf16_t*)(sh + R1B + 256), nb1 = *(const LAS bf16_t*)(sh + R1B + 256 + 64);
            const unsigned vb0 = *(const LAS bf16_t*)(sh + 512), vb1 = *(const LAS bf16_t*)(sh + 512 + 64);
            float sq0, sq1, sp0 = 0.f, sp1 = 0.f;
            scan_dot<DOP>(Q, P, Lh, sq0, sq1, sp0, sp1);
            scan_decay<DOP>(Q, P, (const LAS float*)(sl + R1B) + 4 * half);
            u32x4 fa0 = {kd0 | (nb0 << 16), nb0, 0u, 0u}, fa1 = {kd1 | (nb1 << 16), nb1, 0u, 0u};
            const bf16x8 A0 = *reinterpret_cast<bf16x8*>(&fa0), A1 = *reinterpret_cast<bf16x8*>(&fa1);
#define SCAN_BFRAG(name, vb, sa) u32x4 name##_w = {0u, 0u, 0u, 0u}; { const unsigned _hi = (unsigned)f2bf(sa); const float _lo = (sa) - __uint_as_float(_hi << 16); \
                name##_w.x = (vb) | (_hi << 16); name##_w.y = (unsigned)f2bf(_lo); } const bf16x8 name = *reinterpret_cast<bf16x8*>(&name##_w)
            SCAN_BFRAG(B0q, vb0, sq0); SCAN_BFRAG(B1q, vb1, sq1);
            Q[0][0] = MFMA32(A0, B0q, Q[0][0]); Q[0][1] = MFMA32(A1, B0q, Q[0][1]);
            Q[1][0] = MFMA32(A0, B1q, Q[1][0]); Q[1][1] = MFMA32(A1, B1q, Q[1][1]);
            if (DOP) {
                SCAN_BFRAG(B0p, 0u, sp0); SCAN_BFRAG(B1p, 0u, sp1);
                P[0][0] = MFMA32(A0, B0p, P[0][0]); P[0][1] = MFMA32(A1, B0p, P[0][1]);
                P[1][0] = MFMA32(A0, B1p, P[1][0]); P[1][1] = MFMA32(A1, B1p, P[1][1]);
            }
#undef SCAN_BFRAG
            if (DOY) {
                float y0, y1, u0, u1; scan_dot<false>(Q, Q, Lh + 64, y0, y1, u0, u1);
                *(float*)((char*)(YS + (size_t)s * 64) + lo4) = half ? y1 : y0;
            }
            if (DOZ) {
                float y0, y1, z0, z1; scan_dot<true>(Q, P, Lh + 64, y0, y1, z0, z1);
                *(float*)((char*)(YS + (size_t)s * 64) + lo4) = half ? y1 : y0;
                *(bf16_t*)((char*)(ZB + (size_t)s * 64) + (lo4 >> 1)) = f2bf(half ? z1 : z0);
            }
        }
    }
    asm volatile("s_waitcnt vmcnt(0)" ::: "memory");
#undef SCAN_ISSUE
}
__device__ __forceinline__ void scan_zero(f32x16 (&X)[2][2]) {
#pragma unroll
    for (int a = 0; a < 2; ++a)
#pragma unroll
        for (int c = 0; c < 2; ++c)
#pragma unroll
            for (int k = 0; k < 16; ++k) X[a][c][k] = 0.f;
}
__device__ __forceinline__ void scan_store_acc(float* dst, const f32x16 (&X)[2][2], int lane) {
#pragma unroll
    for (int a = 0; a < 2; ++a)
#pragma unroll
        for (int c = 0; c < 2; ++c)
#pragma unroll
            for (int k = 0; k < 16; ++k) dst[((a * 2 + c) * 16 + k) * 64 + lane] = X[a][c][k];
}
__device__ __forceinline__ void scan_load_acc(const float* src, f32x16 (&X)[2][2], int lane) {
#pragma unroll
    for (int a = 0; a < 2; ++a)
#pragma unroll
        for (int c = 0; c < 2; ++c)
#pragma unroll
            for (int k = 0; k < 16; ++k) X[a][c][k] = src[((a * 2 + c) * 16 + k) * 64 + lane];
}
__device__ __forceinline__ void ph_scan_a(const int wid0, const Params& p, LAS unsigned char* lds) {
    PH_PROLOG;
    const int lane = LANE, wid = WID, half = lane >> 5, l32 = lane & 31;
    LAS unsigned char* L = lds + wid * SCAN_RING;
    for (int it = wid * (int)gridDim.x + (int)blockIdx.x; it < 128 * 16; it += NWAVE) {
        const int c = it >> 7, sid = it & 127, b = sid >> 4, h = (sid >> 1) & 7, d = sid & 1;
        f32x16 Q[2][2], P[2][2];
        scan_zero(Q);
        if (c == 0) {
            scan_run<false, true>(p, b, h, d, 0, SCAN_LC, Q, P, L, lane);
        } else {
#pragma unroll
            for (int a = 0; a < 2; ++a)
#pragma unroll
                for (int cc = 0; cc < 2; ++cc)
#pragma unroll
                    for (int k = 0; k < 16; ++k) P[a][cc][k] = (a == cc && l32 == ((k & 3) + 8 * (k >> 2) + 4 * half)) ? 1.f : 0.f;
            scan_run<true, false, true>(p, b, h, d, c * SCAN_LC, (c + 1) * SCAN_LC, Q, P, L, lane);
            if (c == 15) continue;
            float* pm = p.PMAT + ((size_t)sid * 16 + c) * 4096;
#pragma unroll
            for (int a = 0; a < 2; ++a)
#pragma unroll
                for (int cc = 0; cc < 2; ++cc)
#pragma unroll
                    for (int k = 0; k < 16; ++k)
                        pm[(cc * 32 + (k & 3) + 8 * (k >> 2) + 4 * half) * 64 + a * 32 + l32] = P[a][cc][k];
        }
        scan_store_acc(p.QMAT + ((size_t)sid * 16 + c) * 4096, Q, lane);
    }
}
__device__ __forceinline__ void ph_scan_b(const int wid0, const Params& p) {
    PH_PROLOG;
    const int lane = LANE, wid = WID, half = lane >> 5, l32 = lane & 31;
    const bool packed = gridDim.x == 256;
    if (packed && ((blockIdx.x >> 3) & 7) != 7) return;
    for (int it = packed ? (((int)blockIdx.x >> 6) * 8 + ((int)blockIdx.x & 7)) * 8 + wid : wid * (int)gridDim.x + (int)blockIdx.x; it < 256; it += packed ? 256 : NWAVE) {
        const int sid = it >> 1, ib = it & 1;
        f32x16 X[2];
        { const float* q0 = p.QMAT + ((size_t)sid * 16 + 0) * 4096;
#pragma unroll
          for (int c = 0; c < 2; ++c)
#pragma unroll
              for (int k = 0; k < 16; ++k) X[c][k] = q0[((ib * 2 + c) * 16 + k) * 64 + lane]; }
        for (int c = 1; c < 15; ++c) {
            const float* qc = p.QMAT + ((size_t)sid * 16 + c) * 4096 + lane; const float* pm = p.PMAT + ((size_t)sid * 16 + c) * 4096 + l32 * 64 + 4 * half;
            f32x16 N[2]; f32x4 A0[2][4], A1[2][4];
#pragma unroll
            for (int cc = 0; cc < 2; ++cc)
#pragma unroll
                for (int k = 0; k < 16; ++k) N[cc][k] = qc[((ib * 2 + cc) * 16 + k) * 64];
#pragma unroll
            for (int jb = 0; jb < 2; ++jb)
#pragma unroll
                for (int kq = 0; kq < 4; ++kq) { A0[jb][kq] = *(const f32x4*)(pm + jb * 32 + 8 * kq); A1[jb][kq] = *(const f32x4*)(pm + 32 * 64 + jb * 32 + 8 * kq); }
            float* sm = p.SMAT + ((size_t)sid * 16 + c) * 4096 + lane;
#pragma unroll
            for (int cc = 0; cc < 2; ++cc)
#pragma unroll
                for (int k = 0; k < 16; ++k) sm[((ib * 2 + cc) * 16 + k) * 64] = X[cc][k];
#pragma unroll
            for (int jb = 0; jb < 2; ++jb)
#pragma unroll
                for (int k = 0; k < 16; ++k) { N[0] = MFMA_F32(A0[jb][k >> 2][k & 3], X[jb][k], N[0]); N[1] = MFMA_F32(A1[jb][k >> 2][k & 3], X[jb][k], N[1]); }
            X[0] = N[0]; X[1] = N[1];
        }
        {   float* sm = p.SMAT + ((size_t)sid * 16 + 15) * 4096 + lane;
#pragma unroll
            for (int cc = 0; cc < 2; ++cc)
#pragma unroll
                for (int k = 0; k < 16; ++k) sm[((ib * 2 + cc) * 16 + k) * 64] = X[cc][k]; }
    }
}
__device__ __forceinline__ void ph_scan_c(const int wid0, const Params& p, LAS unsigned char* lds) {
    PH_PROLOG;
    (void)lds;
    const int lane = LANE, wid = WID, half = lane >> 5, l32 = lane & 31;
    for (int it = wid * (int)gridDim.x + (int)blockIdx.x; it < 128 * 15; it += NWAVE) {
        const int c = 1 + (it >> 7), sid = it & 127;
        f32x16 S[2][2];
        scan_load_acc(p.SMAT + ((size_t)sid * 16 + c) * 4096, S, lane);
        float* ys = p.YS + ((size_t)sid * 2304 + c * SCAN_LC) * 64;
        const bf16_t* zs = p.ZB + ((size_t)sid * 2304 + c * SCAN_LC) * 64;
#pragma unroll 1
        for (int tb = 0; tb < (SCAN_LC + 31) / 32; ++tb) {
            const int t = tb * 32 + l32;
            float za[2][16];
#pragma unroll
            for (int jb = 0; jb < 2; ++jb)
#pragma unroll
                for (int g = 0; g < 4; ++g) {
                    u32x2 w = *(const u32x2*)(zs + (size_t)min(t, SCAN_LC - 1) * 64 + jb * 32 + 8 * g + 4 * half);
                    if (t >= SCAN_LC) w = (u32x2){0u, 0u};
                    za[jb][4 * g] = __uint_as_float(w.x << 16); za[jb][4 * g + 1] = __uint_as_float(w.x & 0xffff0000u);
                    za[jb][4 * g + 2] = __uint_as_float(w.y << 16); za[jb][4 * g + 3] = __uint_as_float(w.y & 0xffff0000u);
                }
            f32x16 D[2];
#pragma unroll
            for (int ib = 0; ib < 2; ++ib)
#pragma unroll
                for (int k = 0; k < 16; ++k) { const int tk = tb * 32 + (k & 3) + 8 * (k >> 2) + 4 * half; D[ib][k] = ys[(size_t)min(tk, SCAN_LC - 1) * 64 + ib * 32 + l32]; }
#pragma unroll
            for (int ib = 0; ib < 2; ++ib)
#pragma unroll
                for (int jb = 0; jb < 2; ++jb)
#pragma unroll
                    for (int k = 0; k < 16; ++k) D[ib] = MFMA_F32(za[jb][k], S[ib][jb][k], D[ib]);
#pragma unroll
            for (int ib = 0; ib < 2; ++ib)
#pragma unroll
                for (int k = 0; k < 16; ++k) { const int tk = tb * 32 + (k & 3) + 8 * (k >> 2) + 4 * half; if (k < 8 || tb * 32 + 16 < SCAN_LC) ys[(size_t)tk * 64 + ib * 32 + l32] = D[ib][k]; }
        }
    }
}

__device__ __forceinline__ void ph_rwkv_out(const int wid0, const Params& p, int l) {
    PH_PROLOG;
    const float* r_k = p.in[27] + l * 512; const float* ln_w = p.in[28] + l * 512; const float* ln_b = p.in[29] + l * 512;
    const int lane = LANE, hd = lane >> 3, j0 = (lane & 7) * 8;
    const int nrows = (l == DEPTH - 1) ? T : TT;
    float c_rk[8], c_lw[8], c_lb[8];
    ldf8(r_k + 8 * lane, c_rk); ldf8(ln_w + 8 * lane, c_lw); ldf8(ln_b + 8 * lane, c_lb);
    for (int r0 = GWAVE; r0 < nrows; r0 += 2 * NWAVE) {
        f32x4 ya[2][2], yc[2][2], r4[2][2]; u32x4 wv[2], wkf[2], wkb[2], wg[2];
#pragma unroll
        for (int u = 0; u < 2; ++u) {
            const int r = min(r0 + u * NWAVE, nrows - 1);
            int b, pf; row_bpos(r, b, pf); const int pr = pos_rev(pf);
            const float* yf = p.YS + ((size_t)((b * 8 + hd) * 2 + 0) * 2304 + pf) * 64 + j0; const float* yb = p.YS + ((size_t)((b * 8 + hd) * 2 + 1) * 2304 + pr) * 64 + j0;
            const char* rec1 = p.R1 + ((size_t)(b * 8 + hd) * 2304 + pf) * R1B;
            const char* rf = p.R2 + ((size_t)((b * 8 + hd) * 2 + 0) * 2304 + pf) * R2B + 384; const char* rb = p.R2 + ((size_t)((b * 8 + hd) * 2 + 1) * 2304 + pr) * R2B + 384;
#pragma unroll
            for (int q = 0; q < 2; ++q) { ya[u][q] = *(const f32x4*)(yf + 4 * q); yc[u][q] = *(const f32x4*)(yb + 4 * q); r4[u][q] = *(const f32x4*)(rec1 + 256 + (j0 + 4 * q) * 4); }
            wv[u] = *(const u32x4*)((const bf16_t*)(rec1 + 512) + j0); wkf[u] = *(const u32x4*)((const bf16_t*)rf + j0); wkb[u] = *(const u32x4*)((const bf16_t*)rb + j0);
            wg[u] = *(const u32x4*)(p.GRW + (size_t)r * 512 + 8 * lane);
        }
#pragma unroll
        for (int u = 0; u < 2; ++u) {
            const int r = r0 + u * NWAVE;
            if (r < nrows) {
                float y[8], rr[8], kf[8], kb[8], vv[8], gg[8];
#pragma unroll
                for (int q = 0; q < 2; ++q)
#pragma unroll
                    for (int k = 0; k < 4; ++k) { y[4 * q + k] = ya[u][q][k] + yc[u][q][k]; rr[4 * q + k] = r4[u][q][k]; }
                unpack8(wv[u], vv); unpack8(wkf[u], kf); unpack8(wkb[u], kb); unpack8(wg[u], gg);
                float s = 0.f; for (int k = 0; k < 8; ++k) s += y[k]; s = sum8(s); const float mu = s * (1.0f / 64.0f);
                float q = 0.f; for (int k = 0; k < 8; ++k) { const float dlt = y[k] - mu; q += dlt * dlt; } q = sum8(q);
                const float rstd = rsqrtf(q * (1.0f / 64.0f) + 64e-5f);
                float bc = 0.f; for (int k = 0; k < 8; ++k) bc += rr[k] * (kf[k] + kb[k]) * c_rk[k]; bc = sum8(bc);
                float out[8];
                for (int k = 0; k < 8; ++k) out[k] = ((y[k] - mu) * rstd * c_lw[k] + c_lb[k] + bc * vv[k]) * gg[k];
                store8(p.Y + (size_t)r * 2048 + 1536 + 8 * lane, out);
            }
        }
    }
}

__device__ __forceinline__ void ph_moe_router(const int wid0, const Params& p, int l, LAS unsigned char* lds) {
    PH_PROLOG;
    LAS float* wr = (LAS float*)lds;
    const float* wsrc = p.in[32] + (size_t)l * 2048 * 16;
    for (int i = TID; i < 2048 * 16; i += 512) { const int c = i >> 4, e = i & 15; wr[e * 2048 + c] = wsrc[i]; }
    __syncthreads();
    const float* g = p.in[7] + l * 2048;
    const float* modl = p.MOD + (size_t)l * 9 * 12288;
    const int lane = LANE;
    const int nrows = (l == 0) ? TT : T;
    for (int r0 = GWAVE; r0 < nrows; r0 += 2 * NWAVE) {
        const int r1 = r0 + NWAVE; const bool has1 = r1 < nrows; const int r1c = has1 ? r1 : r0;
        const float* src0 = p.XCUR + (size_t)r0 * 2048; const float* src1 = p.XCUR + (size_t)r1c * 2048;
        f32x4 v0[8], v1[8]; float ss0 = 0.f, ss1 = 0.f;
#pragma unroll
        for (int i = 0; i < 8; ++i) { v0[i] = *(const f32x4*)(src0 + i * 256 + lane * 4); v1[i] = *(const f32x4*)(src1 + i * 256 + lane * 4); }
#pragma unroll
        for (int i = 0; i < 8; ++i) { ss0 += v0[i][0] * v0[i][0] + v0[i][1] * v0[i][1] + v0[i][2] * v0[i][2] + v0[i][3] * v0[i][3]; ss1 += v1[i][0] * v1[i][0] + v1[i][1] * v1[i][1] + v1[i][2] * v1[i][2] + v1[i][3] * v1[i][3]; }
        ss0 = wave_sum(ss0); ss1 = wave_sum(ss1);
        const float rs0 = rsqrtf(ss0 * (1.0f / 2048.0f) + NORM_EPS), rs1 = rsqrtf(ss1 * (1.0f / 2048.0f) + NORM_EPS);
        const float* ms0 = modl + (size_t)row_s(r0) * 12288; const float* ms1 = modl + (size_t)row_s(r1c) * 12288;
#pragma unroll
        for (int i = 0; i < 8; ++i) {
            const int c = i * 256 + lane * 4;
            const f32x4 gg = *(const f32x4*)(g + c);
            const f32x4 sh0 = *(const f32x4*)(ms0 + 3 * 2048 + c), sc0 = *(const f32x4*)(ms0 + 4 * 2048 + c), sh1 = *(const f32x4*)(ms1 + 3 * 2048 + c), sc1 = *(const f32x4*)(ms1 + 4 * 2048 + c);
            v0[i] = v0[i] * rs0 * gg * (1.0f + sc0) + sh0; v1[i] = v1[i] * rs1 * gg * (1.0f + sc1) + sh1;
        }
#pragma unroll
        for (int i = 0; i < 8; ++i) { u32x2 w; w.x = pk2(v0[i][0], v0[i][1]); w.y = pk2(v0[i][2], v0[i][3]); *(u32x2*)(p.H2 + (size_t)r0 * 2048 + i * 256 + lane * 4) = w; }
        if (has1) {
#pragma unroll
            for (int i = 0; i < 8; ++i) { u32x2 w; w.x = pk2(v1[i][0], v1[i][1]); w.y = pk2(v1[i][2], v1[i][3]); *(u32x2*)(p.H2 + (size_t)r1 * 2048 + i * 256 + lane * 4) = w; }
        }
        float a0[16], a1[16];
#pragma unroll
        for (int e = 0; e < 16; ++e) {
            float t0 = 0.f, t1 = 0.f;
#pragma unroll
            for (int i = 0; i < 8; ++i) { const f32x4 w4 = *(const LAS f32x4*)(wr + e * 2048 + i * 256 + lane * 4);
                t0 += v0[i][0] * w4[0] + v0[i][1] * w4[1] + v0[i][2] * w4[2] + v0[i][3] * w4[3]; t1 += v1[i][0] * w4[0] + v1[i][1] * w4[1] + v1[i][2] * w4[2] + v1[i][3] * w4[3]; }
            asm volatile("" : "+v"(t0), "+v"(t1) :: "memory");
            a0[e] = t0; a1[e] = t1;
        }
#pragma unroll
        for (int u = 0; u < 2; ++u) {
            if (u == 1 && !has1) break;
            const int r = u ? r1 : r0;
            float a[16];
#pragma unroll
            for (int e = 0; e < 16; ++e) a[e] = u ? a1[e] : a0[e];
#pragma unroll
            for (int j = 0; j < 8; ++j) { const bool hi = lane & 32; const float keep = hi ? a[j + 8] : a[j], send = hi ? a[j] : a[j + 8]; a[j] = keep + __shfl_xor(send, 32); }
#pragma unroll
            for (int j = 0; j < 4; ++j) { const bool hi = lane & 16; const float keep = hi ? a[j + 4] : a[j], send = hi ? a[j] : a[j + 4]; a[j] = keep + __shfl_xor(send, 16); }
#pragma unroll
            for (int j = 0; j < 2; ++j) { const bool hi = lane & 8; const float keep = hi ? a[j + 2] : a[j], send = hi ? a[j] : a[j + 2]; a[j] = keep + __shfl_xor(send, 8); }
            { const bool hi = lane & 4; const float keep = hi ? a[1] : a[0], send = hi ? a[0] : a[1]; a[0] = keep + __shfl_xor(send, 4); }
            float lg = a[0]; lg += __shfl_xor(lg, 2); lg += __shfl_xor(lg, 1);
            float mx = lg;
            mx = fmaxf(mx, __shfl_xor(mx, 4)); mx = fmaxf(mx, __shfl_xor(mx, 8)); mx = fmaxf(mx, __shfl_xor(mx, 16)); mx = fmaxf(mx, __shfl_xor(mx, 32));
            const float ex = expf(lg - mx);
            float sum = ex;
            sum += __shfl_xor(sum, 4); sum += __shfl_xor(sum, 8); sum += __shfl_xor(sum, 16); sum += __shfl_xor(sum, 32);
            const float mine = ex / sum;
            const int myexp = (lane >> 2) & 15;
            if ((lane & 3) == 0) {
                if (r < T) p.AFFT[((size_t)((r >> 11) * 16 + myexp)) * 2048 + (r & 2047)] = mine;
                else p.AFFC[((size_t)(((r - T) >> 8) * 16 + myexp)) * 256 + ((r - T) & 255)] = mine;
            }
        }
    }
}
__device__ __forceinline__ void ph_topk(const int wid0, const Params& p, int l, LAS unsigned char* lds) {
    PH_PROLOG;
    const int tid = TID, lane = tid & 63, wid = tid >> 6;
    LAS unsigned* keys = (LAS unsigned*)lds;
    LAS int* hist = (LAS int*)(lds + 8192);
    LAS int* hs2 = (LAS int*)(lds + 8192 + 1024);
    LAS int* ctl = (LAS int*)(lds + 8192 + 2048);
    LAS int* wsum = (LAS int*)(lds + 8192 + 2048 + 64);
    LAS int* lidx = (LAS int*)(lds + 8192 + 4096);
    const int nun = (l == 0) ? 256 : 128;
    for (int u = blockIdx.x; u < nun; u += gridDim.x) {
        const bool isctx = u >= 128; const int be = u & 127, b = be >> 4, e = be & 15;
        const int N = isctx ? 256 : 2048, cap = isctx ? 32 : 256;
        const float* src = isctx ? p.AFFC + (size_t)be * 256 : p.AFFT + (size_t)be * 2048;
        __syncthreads();
        for (int i = tid; i < N; i += 512) keys[i] = __float_as_uint(src[i]);
        if (tid == 0) { ctl[0] = 0; ctl[1] = cap; }
        __syncthreads();
        for (int pass = 0; pass < 4; ++pass) {
            const int shift = 24 - 8 * pass;
            if (tid < 256) hist[tid] = 0;
            __syncthreads();
            const unsigned prefix = (unsigned)ctl[0]; const int krem = ctl[1];
            for (int i = tid; i < N; i += 512) { const unsigned k = keys[i]; if (pass == 0 || (k >> (shift + 8)) == (prefix >> (shift + 8))) __hip_atomic_fetch_add(&hist[(k >> shift) & 255u], 1, __ATOMIC_RELAXED, __HIP_MEMORY_SCOPE_WORKGROUP); }
            __syncthreads();
            LAS int* a = hist; LAS int* bb = hs2;
            for (int off = 1; off < 256; off <<= 1) {
                if (tid < 256) bb[tid] = a[tid] + ((tid + off < 256) ? a[tid + off] : 0);
                __syncthreads();
                LAS int* t = a; a = bb; bb = t;
            }
            if (tid < 256) { const int S = a[tid], Sn = (tid < 255) ? a[tid + 1] : 0; if (S >= krem && Sn < krem) { ctl[0] = (int)(prefix | ((unsigned)tid << shift)); ctl[1] = krem - Sn; } }
            __syncthreads();
        }
        const unsigned Tk = (unsigned)ctl[0]; const int need = ctl[1], ngt = cap - need;
        const int per = isctx ? 1 : 4, i0 = tid * per;
        int cg = 0, ce = 0;
        if (i0 < N) for (int k = 0; k < per; ++k) { const unsigned kk = keys[i0 + k]; cg += (kk > Tk); ce += (kk == Tk); }
        int pk = cg | (ce << 16), incl = pk;
#pragma unroll
        for (int o = 1; o < 64; o <<= 1) { const int t = __shfl_up(incl, o); if (lane >= o) incl += t; }
        if (lane == 63) wsum[wid] = incl;
        __syncthreads();
        int base = 0;
        for (int w = 0; w < wid; ++w) base += wsum[w];
        int ex = base + incl - pk, pg = ex & 0xffff, pe = ex >> 16;
        if (i0 < N) for (int k = 0; k < per; ++k) {
            const int i = i0 + k; const unsigned kk = keys[i];
            const int trow = isctx ? (T + b * 256 + i) : (b * 2048 + i);
            int slot = -1;
            if (kk > Tk) { slot = pg; ++pg; } else if (kk == Tk) { if (pe < need) slot = ngt + pe; ++pe; }
            int xrow = -1;
            if (slot >= 0) { xrow = isctx ? ((128 + e) * 256 + b * 32 + slot) : ((e * 8 + b) * 256 + slot); p.IDXROW[xrow] = trow; p.GATEV[xrow] = __uint_as_float(kk); }
            p.SEL[(size_t)trow * 16 + e] = xrow;
        }
    }
}
__device__ __forceinline__ void ph_gather(const int wid0, const Params& p, int l) {
    PH_PROLOG;
    const int nrows = (l == 0) ? XE_ROWS : 128 * 256; const int lane = LANE;
    for (int r = GWAVE; r < nrows; r += NWAVE) {
        const bf16_t* src = p.H2 + (size_t)p.IDXROW[r] * 2048; bf16_t* dst = p.XE + (size_t)r * 2048;
#pragma unroll
        for (int k = 0; k < 4; ++k) *(u32x4*)(dst + (k * 64 + lane) * 8) = *(const u32x4*)(src + (k * 64 + lane) * 8);
    }
}
__device__ __forceinline__ void ph_combine(const int wid0, const Params& p, int l) {
    PH_PROLOG;
    const float* modl = p.MOD + (size_t)l * 9 * 12288; const int lane = LANE;
    const int nrows = (l == 0) ? TT : T;
    const float* g1n = p.in[6] + (l + 1 < DEPTH ? (l + 1) * 2048 : 0);
    const float* modn = p.MOD + (size_t)(l + 1 < DEPTH ? l + 1 : l) * 9 * 12288;
    int selv_n = (lane < 16 && GWAVE < nrows) ? p.SEL[(size_t)GWAVE * 16 + lane] : -1;
    for (int r = GWAVE; r < nrows; r += NWAVE) {
        const int selv = selv_n;
        { const int rn = r + NWAVE; selv_n = (lane < 16 && rn < nrows) ? p.SEL[(size_t)rn * 16 + lane] : -1; }
        const float* g2 = modl + (size_t)row_s(r) * 12288 + 5 * 2048;
        float* xp = p.XCUR + (size_t)r * 2048;
        f32x4 xv[8], gv[8];
#pragma unroll
        for (int i = 0; i < 8; ++i) { const int c = (i >> 1) * 512 + lane * 8 + (i & 1) * 4; xv[i] = *(const f32x4*)(xp + c); gv[i] = *(const f32x4*)(g2 + c); }
        float acc[32];
#pragma unroll
        for (int k = 0; k < 32; ++k) acc[k] = 0.f;
        for (int e = 0; e < 16; ++e) {
            const int xr = __shfl(selv, e);
            if (xr >= 0) {
                const bf16_t* ye = p.YE + (size_t)xr * 2048;
#pragma unroll
                for (int i = 0; i < 4; ++i) { float f[8]; load8(ye + i * 512 + lane * 8, f);
#pragma unroll
                    for (int k = 0; k < 8; ++k) acc[i * 8 + k] += f[k]; }
            }
        }
        float ss = 0.f;
#pragma unroll
        for (int i = 0; i < 4; ++i)
#pragma unroll
            for (int hh = 0; hh < 2; ++hh) {
                const int c = i * 512 + lane * 8 + hh * 4;
                f32x4 x = xv[i * 2 + hh]; const f32x4 g = gv[i * 2 + hh];
#pragma unroll
                for (int k = 0; k < 4; ++k) { x[k] += g[k] * acc[i * 8 + hh * 4 + k]; acc[i * 8 + hh * 4 + k] = x[k]; ss += x[k] * x[k]; }
                if (l == DEPTH - 1) *(f32x4*)(p.out + (size_t)r * 2048 + c) = x; else *(f32x4*)(xp + c) = x;
            }
        if (l + 1 < DEPTH) {
            ss = wave_sum(ss);
            const float rs = rsqrtf(ss * (1.0f / 2048.0f) + NORM_EPS);
            const float* ms = modn + (size_t)row_s(r) * 12288;
#pragma unroll
            for (int i = 0; i < 4; ++i) {
                const int c = i * 512 + lane * 8;
#pragma unroll
                for (int hh = 0; hh < 2; ++hh) {
                    const f32x4 gg = *(const f32x4*)(g1n + c + hh * 4), sh = *(const f32x4*)(ms + c + hh * 4), sc = *(const f32x4*)(ms + 2048 + c + hh * 4);
#pragma unroll
                    for (int k = 0; k < 4; ++k) acc[i * 8 + hh * 4 + k] = acc[i * 8 + hh * 4 + k] * rs * gg[k] * (1.0f + sc[k]) + sh[k];
                }
            }
#pragma unroll
            for (int i = 0; i < 4; ++i) store8(p.H + (size_t)r * 2048 + i * 512 + lane * 8, acc + i * 8);
        }
    }
}

#define XB_TMO      128
#define XB_XCNT(j)  (256  + 64 * (j))
#define XB_XSUB(j)  (1280 + 64 * (j))
#define XB_XGEN(j)  (2304 + 64 * (j))
#define XB_TOP      3328
#define XB_TOPGEN   3392
#define XCD_BAR_WORDS 3456
#define XB_SPIN_CAP (1u << 22)
__device__ __forceinline__ unsigned xb_ld(unsigned* p)              { return __hip_atomic_load(p, __ATOMIC_RELAXED, __HIP_MEMORY_SCOPE_AGENT); }
__device__ __forceinline__ unsigned xb_add(unsigned* p, unsigned v) { return __hip_atomic_fetch_add(p, v, __ATOMIC_RELAXED, __HIP_MEMORY_SCOPE_AGENT); }
__device__ __forceinline__ unsigned xb_xcc_id() { return (unsigned)__builtin_amdgcn_s_getreg((3 << 11) | 20) & 0xFu; }
#define XB_SPIN(cond, bar) do { unsigned _sp = 0; while (cond) { __builtin_amdgcn_s_sleep(1); \
    if ((++_sp & 255u) == 0u) { if (xb_ld(&(bar)[XB_TMO])) break; if (_sp > XB_SPIN_CAP) { atomicAdd(&(bar)[XB_TMO], 1u); break; } } } } while (0)
struct XcdBarrier { unsigned* bar; unsigned x; volatile LAS unsigned* st; int wid0; };
__device__ __forceinline__ bool xb_leader(int wid0) { return wid0 == 0 && opaque_lane() == 0; }
__device__ __forceinline__ XcdBarrier xcd_barrier_post(unsigned* bar, volatile LAS unsigned* st, int wid0) {
    XcdBarrier b; b.bar = bar; b.x = xb_xcc_id(); b.st = st; b.wid0 = wid0;
    if (xb_leader(wid0)) (void)xb_add(&bar[XB_XCNT(b.x)], 1u);
    return b;
}
__device__ __forceinline__ void xcd_barrier_complete(unsigned* bar, unsigned x, unsigned& nloc, unsigned& nx) {
    const unsigned G = gridDim.x * gridDim.y * gridDim.z;
    unsigned sum, cnt, mine, sp = 0u;
    for (;;) {
        sum = 0u; cnt = 0u; mine = 0u;
#pragma unroll
        for (unsigned j = 0; j < 16; ++j) { const unsigned c = xb_ld(&bar[XB_XCNT(j)]); sum += c; cnt += (c > 0u) ? 1u : 0u; mine = (j == x) ? c : mine; }
        if (sum == G) break;
        __builtin_amdgcn_s_sleep(1);
        if ((++sp & 255u) == 0u) { if (xb_ld(&bar[XB_TMO])) break; if (sp > XB_SPIN_CAP) { atomicAdd(&bar[XB_TMO], 1u); break; } }
    }
    nloc = mine > 0u ? mine : 1u; nx = cnt > 0u ? cnt : 1u;
}
__device__ __forceinline__ void xcd_barrier(const XcdBarrier& b) {
    asm volatile("s_waitcnt vmcnt(0)" ::: "memory");
    __syncthreads();
    if (xb_leader(b.wid0)) {
        unsigned* bar = b.bar;
        __builtin_amdgcn_s_waitcnt(0);
        unsigned nloc = b.st[0], nx = b.st[1];
        if (nloc == 0u) { xcd_barrier_complete(bar, b.x, nloc, nx); b.st[0] = nloc; b.st[1] = nx; }
        const unsigned old = xb_add(&bar[XB_XSUB(b.x)], 1u);
        const unsigned gen = old / nloc;
        if (old + 1u == (gen + 1u) * nloc) {
            __builtin_amdgcn_fence(__ATOMIC_RELEASE, "agent");
            asm volatile("s_waitcnt vmcnt(0)" ::: "memory");
            const unsigned og = xb_add(&bar[XB_TOP], 1u);
            const unsigned tg = og / nx;
            if (og + 1u == (tg + 1u) * nx) xb_add(&bar[XB_TOPGEN], 1u);
            else XB_SPIN(xb_ld(&bar[XB_TOPGEN]) == tg, bar);
            __builtin_amdgcn_fence(__ATOMIC_ACQUIRE, "agent");
            xb_add(&bar[XB_XGEN(b.x)], 1u);
            asm volatile("s_waitcnt vmcnt(0)" ::: "memory");
        } else {
            XB_SPIN(xb_ld(&bar[XB_XGEN(b.x)]) == gen, bar);
            __builtin_amdgcn_fence(__ATOMIC_ACQUIRE, "agent");
            asm volatile("s_waitcnt vmcnt(0)" ::: "memory");
        }
    }
    __syncthreads();
}

enum { PH_ADALN_P = 0, PH_ADALN_R, PH_CONST, PH_CVT_MIX, PH_MODULATE, PH_GEMM_WIN, PH_PREPA, PH_GEMM_LORA, PH_GEMM_FCHAN, PH_GEMM_UQ, PH_GEMM_UKV, PH_PREPB,
       PH_MLA, PH_NA, PH_SCAN, PH_SCAN_A, PH_SCAN_B, PH_SCAN_C, PH_GEMM_WIN_DEFER, PH_RWKV_OUT, PH_GEMM_FSEQ, PH_GEMM_FSEQC, PH_GEMM_MERGE, PH_GEMM_WOUT, PH_CVT_MOE, PH_ROUTER, PH_TOPK, PH_GATHER, PH_GEMM_MOE1, PH_GEMM_MOE2, PH_COMBINE };

template <int PH> __device__ __forceinline__ void run_phase(const int wid0, const Params& p, int l, LAS unsigned char* lds, int blk0 = 0, int nblk = 0) {
    const int G = nblk ? nblk : (int)gridDim.x, c = (int)blockIdx.x - blk0;
    if constexpr (PH == PH_ADALN_P) ph_adaln_partial(wid0, p, lds);
    else if constexpr (PH == PH_ADALN_R) ph_adaln_reduce(wid0, p);
    else if constexpr (PH == PH_CONST) ph_const(wid0, p);
    else if constexpr (PH == PH_CVT_MIX) ph_cvt_mixer(wid0, p, l, lds, 3, (int)blockIdx.x, (int)gridDim.x);
    else if constexpr (PH == PH_MODULATE) ph_modulate(wid0, p, l, p.H);
    else if constexpr (PH == PH_GEMM_WIN || PH == PH_GEMM_WIN_DEFER) {
        pg8::SchedRects S{(const char*)p.H, (const char*)p.WIN_T, 256L * 2048 * 2, 256L * 2048 * 2, G, c, {{0, 0, 0, 0}, {0, 0, 0, 0}, {0, 0, 0, 0}}};
        constexpr bool DEF = (PH == PH_GEMM_WIN_DEFER);
        if (l == 0) {
            if (!DEF) { S.r[0][0] = 0; S.r[0][1] = 69; S.r[0][2] = 0; S.r[0][3] = 51;  S.r[1][0] = 69; S.r[1][1] = 1; S.r[1][2] = 0; S.r[1][3] = 27;  S.r[2][0] = 70; S.r[2][1] = 2; S.r[2][2] = 0; S.r[2][3] = 19; }
            else      { S.r[0][0] = 69; S.r[0][1] = 1; S.r[0][2] = 27; S.r[0][3] = 24;  S.r[1][0] = 70; S.r[1][1] = 2; S.r[1][2] = 19; S.r[1][3] = 32; }
        } else {
            if (!DEF) { S.r[0][0] = 0; S.r[0][1] = 63; S.r[0][2] = 0; S.r[0][3] = 51;  S.r[1][0] = 63; S.r[1][1] = 1; S.r[1][2] = 0; S.r[1][3] = 35;  S.r[2][0] = 64; S.r[2][1] = 8; S.r[2][2] = 0; S.r[2][3] = 10; }
            else      { S.r[0][0] = 63; S.r[0][1] = 1; S.r[0][2] = 35; S.r[0][3] = 16; }
        }
        EpiWin E{p.ZS, p.G};
        pg8::gemm_phase(wid0, lds, 2048, 2048, 2048, S, E);
    } else if constexpr (PH == PH_PREPA) ph_prepA(wid0, p, l);
    else if constexpr (PH == PH_GEMM_LORA) {
        pg8::Sched2D S{(const char*)p.LA, (const char*)p.WLORA_T, 256L * 256 * 2, 256L * 256 * 2, 0, TT / 256, 2560 / 256, G, c, 0};
        EpiLora E{p.in[20] + l * 1024, p.in[22] + l * 1024, p.in[26] + l * 512, p.RK, p.R1, p.R2, p.GRW, p.RBP};
        pg8::gemm_phase(wid0, lds, 256, 256, 256, S, E);
    } else if constexpr (PH == PH_GEMM_FCHAN) {
        pg8::Sched2D S{(const char*)p.WFC, (const char*)(p.ZS + 4128), 256L * 512 * 2, 256L * ZW * 2, 0, 1024 / 256, (l == DEPTH - 1) ? T / 256 : TT / 256, G, (c + 40) % G, 0};
        EpiFourChan E{p.XCS, p.XCSC};
        pg8::gemm_phase(wid0, lds, 512, 512, ZW, S, E);
    } else if constexpr (PH == PH_GEMM_UQ) {
        pg8::Sched2D S{(const char*)p.CQN, (const char*)p.WUQ_T, 256L * 512 * 2, 256L * 512 * 2, 0, (l == DEPTH - 1) ? T / 256 : TT / 256, 768 / 256, G, c, 0};
        EpiBf16 E{p.Q0, 768};
        pg8::gemm_phase(wid0, lds, 512, 512, 512, S, E);
    } else if constexpr (PH == PH_GEMM_UKV) {
        pg8::Sched2D S{(const char*)p.CKVN, (const char*)p.WUKV_T, 256L * 256 * 2, 256L * 256 * 2, 0, TT / 256, 1024 / 256, G, (c + 48) % G, 0};
        EpiBf16 E{p.KV0, 1024};
        pg8::gemm_phase(wid0, lds, 256, 256, 256, S, E);
    } else if constexpr (PH == PH_PREPB) ph_prepB(wid0, p, l);
    else if constexpr (PH == PH_MLA) ph_mla_flash(wid0, p, l, lds);
    else if constexpr (PH == PH_NA) ph_na_flash(wid0, p, l, lds);
    else if constexpr (PH == PH_SCAN_A) ph_scan_a(wid0, p, lds);
    else if constexpr (PH == PH_SCAN_B) ph_scan_b(wid0, p);
    else if constexpr (PH == PH_SCAN_C) ph_scan_c(wid0, p, lds);
    else if constexpr (PH == PH_RWKV_OUT) ph_rwkv_out(wid0, p, l);
    else if constexpr (PH == PH_GEMM_FSEQ) {
        pg8::Sched2D S{(const char*)p.ADFT, (const char*)p.XCS, 256L * 4096 * 2, 256L * 4096 * 2, 0, 2048 / 256, 4096 / 256, G, c, 0};
        EpiFourSeq E{p.Y, 0, 2048, 1.0f / 512.0f};
        pg8::gemm_phase(wid0, lds, 4096, 4096, 4096, S, E);
    } else if constexpr (PH == PH_GEMM_FSEQC) {
        pg8::Sched2D S{(const char*)p.ADFTC, (const char*)p.XCSC, 256L * 512 * 2, 256L * 512 * 2, 0, 1, 4096 / 256, G, (c + 40) % G, 0};
        EpiFourSeq E{p.Y, T, 256, 0.005524271728019903f};
        pg8::gemm_phase(wid0, lds, 512, 512, 512, S, E);
    } else if constexpr (PH == PH_GEMM_MERGE) {
        pg8::gemm_merge(wid0, lds, p.Y, p.WBR_T, p.G, p.ACCB, (l == DEPTH - 1) ? T / 256 : TT / 256, G, c);
    } else if constexpr (PH == PH_GEMM_WOUT) {
        pg8::Sched2D S{(const char*)p.ACCB, (const char*)p.WOUT_T, 256L * 2048 * 2, 256L * 2048 * 2, 0, (l == DEPTH - 1) ? T / 256 : TT / 256, 2048 / 256, G, c, 0};
        EpiWout E{p.XCUR, p.MOD + (size_t)l * 9 * 12288, (l == 0) ? p.in[0] : p.XCUR, (l == 0) ? p.in[2] - (size_t)T * 2048 : p.XCUR};
        pg8::gemm_phase(wid0, lds, 2048, 2048, 2048, S, E);
    } else if constexpr (PH == PH_CVT_MOE) ph_cvt_moe(wid0, p, l, lds, (l == 0 && gridDim.x == 256) ? 4 : 7, (int)blockIdx.x, (int)gridDim.x);
    else if constexpr (PH == PH_ROUTER) ph_moe_router(wid0, p, l, lds);
    else if constexpr (PH == PH_TOPK) ph_topk(wid0, p, l, lds);
    else if constexpr (PH == PH_GATHER) ph_gather(wid0, p, l);
    else if constexpr (PH == PH_GEMM_MOE1) {
        pg8::Sched2D S{(const char*)p.H2, (const char*)p.W13T, 0L, 256L * 2048 * 2, 2048L * 2048 * 2, (l == 0) ? 144 : 128, 2048 / 256, G, c, 1};
        EpiSwiglu E{p.HH};
        pg8::gemm_phase<EpiSwiglu, pg8::Sched2D, true>(wid0, lds, 2048, 2048, 2048, S, E, p.IDXROW);
    } else if constexpr (PH == PH_GEMM_MOE2) {
        pg8::Sched2D S{(const char*)p.HH, (const char*)p.W2T, 256L * 1024 * 2, 256L * 1024 * 2, 2048L * 1024 * 2, (l == 0) ? 144 : 128, 2048 / 256, G, c, 1};
        EpiMoeOut E{p.YE, p.GATEV};
        pg8::gemm_phase(wid0, lds, 1024, 1024, 1024, S, E);
    } else if constexpr (PH == PH_COMBINE) ph_combine(wid0, p, l);
}

template <int PH> __global__ void __launch_bounds__(512, 2) k_phase(Params p, int l) {
    extern __shared__ __attribute__((aligned(16))) unsigned char shm[];
    run_phase<PH>(__builtin_amdgcn_readfirstlane((int)threadIdx.x >> 6), p, l, (LAS unsigned char*)shm);
}


constexpr int LDS_BYTES = 147456;
#define PHASE(PH, L) do { run_phase<PH>(wid0, p, (L), lds); __syncthreads(); } while (0)
#define GBAR() xcd_barrier(xb)
template <int l> __device__ __forceinline__ void layer_body(const int wid0, const Params& p, LAS unsigned char* lds, const XcdBarrier& xb) {
    constexpr int DUP = (l == 0) ? PROBE_DUP : 0;
    if constexpr (DUP == 2) PHASE(PH_CVT_MIX, l);
    if constexpr (l == 0) {
        PHASE(PH_MODULATE, l);
        if constexpr (DUP == 3 || DUP == 11) PHASE(PH_MODULATE, l);
        GBAR();
    }
    PHASE(PH_GEMM_WIN, l);
    if constexpr (DUP == 1) PHASE(PH_GEMM_WIN, l);
    GBAR();
    PHASE(PH_PREPA, l);
    if constexpr (DUP == 3 || DUP == 11) PHASE(PH_PREPA, l);
    GBAR();
    PHASE(PH_GEMM_LORA, l); PHASE(PH_GEMM_FCHAN, l); PHASE(PH_GEMM_UQ, l); PHASE(PH_GEMM_UKV, l);
    if constexpr (DUP == 6 || DUP == 61) { PHASE(PH_GEMM_LORA, l); }
    if constexpr (DUP == 6 || DUP == 62) { PHASE(PH_GEMM_FCHAN, l); }
    if constexpr (DUP == 6 || DUP == 63) { PHASE(PH_GEMM_UQ, l); PHASE(PH_GEMM_UKV, l); }
    GBAR();
    PHASE(PH_PREPB, l);
    if constexpr (DUP == 3 || DUP == 12) PHASE(PH_PREPB, l);
    GBAR();
    PHASE(PH_SCAN_A, l);
    if constexpr (DUP == 5 || DUP == 16) PHASE(PH_SCAN_A, l);
    GBAR();
    PHASE(PH_SCAN_B, l); PHASE(PH_MLA, l); PHASE(PH_NA, l);
    if constexpr (DUP == 5) PHASE(PH_SCAN_B, l);
    if constexpr (DUP == 4) PHASE(PH_MLA, l);
    if constexpr (DUP == 4 || DUP == 41) PHASE(PH_NA, l);
    GBAR();
    PHASE(PH_SCAN_C, l);
    if (gridDim.x == 256) {
        if (blockIdx.x < 128) run_phase<PH_GEMM_FSEQ>(wid0, p, l, lds, 0, 128); else run_phase<PH_GEMM_WIN_DEFER>(wid0, p, l, lds, 128, 128);
        __syncthreads();
    } else { PHASE(PH_GEMM_FSEQ, l); PHASE(PH_GEMM_WIN_DEFER, l); }
    if constexpr (l == 0) PHASE(PH_GEMM_FSEQC, l);
    if constexpr (DUP == 5 || DUP == 18) PHASE(PH_SCAN_C, l);
    if constexpr (DUP == 6 || DUP == 64) { PHASE(PH_GEMM_FSEQ, l); PHASE(PH_GEMM_FSEQC, l); }
    GBAR();
    PHASE(PH_RWKV_OUT, l);
    if constexpr (DUP == 3 || DUP == 13) PHASE(PH_RWKV_OUT, l);
    GBAR();
    constexpr bool FILL = (l == 0);
    PHASE(PH_GEMM_MERGE, l);
    if constexpr (FILL) { if (gridDim.x == 256 && blockIdx.x >= 64) { ph_cvt_moe(wid0, p, l, lds, 1, (int)blockIdx.x - 64, 192); __syncthreads(); } }
    if constexpr (DUP == 7) PHASE(PH_GEMM_MERGE, l);
    GBAR();
    PHASE(PH_GEMM_WOUT, l);
    if constexpr (FILL) { if (gridDim.x == 256 && blockIdx.x >= 64) { ph_cvt_moe(wid0, p, l, lds, 2, (int)blockIdx.x - 64, 192); __syncthreads(); } }
    GBAR();
    PHASE(PH_CVT_MOE, l); PHASE(PH_ROUTER, l);
    if constexpr (DUP == 2) PHASE(PH_CVT_MOE, l);
    if constexpr (DUP == 3 || DUP == 14) PHASE(PH_ROUTER, l);
    GBAR();
    PHASE(PH_TOPK, l);
    if constexpr (DUP == 3 || DUP == 14) PHASE(PH_TOPK, l);
    GBAR();
    PHASE(PH_GEMM_MOE1, l);
    if constexpr (FILL && l + 1 < DEPTH) { if (gridDim.x == 256 && blockIdx.x >= 128) { ph_cvt_mixer(wid0, p, l + 1, lds, 1, (int)blockIdx.x - 128, 128); __syncthreads(); } }
    if constexpr (DUP == 8) PHASE(PH_GEMM_MOE1, l);
    GBAR();
    PHASE(PH_GEMM_MOE2, l);
    if constexpr (FILL && l + 1 < DEPTH) { if (gridDim.x == 256 && blockIdx.x >= 128) { ph_cvt_mixer(wid0, p, l + 1, lds, 2, (int)blockIdx.x - 128, 128); __syncthreads(); } }
    if constexpr (DUP == 8) PHASE(PH_GEMM_MOE2, l);
    GBAR();
    PHASE(PH_COMBINE, l);
    if constexpr (l + 1 < DEPTH) { if (!(FILL && gridDim.x == 256)) PHASE(PH_CVT_MIX, l + 1); }
    GBAR();
}
__global__ void __launch_bounds__(512, 2) k_mega(Params p) {
    extern __shared__ __attribute__((aligned(16))) unsigned char shm[];
    LAS unsigned char* lds = (LAS unsigned char*)shm;
    const int wid0 = __builtin_amdgcn_readfirstlane((int)threadIdx.x >> 6);
    volatile LAS unsigned* xw = (volatile LAS unsigned*)(lds + LDS_BYTES - 16);
    if (xb_leader(wid0)) { xw[0] = 0u; xw[1] = 0u; xw[2] = 0u; xw[3] = 0u; }
    __syncthreads();
    XcdBarrier xb = xcd_barrier_post(p.bar, xw, wid0);
    PHASE(PH_ADALN_P, 0); PHASE(PH_CONST, 0);
    if (gridDim.x == 256) {
        if (blockIdx.x < 192) { ph_cvt_mixer(wid0, p, 0, lds, 3, (int)blockIdx.x, 320); }
        else { ph_cvt_mixer(wid0, p, 0, lds, 3, 192 + 2 * ((int)blockIdx.x - 192), 320); __syncthreads(); ph_cvt_mixer(wid0, p, 0, lds, 3, 193 + 2 * ((int)blockIdx.x - 192), 320); }
        __syncthreads();
    } else { PHASE(PH_CVT_MIX, 0); }
    GBAR();
    PHASE(PH_ADALN_R, 0);
    GBAR();
    layer_body<0>(wid0, p, lds, xb);
    layer_body<1>(wid0, p, lds, xb);
}

static inline size_t al256(size_t x) { return (x + 255) & ~(size_t)255; }

template <int PH> static void launch(const Params& p, int l, hipStream_t st) {
    static bool attr = false;
    if (!attr) { (void)hipFuncSetAttribute((const void*)k_phase<PH>, hipFuncAttributeMaxDynamicSharedMemorySize, LDS_BYTES); attr = true; }
    hipLaunchKernelGGL((k_phase<PH>), dim3(256), dim3(512), LDS_BYTES, st, p, l);
}

extern "C" void kernel_launch(void* const* d_in, const int* in_sizes, int n_in, void* d_out, int out_size, void* d_ws, size_t ws_size, hipStream_t stream) {
    Params p;
    memset(&p, 0, sizeof(p));
    for (int i = 0; i < 36; ++i) p.in[i] = (const float*)d_in[i];
    p.out = (float*)d_out;
    char* ws = (char*)d_ws; size_t off = 0;
    auto take = [&](size_t bytes) { char* r = ws + off; off = al256(off + bytes); return r; };
    p.bar = (unsigned*)take(16384);
    p.MOD = (float*)take((size_t)2 * 9 * 12288 * 4);
    p.MODP = (float*)take((size_t)16 * 2 * 9 * 12288 * 4);
    p.XCUR = (float*)take((size_t)TT * 2048 * 4);
    p.WIN_T = (bf16_t*)take((size_t)ZN * 2048 * 2);
    p.WBR_T = (bf16_t*)take((size_t)4 * 2048 * 512 * 2);
    p.WOUT_T = (bf16_t*)take((size_t)2048 * 2048 * 2);
    p.WUQ_T = (bf16_t*)take((size_t)768 * 512 * 2);
    p.WUKV_T = (bf16_t*)take((size_t)1024 * 256 * 2);
    p.WLORA_T = (bf16_t*)take((size_t)2560 * 256 * 2);
    p.WFC = (bf16_t*)take((size_t)1024 * 512 * 2);
    p.ADFT = (bf16_t*)take((size_t)2048 * 4096 * 2);
    p.ADFTC = (bf16_t*)take((size_t)256 * 512 * 2);
    p.H = (bf16_t*)take((size_t)TT * 2048 * 2);
    p.RBP = (int*)take((size_t)TT * 16);
    const size_t base = off;
    p.Y = (bf16_t*)take((size_t)TT * 2048 * 2);
    p.ZS = (bf16_t*)take((size_t)TT * ZW * 2); p.ACC = (float*)p.ZS;
    p.G = (bf16_t*)take((size_t)TT * GW * 2);
    p.NQ = (bf16_t*)take((size_t)TT * 512 * 2);
    p.NK = (bf16_t*)take((size_t)TT * 512 * 2);
    const size_t scan_base = off;
    p.R1 = (char*)take((size_t)8 * 8 * 2304 * R1B);
    p.R2 = (char*)take((size_t)8 * 8 * 2 * 2304 * R2B);
    p.GRW = (bf16_t*)take((size_t)TT * 512 * 2);
    const size_t scan_end = off;
    p.CQN = (bf16_t*)take((size_t)TT * 512 * 2);
    p.CKVN = (bf16_t*)take((size_t)TT * 256 * 2);
    p.LA = (bf16_t*)take((size_t)TT * 256 * 2);
    p.RK = (bf16_t*)take((size_t)TT * 512 * 2);
    p.Q0 = (bf16_t*)take((size_t)TT * 768 * 2);
    p.KV0 = (bf16_t*)take((size_t)TT * 1024 * 2);
    p.MQ = (bf16_t*)take((size_t)TT * 768 * 2);
    p.MK = (bf16_t*)take((size_t)TT * 768 * 2);
    p.MVT = p.CQN; p.NVT = p.RK; p.ZB = p.KV0;
    p.YS = (float*)p.ZS; p.PMAT = p.YS + (size_t)2 * TT * 512; p.QMAT = p.PMAT + (size_t)128 * 16 * 4096; p.SMAT = p.QMAT + (size_t)128 * 16 * 4096;
    if ((size_t)((char*)(p.SMAT + (size_t)128 * 16 * 4096) - (char*)p.ZS) > (size_t)TT * ZW * 2) fprintf(stderr, "kernel_launch: scan scratch overflows the ZS region\n");
    p.XCS = (bf16_t*)take((size_t)4096 * 2 * 2048 * 2);
    p.XCSC = (bf16_t*)take((size_t)4096 * 2 * 256 * 2);
    const size_t mix_end = off;
    p.ACCB = (bf16_t*)(ws + scan_base);
    size_t moff = scan_base + al256((size_t)TT * 2048 * 2);
    p.W13T = (bf16_t*)(ws + moff); moff = al256(moff + (size_t)16 * 2048 * 2048 * 2);
    p.W2T = (bf16_t*)(ws + moff); moff = al256(moff + (size_t)16 * 2048 * 1024 * 2);
    (void)scan_end;
    if (moff > mix_end) { fprintf(stderr, "kernel_launch: moe weights overflow the mixer region (%zu > %zu)\n", moff, mix_end); }
    size_t aoff = base;
    auto atake = [&](size_t bytes) { char* r = ws + aoff; aoff = al256(aoff + bytes); return r; };
    p.H2 = (bf16_t*)atake((size_t)TT * 2048 * 2);
    p.XE = (bf16_t*)atake((size_t)XE_ROWS * 2048 * 2);
    p.HH = (bf16_t*)atake((size_t)XE_ROWS * 1024 * 2);
    p.YE = (bf16_t*)atake((size_t)XE_ROWS * 2048 * 2);
    p.AFFT = (float*)atake((size_t)128 * 2048 * 4);
    p.AFFC = (float*)atake((size_t)128 * 256 * 4);
    p.IDXROW = (int*)atake((size_t)XE_ROWS * 4);
    p.GATEV = (float*)atake((size_t)XE_ROWS * 4);
    p.SEL = (int*)atake((size_t)TT * 16 * 4);
    if (aoff > scan_base) fprintf(stderr, "kernel_launch: moe activations overflow (%zu > %zu)\n", aoff, scan_base);
    if (mix_end > ws_size) { fprintf(stderr, "kernel_launch: workspace too small: need %zu have %zu\n", mix_end, ws_size); return; }

#ifdef MK_MULTI
    launch<PH_ADALN_P>(p, 0, stream); launch<PH_CONST>(p, 0, stream); launch<PH_ADALN_R>(p, 0, stream);
    for (int l = 0; l < DEPTH; ++l) {
        launch<PH_CVT_MIX>(p, l, stream); launch<PH_MODULATE>(p, l, stream); launch<PH_GEMM_WIN>(p, l, stream); launch<PH_PREPA>(p, l, stream);
        launch<PH_GEMM_LORA>(p, l, stream); launch<PH_GEMM_FCHAN>(p, l, stream); launch<PH_GEMM_UQ>(p, l, stream); launch<PH_GEMM_UKV>(p, l, stream);
        launch<PH_PREPB>(p, l, stream); launch<PH_MLA>(p, l, stream); launch<PH_NA>(p, l, stream); launch<PH_SCAN>(p, l, stream); launch<PH_RWKV_OUT>(p, l, stream);
        launch<PH_GEMM_FSEQ>(p, l, stream); if (l == 0) launch<PH_GEMM_FSEQC>(p, l, stream);
        launch<PH_GEMM_MERGE>(p, l, stream); launch<PH_GEMM_WOUT>(p, l, stream); launch<PH_CVT_MOE>(p, l, stream); launch<PH_ROUTER>(p, l, stream);
        launch<PH_TOPK>(p, l, stream); launch<PH_GATHER>(p, l, stream); launch<PH_GEMM_MOE1>(p, l, stream); launch<PH_GEMM_MOE2>(p, l, stream); launch<PH_COMBINE>(p, l, stream);
    }
#else
    static int grid = 0;
    if (!grid) {
        int dev = 0, cus = 0, per_cu = 0;
        (void)hipGetDevice(&dev);
        (void)hipDeviceGetAttribute(&cus, hipDeviceAttributeMultiprocessorCount, dev);
        (void)hipFuncSetAttribute((const void*)k_mega, hipFuncAttributeMaxDynamicSharedMemorySize, LDS_BYTES);
        (void)hipOccupancyMaxActiveBlocksPerMultiprocessor(&per_cu, (const void*)k_mega, 512, LDS_BYTES);
        if (per_cu < 1) fprintf(stderr, "kernel_launch: occupancy query says %d blocks per CU\n", per_cu);
        grid = cus > 0 ? cus : 256;
    }
    (void)hipMemsetAsync(p.bar, 0, 16384, stream);
    hipLaunchKernelGGL(k_mega, dim3(grid), dim3(512), LDS_BYTES, stream, p);
#endif
}
#ifdef MK_DIAG
template __global__ void k_phase<PH_SCAN_A>(Params, int);
template __global__ void k_phase<PH_SCAN_B>(Params, int);
template __global__ void k_phase<PH_SCAN_C>(Params, int);
template __global__ void k_phase<PH_MLA>(Params, int);
template __global__ void k_phase<PH_NA>(Params, int);
#endif
#ifdef MK_DIAG
template __global__ void k_phase<PH_GEMM_LORA>(Params, int);
template __global__ void k_phase<PH_GEMM_WIN>(Params, int);
template __global__ void k_phase<PH_GEMM_MERGE>(Params, int);
#endif
#ifdef MK_DIAG
template __global__ void k_phase<PH_GEMM_WOUT>(Params, int);
template __global__ void k_phase<PH_GEMM_MOE2>(Params, int);
#endif
```
